# Optimizing an MI355X kernel written in HIP

```python
import math
import jax, jax.numpy as jnp
from jax import lax
import numpy as np

D_MODEL = 1024
BATCH = 16
SEQ = 4096
DEPTH = 4

CTX_LEN = 256
GRID_W = 64
N_MOD = 9
D_FF = 2816

POOL_WINDOWS = (2, 4, 8, 16)
POOL_GROUP = 64
POOL_WIDTH = POOL_GROUP * len(POOL_WINDOWS)
MLA_HEADS = 4
MLA_NOPE = 64
MLA_ROPE = 32
MLA_V = 64
MLA_Q_RANK = 384
MLA_KV_RANK = 256
MLA_WIDTH = MLA_HEADS * MLA_V
DIFF_HEADS = 4
DIFF_DIM = 64
DIFF_V = 2 * DIFF_DIM
DIFF_WIDTH = DIFF_HEADS * DIFF_V
MIX_WIDTH = POOL_WIDTH + MLA_WIDTH + DIFF_WIDTH
IN_POOL = POOL_WIDTH
IN_MLA = MLA_Q_RANK + MLA_KV_RANK + MLA_ROPE
IN_DIFF = 3 * DIFF_HEADS * 2 * DIFF_DIM
IN_WIDTH = IN_POOL + IN_MLA + IN_DIFF
ROPE_BASE = 10000.0
Q_BLOCK = 128
EPS = 1e-6

kernel_name = "hymba_pool_mla_diff_macaron"

F32 = jnp.float32


def _rmsnorm(x, g):
    xf = x.astype(F32)
    y = xf * lax.rsqrt(jnp.mean(xf * xf, axis=-1, keepdims=True) + EPS)
    return (y * g.astype(F32)).astype(x.dtype)


def _modulate(n, shift, scale):
    return n * (1.0 + scale) + shift


def _swiglu(x, w1, w3, w2):
    return (jax.nn.silu(x @ w1) * (x @ w3)) @ w2


def _axial_rope(n_tok, rot_dim):
    t = jnp.arange(n_tok)
    row = (t // GRID_W).astype(F32)
    col = (t % GRID_W).astype(F32)
    n_axis = rot_dim // 4
    inv = ROPE_BASE ** (-jnp.arange(n_axis, dtype=F32) / n_axis)
    ang = jnp.concatenate([row[:, None] * inv, col[:, None] * inv], axis=-1)
    return jnp.cos(ang), jnp.sin(ang)


def _rope(x, cos, sin):
    h = x.shape[-1] // 2
    x1 = x[..., :h].astype(F32)
    x2 = x[..., h:].astype(F32)
    c = cos[None, :, None, :]
    s = sin[None, :, None, :]
    return jnp.concatenate([x1 * c - x2 * s, x1 * s + x2 * c], axis=-1).astype(x.dtype)


def _window_mean(u, k, axis):
    n = u.shape[axis]
    lo = k // 2
    hi = k - 1 - lo
    csum = jnp.cumsum(u.astype(F32), axis=axis)
    pad = [(0, 0)] * u.ndim
    pad[axis] = (1, 0)
    pref = jnp.pad(csum, pad)
    idx = jnp.arange(n)
    start = jnp.clip(idx - lo, 0, n)
    end = jnp.clip(idx + hi + 1, 0, n)
    tot = jnp.take(pref, end, axis=axis) - jnp.take(pref, start, axis=axis)
    cnt_shape = [1] * u.ndim
    cnt_shape[axis] = n
    cnt = (end - start).astype(F32).reshape(cnt_shape)
    return (tot / cnt).astype(u.dtype)


def _pool_mixer(u, pool_w, pool_scale, rows):
    b, n, _ = u.shape
    outs = []
    for g, k in enumerate(POOL_WINDOWS):
        ug = u[..., g * POOL_GROUP:(g + 1) * POOL_GROUP]
        if rows is None:
            m = _window_mean(ug, k, 1)
        else:
            ug2 = ug.reshape(b, rows, GRID_W, POOL_GROUP)
            m = _window_mean(_window_mean(ug2, k, 1), k, 2).reshape(b, n, POOL_GROUP)
        outs.append((m - ug) @ pool_w[g])
    return jnp.concatenate(outs, axis=-1) * pool_scale


def _mla_qkv(u, q_norm, w_uq, kv_norm, w_ukv, rope):
    b, n, _ = u.shape
    c_q = _rmsnorm(u[..., :MLA_Q_RANK], q_norm)
    c_kv = _rmsnorm(u[..., MLA_Q_RANK:MLA_Q_RANK + MLA_KV_RANK], kv_norm)
    k_rope = u[..., MLA_Q_RANK + MLA_KV_RANK:][:, :, None, :]
    q = (c_q @ w_uq).reshape(b, n, MLA_HEADS, MLA_NOPE + MLA_ROPE)
    kv = (c_kv @ w_ukv).reshape(b, n, MLA_HEADS, MLA_NOPE + MLA_V)
    q_nope, q_rope = q[..., :MLA_NOPE], q[..., MLA_NOPE:]
    if rope is not None:
        q_rope = _rope(q_rope, *rope)
        k_rope = _rope(k_rope, *rope)
    q = jnp.concatenate([q_nope, q_rope], axis=-1)
    k = jnp.concatenate([kv[..., :MLA_NOPE], jnp.broadcast_to(k_rope, (b, n, MLA_HEADS, MLA_ROPE))], axis=-1)
    v = kv[..., MLA_NOPE:]
    return q, k, v


def _diff_qkv(u, rope):
    b, n, _ = u.shape
    hq = DIFF_HEADS * 2 * DIFF_DIM
    q = u[..., :hq].reshape(b, n, 2 * DIFF_HEADS, DIFF_DIM)
    k = u[..., hq:2 * hq].reshape(b, n, 2 * DIFF_HEADS, DIFF_DIM)
    v = u[..., 2 * hq:].reshape(b, n, DIFF_HEADS, DIFF_V)
    if rope is not None:
        q = _rope(q, *rope)
        k = _rope(k, *rope)
    return q[:, :, 0::2], q[:, :, 1::2], k[:, :, 0::2], k[:, :, 1::2], v


def _sdpa(q, k, v, scale):
    s = jnp.einsum('bqhd,bkhd->bhqk', q, k).astype(F32) * scale
    p = jax.nn.softmax(s, axis=-1).astype(v.dtype)
    return jnp.einsum('bhqk,bkhd->bqhd', p, v)


def _diff_sdpa(q1, q2, k1, k2, v, scale, lam):
    p1 = jax.nn.softmax(jnp.einsum('bqhd,bkhd->bhqk', q1, k1).astype(F32) * scale, axis=-1)
    p2 = jax.nn.softmax(jnp.einsum('bqhd,bkhd->bhqk', q2, k2).astype(F32) * scale, axis=-1)
    return jnp.einsum('bhqk,bkhd->bqhd', (p1 - lam * p2).astype(v.dtype), v)


def _by_query_blocks(fn, qs):
    b, s = qs[0].shape[:2]
    nb = s // Q_BLOCK
    blocks = tuple(q.reshape(b, nb, Q_BLOCK, *q.shape[2:]).swapaxes(0, 1) for q in qs)
    out = lax.map(lambda qb: fn(*qb), blocks)
    return out.swapaxes(0, 1).reshape(b, s, *out.shape[3:])


def _diff_out(o, subln, lam_init):
    o = _rmsnorm(o, subln) * (1.0 - lam_init)
    return o.reshape(o.shape[0], o.shape[1], DIFF_WIDTH)


def _token_mixing(n_lat, n_ctx, w_in, w_out, pool_w, pool_scale, mla_q_norm, mla_w_uq, mla_kv_norm,
                  mla_w_ukv, diff_lambda, diff_subln, lam_init, rope_mla, rope_diff, rows, with_ctx):
    b, s, _ = n_lat.shape
    p_lat = n_lat @ w_in
    p_ctx = n_ctx @ w_in
    s1, s2 = IN_POOL, IN_POOL + IN_MLA
    a_lat = _pool_mixer(p_lat[..., :s1], pool_w, pool_scale, rows)
    qb, kb, vb = _mla_qkv(p_lat[..., s1:s2], mla_q_norm, mla_w_uq, mla_kv_norm, mla_w_ukv, rope_mla)
    qbc, kbc, vbc = _mla_qkv(p_ctx[..., s1:s2], mla_q_norm, mla_w_uq, mla_kv_norm, mla_w_ukv, None)
    kb_all = jnp.concatenate([kbc, kb], axis=1)
    vb_all = jnp.concatenate([vbc, vb], axis=1)
    scale_b = (MLA_NOPE + MLA_ROPE) ** -0.5
    b_lat = _by_query_blocks(lambda q: _sdpa(q, kb_all, vb_all, scale_b), (qb,))
    lq1, lk1, lq2, lk2 = diff_lambda.astype(F32)
    lam = jnp.exp(jnp.sum(lq1 * lk1)) - jnp.exp(jnp.sum(lq2 * lk2)) + lam_init
    q1, q2, k1, k2, vc = _diff_qkv(p_lat[..., s2:], rope_diff)
    q1c, q2c, k1c, k2c, vcc = _diff_qkv(p_ctx[..., s2:], None)
    k1_all = jnp.concatenate([k1c, k1], axis=1)
    k2_all = jnp.concatenate([k2c, k2], axis=1)
    vc_all = jnp.concatenate([vcc, vc], axis=1)
    scale_c = DIFF_DIM ** -0.5
    c_lat = _by_query_blocks(lambda a1, a2: _diff_sdpa(a1, a2, k1_all, k2_all, vc_all, scale_c, lam), (q1, q2))
    y_lat = jnp.concatenate([a_lat, b_lat.reshape(b, s, MLA_WIDTH), _diff_out(c_lat, diff_subln, lam_init)],
                            axis=-1) @ w_out
    if not with_ctx:
        return y_lat, None
    bc, lc, _ = n_ctx.shape
    a_ctx = _pool_mixer(p_ctx[..., :s1], pool_w, pool_scale, None)
    b_ctx = _sdpa(qbc, kbc, vbc, scale_b).reshape(bc, lc, MLA_WIDTH)
    c_ctx = _diff_out(_diff_sdpa(q1c, q2c, k1c, k2c, vcc, scale_c, lam), diff_subln, lam_init)
    y_ctx = jnp.concatenate([a_ctx, b_ctx, c_ctx], axis=-1) @ w_out
    return y_lat, y_ctx


def setup_inputs(seed: int = 0) -> dict:
    key = jax.random.key(seed)
    ks = iter(jax.random.split(key, 32))

    def nrm(shape, scale):
        return jax.random.normal(next(ks), shape, F32) * scale

    def gain(shape):
        return 1.0 + nrm(shape, 0.02)

    L = DEPTH
    return {
        "x": nrm((BATCH, SEQ, D_MODEL), 1.0),
        "c": nrm((BATCH, D_MODEL), 1.0),
        "ctx": nrm((BATCH, CTX_LEN, D_MODEL), 1.0),
        "c_ctx": nrm((D_MODEL,), 1.0),
        "w_mod": nrm((L, D_MODEL, N_MOD * D_MODEL), 0.5 * D_MODEL ** -0.5),
        "b_mod": nrm((L, N_MOD * D_MODEL), 0.01),
        "ffn1_norm": gain((L, D_MODEL)),
        "ffn1_w1": nrm((L, D_MODEL, D_FF), D_MODEL ** -0.5),
        "ffn1_w3": nrm((L, D_MODEL, D_FF), D_MODEL ** -0.5),
        "ffn1_w2": nrm((L, D_FF, D_MODEL), D_FF ** -0.5),
        "mix_norm": gain((L, D_MODEL)),
        "w_in": nrm((L, D_MODEL, IN_WIDTH), D_MODEL ** -0.5),
        "w_out": nrm((L, MIX_WIDTH, D_MODEL), MIX_WIDTH ** -0.5),
        "pool_w": nrm((L, len(POOL_WINDOWS), POOL_GROUP, POOL_GROUP), POOL_GROUP ** -0.5),
        "pool_scale": 1.0 + nrm((L, POOL_WIDTH), 0.1),
        "mla_q_norm": gain((L, MLA_Q_RANK)),
        "mla_w_uq": nrm((L, MLA_Q_RANK, MLA_HEADS * (MLA_NOPE + MLA_ROPE)), MLA_Q_RANK ** -0.5),
        "mla_kv_norm": gain((L, MLA_KV_RANK)),
        "mla_w_ukv": nrm((L, MLA_KV_RANK, MLA_HEADS * (MLA_NOPE + MLA_V)), MLA_KV_RANK ** -0.5),
        "diff_lambda": nrm((L, 4, DIFF_DIM), 0.1),
        "diff_subln": gain((L, DIFF_V)),
        "ffn2_norm": gain((L, D_MODEL)),
        "ffn2_w1": nrm((L, D_MODEL, D_FF), D_MODEL ** -0.5),
        "ffn2_w3": nrm((L, D_MODEL, D_FF), D_MODEL ** -0.5),
        "ffn2_w2": nrm((L, D_FF, D_MODEL), D_FF ** -0.5),
        "final_norm": gain((D_MODEL,)),
    }


def reference(x, c, ctx, c_ctx, w_mod, b_mod, ffn1_norm, ffn1_w1, ffn1_w3, ffn1_w2, mix_norm, w_in, w_out,
              pool_w, pool_scale, mla_q_norm, mla_w_uq, mla_kv_norm, mla_w_ukv, diff_lambda, diff_subln,
              ffn2_norm, ffn2_w1, ffn2_w3, ffn2_w2, final_norm):
    b, seq, d = x.shape
    rows = seq // GRID_W
    rope_mla = _axial_rope(seq, MLA_ROPE)
    rope_diff = _axial_rope(seq, DIFF_DIM)
    sc = jax.nn.silu(c)
    scc = jax.nn.silu(c_ctx)
    h, hc = x, ctx
    for i in range(DEPTH):
        last = i == DEPTH - 1
        m = jnp.split((sc @ w_mod[i] + b_mod[i])[:, None, :], N_MOD, axis=-1)
        mc = jnp.split((scc @ w_mod[i] + b_mod[i])[None, None, :], N_MOD, axis=-1)
        h = h + 0.5 * m[2] * _swiglu(_modulate(_rmsnorm(h, ffn1_norm[i]), m[0], m[1]),
                                     ffn1_w1[i], ffn1_w3[i], ffn1_w2[i])
        hc = hc + 0.5 * mc[2] * _swiglu(_modulate(_rmsnorm(hc, ffn1_norm[i]), mc[0], mc[1]),
                                        ffn1_w1[i], ffn1_w3[i], ffn1_w2[i])
        lam_init = 0.8 - 0.6 * math.exp(-0.3 * i)
        n_lat = _modulate(_rmsnorm(h, mix_norm[i]), m[3], m[4])
        n_ctx = _modulate(_rmsnorm(hc, mix_norm[i]), mc[3], mc[4])
        y, yc = _token_mixing(n_lat, n_ctx, w_in[i], w_out[i], pool_w[i], pool_scale[i], mla_q_norm[i],
                              mla_w_uq[i], mla_kv_norm[i], mla_w_ukv[i], diff_lambda[i], diff_subln[i],
                              lam_init, rope_mla, rope_diff, rows, not last)
        h = h + m[5] * y
        h = h + 0.5 * m[8] * _swiglu(_modulate(_rmsnorm(h, ffn2_norm[i]), m[6], m[7]),
                                     ffn2_w1[i], ffn2_w3[i], ffn2_w2[i])
        if not last:
            hc = hc + mc[5] * yc
            hc = hc + 0.5 * mc[8] * _swiglu(_modulate(_rmsnorm(hc, ffn2_norm[i]), mc[6], mc[7]),
                                            ffn2_w1[i], ffn2_w3[i], ffn2_w2[i])
    return _rmsnorm(h, final_norm)
```

```cpp
#include <hip/hip_runtime.h>
#include <hip/hip_cooperative_groups.h>
#include <cstdio>
namespace cg = cooperative_groups;

#define LAS __attribute__((address_space(3)))
typedef unsigned short bf16_t;
typedef short bf16x8 __attribute__((ext_vector_type(8)));
typedef float f32x4 __attribute__((ext_vector_type(4)));
typedef float f32x2 __attribute__((ext_vector_type(2)));
typedef unsigned u32x4 __attribute__((ext_vector_type(4)));
typedef unsigned u32x2 __attribute__((ext_vector_type(2)));

constexpr int DM = 1024, NB = 16, SEQ = 4096, DEPTH = 4, CTXL = 256, DFF = 2816;
constexpr int NLAT = NB * SEQ, NCTX = NB * CTXL, NT = NLAT + NCTX, KVL = SEQ + CTXL;
constexpr int INW = 2464;
constexpr float EPS = 1e-6f;
constexpr float LOG2E = 1.4426950408889634f;
constexpr int LDS_BYTES = 131072 + 8 * 3072;
#ifndef MULTI_LAUNCH
#define MULTI_LAUNCH 0
#endif

struct Params {
    const float *x, *c, *ctx, *c_ctx, *w_mod, *b_mod, *ffn1_norm, *ffn1_w1, *ffn1_w3, *ffn1_w2, *mix_norm, *w_in, *w_out, *pool_w, *pool_scale,
        *mla_q_norm, *mla_w_uq, *mla_kv_norm, *mla_w_ukv, *diff_lambda, *diff_subln, *ffn2_norm, *ffn2_w1, *ffn2_w3, *ffn2_w2, *final_norm;
    float* out;
    float* H; bf16_t* XN; bf16_t* G; float* U; bf16_t* CQ; bf16_t* CKV; float* SSQ; bf16_t* QD; bf16_t* KD; bf16_t* VTD; bf16_t* QM; bf16_t* KM; bf16_t* VTM;
    bf16_t *Bt13a, *Bt2a, *Bt13b, *Bt2b, *Btin, *Btout, *Btuq, *Btukv, *Btpool;
    float *MODS, *ROPED, *ROPEM;
    float* P4;
    unsigned* BAR;
    int ph_lo, ph_hi;
};

typedef __bf16 bf16x2_t __attribute__((ext_vector_type(2)));
__device__ __forceinline__ unsigned cvt_pk_bf16(float lo, float hi) { const f32x2 v = {lo, hi}; const bf16x2_t b = __builtin_convertvector(v, bf16x2_t); return __builtin_bit_cast(unsigned, b); }
__device__ __forceinline__ bf16_t f2bf(float v) { return (bf16_t)(cvt_pk_bf16(v, 0.f) & 0xffffu); }
__device__ __forceinline__ int opaque_tid() { int t = threadIdx.x; asm volatile("" : "+v"(t)); return t; }
__device__ __forceinline__ float shx(float v, int mask, int lane) { return __int_as_float(__builtin_amdgcn_ds_bpermute((lane ^ mask) << 2, __float_as_int(v))); }
__device__ __forceinline__ float fast_exp2(float x) { return __builtin_amdgcn_exp2f(x); }
__device__ __forceinline__ float fast_rcp(float x) { return __builtin_amdgcn_rcpf(x); }

namespace pg8 {
constexpr int BM = 256, BK = 64, HALF = 128, HTB = HALF * BK * 2, STAGE_BYTES = 8 * HTB, NXCD = 8, WGM = 2;
__host__ __device__ __forceinline__ int lds_byte(int r, int c) { const int st = (r >> 4) * 2 + (c >> 5), rr = r & 15, cc = c & 31, ob = rr * 64 + cc * 2; return st * 1024 + (ob ^ (((ob >> 9) & 1) << 5)); }
__host__ __device__ __forceinline__ void stage_rc(int b, int& R, int& C) { const int st = b / 1024, sb = b % 1024, swz = sb ^ (((sb >> 9) & 1) << 5); R = (st >> 1) * 16 + swz / 64; C = (st & 1) * 32 + (swz % 64) / 2; }
struct Unit { int pm, pn; };
struct Gemm { const bf16_t* A; const bf16_t* Bt; int M, N, K, ld; };
struct StaticOrder {
    int nM, nN, nwg, G, c, fixed;
    __device__ void init(int M, int N, int G_, int c_) { nM = M / BM; nN = N / BM; nwg = nM * nN; G = G_; c = c_; fixed = -1; }
    __device__ bool next(int i, Unit& u) const {
        if (fixed >= 0) { if (i > 0) return false; u.pm = fixed / nN; u.pn = fixed % nN; return true; }
        const long L = (long)i * G + c; if (L >= nwg) return false;
        int wgid = (int)L; { const int q = nwg / NXCD, r = nwg % NXCD, xcd = wgid % NXCD, off = wgid / NXCD; wgid = (xcd < r ? xcd * (q + 1) : r * (q + 1) + (xcd - r) * q) + off; }
        const int nig = WGM * nN, gid = wgid / nig, fm = gid * WGM, gsz = (nM - fm) < WGM ? (nM - fm) : WGM;
        u.pm = fm + ((wgid % nig) % gsz); u.pn = (wgid % nig) / gsz; return true;
    }
};
template <class Epi>
__device__ __forceinline__ void gemm_phase(LAS unsigned char* lds, const Gemm g, const StaticOrder& S, const Epi& E) {
    const int tid = opaque_tid(), wid = __builtin_amdgcn_readfirstlane(tid >> 6), lane = tid & 63, wr = wid >> 2, wc = wid & 3, fr = lane & 15, fq = lane >> 4;
    const int K = g.K, LD = g.ld, nt = K / BK;
    unsigned voffA[2];
#pragma unroll
    for (int i = 0; i < 2; ++i) { int R, C; stage_rc(tid * 16 + i * 8192, R, C); voffA[i] = (unsigned)(R * LD + C) * 2u; }
    const size_t kstep = (size_t)(BK * 2);
    const size_t hstep = (size_t)HALF * LD * 2;
    const size_t tstep = 2 * hstep;
    const unsigned ldsw = (unsigned)wid * 1024u;
    const int aoff = lds_byte(wr * 64 + fr, fq * 8), boff = lds_byte(wc * 32 + fr, fq * 8);
#define PG8_SA(b, h) (((b) * 2 + (h)) * HTB)
#define PG8_SB(b, h) ((4 + (b) * 2 + (h)) * HTB)
#define PG8_STAGE(bufoff, gbase, voff) do { _Pragma("unroll") for (int _i = 0; _i < 2; ++_i) \
        __builtin_amdgcn_global_load_lds((const unsigned*)((const char*)(gbase) + (voff)[_i]), (LAS unsigned*)(lds + (bufoff) + ldsw + _i * 8192), 16, 0, 0); } while (0)
#define PG8_LDA(dst, b, h) do { _Pragma("unroll") for (int m = 0; m < 4; ++m) _Pragma("unroll") for (int k = 0; k < 2; ++k) dst[m][k] = *(const LAS bf16x8*)(lds + PG8_SA(b, h) + aoff + m * 2048 + k * 1024); } while (0)
#define PG8_LDB(dst, b, h) do { _Pragma("unroll") for (int n = 0; n < 2; ++n) _Pragma("unroll") for (int k = 0; k < 2; ++k) dst[n][k] = *(const LAS bf16x8*)(lds + PG8_SB(b, h) + boff + n * 2048 + k * 1024); } while (0)
#define PG8_MMA(ai, bj, At, Bt) do { __builtin_amdgcn_s_setprio(1); _Pragma("unroll") for (int m = 0; m < 4; ++m) _Pragma("unroll") for (int n = 0; n < 2; ++n) _Pragma("unroll") for (int k = 0; k < 2; ++k) \
        acc[ai][bj][m][n] = __builtin_amdgcn_mfma_f32_16x16x32_bf16(Bt[n][k], At[m][k], acc[ai][bj][m][n], 0, 0, 0); __builtin_amdgcn_s_setprio(0); } while (0)
#define PG8_WAIT_V(n) asm volatile("s_waitcnt vmcnt(" #n ")" ::: "memory")
#define PG8_WAIT_L(n) asm volatile("s_waitcnt lgkmcnt(" #n ")" ::: "memory")
#define PG8_BAR __builtin_amdgcn_s_barrier()
#define PG8_SCHED __builtin_amdgcn_sched_barrier(0)
    Unit cur, nxt; int ui = 0;
    if (!S.next(0, cur)) return;
    f32x4 acc[2][2][4][2];
#pragma unroll
    for (int a = 0; a < 2; ++a)
#pragma unroll
        for (int b = 0; b < 2; ++b)
#pragma unroll
            for (int m = 0; m < 4; ++m)
#pragma unroll
                for (int n = 0; n < 2; ++n) acc[a][b][m][n] = (f32x4){0.f, 0.f, 0.f, 0.f};
    bf16x8 At[4][2], B0[2][2], B1[2][2];
    const char* cA = (const char*)g.A + (size_t)cur.pm * tstep; const char* cB = (const char*)g.Bt + (size_t)cur.pn * tstep;
    PG8_STAGE(PG8_SB(0, 0), cB, voffA); PG8_STAGE(PG8_SA(0, 0), cA, voffA); PG8_STAGE(PG8_SB(0, 1), cB + hstep, voffA); PG8_STAGE(PG8_SA(0, 1), cA + hstep, voffA);
    if (wr == 1) PG8_BAR;
    PG8_WAIT_V(4); PG8_BAR;
    PG8_STAGE(PG8_SB(1, 0), cB + kstep, voffA); PG8_STAGE(PG8_SA(1, 0), cA + kstep, voffA); PG8_STAGE(PG8_SB(1, 1), cB + hstep + kstep, voffA);
    PG8_WAIT_V(6); PG8_BAR;
    for (;;) {
        const bool has_next = S.next(ui + 1, nxt);
        const char* nA = has_next ? (const char*)g.A + (size_t)nxt.pm * tstep : cA; const char* nB = has_next ? (const char*)g.Bt + (size_t)nxt.pn * tstep : cB;
        for (int t = 0; t < nt; t += 2) {
            const bool last = (t == nt - 2);
            const char* a1 = cA + (size_t)(t + 1) * kstep;
            const char* a2 = last ? nA : cA + (size_t)(t + 2) * kstep; const char* b2 = last ? nB : cB + (size_t)(t + 2) * kstep;
            const char* a3 = a2 + kstep; const char* b3 = b2 + kstep;
            PG8_LDB(B0, 0, 0); PG8_SCHED; PG8_LDA(At, 0, 0); PG8_STAGE(PG8_SA(1, 1), a1 + hstep, voffA);
            PG8_WAIT_L(8); PG8_BAR; PG8_WAIT_L(0); PG8_MMA(0, 0, At, B0); PG8_BAR; PG8_SCHED;
            PG8_LDB(B1, 0, 1); PG8_STAGE(PG8_SB(0, 0), b2, voffA);
            PG8_BAR; PG8_WAIT_L(0); PG8_MMA(0, 1, At, B1); PG8_BAR;
            PG8_LDA(At, 0, 1); PG8_STAGE(PG8_SA(0, 0), a2, voffA);
            PG8_BAR; PG8_WAIT_L(0); PG8_MMA(1, 0, At, B0); PG8_BAR; PG8_SCHED;
            PG8_STAGE(PG8_SB(0, 1), b2 + hstep, voffA);
            PG8_WAIT_V(6); PG8_BAR; PG8_MMA(1, 1, At, B1); PG8_BAR;
            PG8_LDB(B0, 1, 0); PG8_SCHED; PG8_LDA(At, 1, 0); PG8_STAGE(PG8_SA(0, 1), a2 + hstep, voffA);
            PG8_WAIT_L(8); PG8_BAR; PG8_WAIT_L(0); PG8_MMA(0, 0, At, B0); PG8_BAR; PG8_SCHED;
            PG8_LDB(B1, 1, 1); PG8_STAGE(PG8_SB(1, 0), b3, voffA);
            PG8_BAR; PG8_WAIT_L(0); PG8_MMA(0, 1, At, B1); PG8_BAR;
            PG8_LDA(At, 1, 1); PG8_STAGE(PG8_SA(1, 0), a3, voffA);
            PG8_BAR; PG8_WAIT_L(0); PG8_MMA(1, 0, At, B0); PG8_BAR; PG8_SCHED;
            PG8_STAGE(PG8_SB(1, 1), b3 + hstep, voffA);
            PG8_WAIT_V(6); PG8_BAR; PG8_MMA(1, 1, At, B1); PG8_BAR;
        }
        E(acc, cur, wr, wc, fr, fq);
        if (!has_next) break;
#pragma unroll
        for (int a = 0; a < 2; ++a)
#pragma unroll
            for (int b = 0; b < 2; ++b)
#pragma unroll
                for (int m = 0; m < 4; ++m)
#pragma unroll
                    for (int n = 0; n < 2; ++n) acc[a][b][m][n] = (f32x4){0.f, 0.f, 0.f, 0.f};
        cur = nxt; cA = nA; cB = nB; ++ui;
    }
    PG8_WAIT_V(0);
    if (wr == 0) PG8_BAR;
    PG8_BAR;
#undef PG8_SA
#undef PG8_SB
#undef PG8_STAGE
#undef PG8_LDA
#undef PG8_LDB
#undef PG8_MMA
#undef PG8_WAIT_V
#undef PG8_WAIT_L
#undef PG8_BAR
#undef PG8_SCHED
}
}
using pg8::Unit;

__device__ __forceinline__ int slot_of_L(int L) { return (((L >> 3) & 1) << 7) | (((L >> 6) & 3) << 5) | (((L >> 2) & 1) << 4) | (((L >> 4) & 3) << 2) | (L & 3); }
__device__ __forceinline__ int rope_lambda(int dd, int half) { const int hf = dd / half, i = dd % half; return 16 * (i >> 3) + 8 * hf + (i & 7); }
__device__ __forceinline__ int keypos_of(int key) { return (key & ~12) | ((key & 4) << 1) | ((key & 8) >> 1); }
enum { KNAT = 0, KSWI = 1, KIN = 2, KUQ = 3, KUKV = 4 };
__device__ __forceinline__ int dstrow(int kind, int which, int c) {
    if (kind == KNAT) return c;
    if (kind == KSWI) { const int pn = c >> 7, cg = c & 127; return pn * 256 + ((((cg >> 2) & 1) << 7) | (((cg >> 5) & 3) << 5) | (which << 4) | (((cg >> 3) & 3) << 2) | (cg & 3)); }
    if (kind == KIN) {
        int tile, L;
        if (c < 256) { tile = 0; L = c; }
        else if (c < 640) { const int q = c - 256; tile = 1 + (q >> 8); L = q & 255; }
        else if (c < 896) { tile = 3; L = c - 640; }
        else if (c < 928) { tile = 2; L = 128 + rope_lambda(c - 896, 16); }
        else if (c < 1952) { int qq = c - 928; const int isk = qq >= 512 ? 1 : 0; qq &= 511; const int hd = qq >> 6; tile = 4 + 2 * isk + (hd >> 2); L = 64 * (hd & 3) + rope_lambda(qq & 63, 32); }
        else { const int vv = c - 1952; tile = 8 + (vv >> 8); L = vv & 255; }
        return tile * 256 + slot_of_L(L);
    }
    if (kind == KUQ) { const int head = c / 96, dd = c % 96; const int Lh = dd < 64 ? dd : 64 + rope_lambda(dd - 64, 16); const int L = 128 * (head & 1) + Lh; return (head >> 1) * 256 + slot_of_L(L); }
      { const int head = c >> 7, dd = c & 127; const int tile = dd >> 6; const int L = 64 * head + (dd & 63); return tile * 256 + slot_of_L(L); }
}

struct EpiSwiGLU {
    bf16_t* __restrict__ G;
    __device__ __forceinline__ void operator()(const f32x4 (&acc)[2][2][4][2], const Unit& u, int wr, int wc, int fr_, int fq_) const {
        const int tq_ = opaque_tid(); const int fr = tq_ & 15, fq = (tq_ >> 4) & 3; (void)fr_; (void)fq_;
        const int row0 = u.pm * 256 + wr * 64 + fr, col0 = u.pn * 128 + wc * 32 + fq * 8;
#pragma unroll
        for (int ai = 0; ai < 2; ++ai)
#pragma unroll
            for (int m = 0; m < 4; ++m) {
                float o[8];
#pragma unroll
                for (int bj = 0; bj < 2; ++bj)
#pragma unroll
                    for (int j = 0; j < 4; ++j) { const float a = acc[ai][bj][m][0][j], b = acc[ai][bj][m][1][j]; o[bj * 4 + j] = a * fast_rcp(1.f + fast_exp2(-a * LOG2E)) * b; }
                u32x4 w; w.x = cvt_pk_bf16(o[0], o[1]); w.y = cvt_pk_bf16(o[2], o[3]); w.z = cvt_pk_bf16(o[4], o[5]); w.w = cvt_pk_bf16(o[6], o[7]);
                *(u32x4*)(G + (size_t)(row0 + ai * 128 + m * 16) * DFF + col0) = w;
            }
    }
};
struct EpiResid {
    const float* Hin; const float* Hin_ctx; float* Hout; const float* gate_l; float sc;
    __device__ __forceinline__ void operator()(const f32x4 (&acc)[2][2][4][2], const Unit& u, int wr, int wc, int fr_, int fq_) const {
        const int tq_ = opaque_tid(); const int fr = tq_ & 15, fq = (tq_ >> 4) & 3; (void)fr_; (void)fq_;
        const int bi = u.pm < 256 ? (u.pm >> 4) : 16;
        const int row0 = u.pm * 256 + wr * 64 + fr, col0 = u.pn * 256 + wc * 32 + 4 * fq;
        const float* gate = gate_l + (size_t)bi * 9216 + col0;
        const float* hin = u.pm < 256 ? Hin : Hin_ctx;
        f32x4 gv[2][2];
#pragma unroll
        for (int bj = 0; bj < 2; ++bj)
#pragma unroll
            for (int n = 0; n < 2; ++n) gv[bj][n] = *(const f32x4*)(gate + bj * 128 + n * 16) * sc;
        f32x4 hb[3][2][2];
#define RES_LOAD(g_, st_) { const size_t base_ = (size_t)(row0 + ((g_) >> 2) * 128 + ((g_) & 3) * 16) * DM + col0; \
            _Pragma("unroll") for (int bj = 0; bj < 2; ++bj) _Pragma("unroll") for (int n = 0; n < 2; ++n) hb[st_][bj][n] = *(const f32x4*)(hin + base_ + bj * 128 + n * 16); }
        RES_LOAD(0, 0); RES_LOAD(1, 1);
#pragma unroll
        for (int g = 0; g < 8; ++g) {
            if (g + 2 < 8) { RES_LOAD(g + 2, (g + 2) % 3); }
            const int ai = g >> 2, m = g & 3;
            const size_t base = (size_t)(row0 + ai * 128 + m * 16) * DM + col0;
#pragma unroll
            for (int bj = 0; bj < 2; ++bj)
#pragma unroll
                for (int n = 0; n < 2; ++n) *(f32x4*)(Hout + base + bj * 128 + n * 16) = hb[g % 3][bj][n] + gv[bj][n] * acc[ai][bj][m][n];
        }
#undef RES_LOAD
    }
};
struct EpiPartial {
    float* __restrict__ P;
    __device__ __forceinline__ void operator()(const f32x4 (&acc)[2][2][4][2], const Unit& u, int wr, int wc, int fr_, int fq_) const {
        const int tq_ = opaque_tid(); const int fr = tq_ & 15, fq = (tq_ >> 4) & 3; (void)fr_; (void)fq_;
        const int row0 = u.pm * 256 + wr * 64 + fr, col0 = u.pn * 256 + wc * 32 + 4 * fq;
#pragma unroll
        for (int ai = 0; ai < 2; ++ai)
#pragma unroll
            for (int m = 0; m < 4; ++m) {
                float* hp = P + (size_t)(row0 + ai * 128 + m * 16) * DM + col0;
#pragma unroll
                for (int bj = 0; bj < 2; ++bj)
#pragma unroll
                    for (int n = 0; n < 2; ++n) *(f32x4*)(hp + bj * 128 + n * 16) = acc[ai][bj][m][n];
            }
    }
};
__device__ __forceinline__ void store16bf(bf16_t* dst, const float (&v)[16]) {
    u32x4 w0, w1;
    w0.x = cvt_pk_bf16(v[0], v[1]); w0.y = cvt_pk_bf16(v[2], v[3]); w0.z = cvt_pk_bf16(v[4], v[5]); w0.w = cvt_pk_bf16(v[6], v[7]);
    w1.x = cvt_pk_bf16(v[8], v[9]); w1.y = cvt_pk_bf16(v[10], v[11]); w1.z = cvt_pk_bf16(v[12], v[13]); w1.w = cvt_pk_bf16(v[14], v[15]);
    *(u32x4*)dst = w0; *(u32x4*)(dst + 8) = w1;
}
__device__ __forceinline__ void rope16(float (&v)[16], const float* tab) {
#pragma unroll
    for (int q = 0; q < 4; ++q) {
        const f32x4 cs = *(const f32x4*)(tab + q * 4);
        { const float x1 = v[2 * q], x2 = v[8 + 2 * q]; v[2 * q] = x1 * cs[0] - x2 * cs[1]; v[8 + 2 * q] = x1 * cs[1] + x2 * cs[0]; }
        { const float x1 = v[2 * q + 1], x2 = v[9 + 2 * q]; v[2 * q + 1] = x1 * cs[2] - x2 * cs[3]; v[9 + 2 * q] = x1 * cs[3] + x2 * cs[2]; }
    }
}
__device__ __forceinline__ void store_vt(LAS unsigned char* tw, const float (&v)[16], int fr, int fq, bf16_t* vt) {
    const int pos = ((fr & 4) << 1) | ((fr & 8) >> 1) | (fr & 3);
#pragma unroll
    for (int e = 0; e < 16; ++e) *(LAS bf16_t*)(tw + (16 * fq + e) * 48 + pos * 2) = f2bf(v[e]);
    const int lane = fq * 16 + fr;
#pragma unroll
    for (int i = 0; i < 2; ++i) { const int ch = lane + 64 * i, col = ch >> 1, half = ch & 1;
        const u32x4 w = *(const LAS u32x4*)(tw + col * 48 + half * 16);
        *(u32x4*)(vt + (size_t)col * KVL + half * 8) = w; }
}
struct EpiIn {
    float* __restrict__ U; bf16_t* __restrict__ CQ; bf16_t* __restrict__ CKV; float* __restrict__ SSQ; bf16_t* __restrict__ QD; bf16_t* __restrict__ KD; bf16_t* __restrict__ VTD; bf16_t* __restrict__ KM; const float* __restrict__ ROPED; const float* __restrict__ ROPEM; LAS unsigned char* tl;
    __device__ __forceinline__ void operator()(const f32x4 (&acc)[2][2][4][2], const Unit& u, int wr, int wc, int fr_, int fq_) const {
        const int tq_ = opaque_tid(); const int fr = tq_ & 15, fq = (tq_ >> 4) & 3; (void)fr_; (void)fq_;
        const int pn = u.pn, L0 = 64 * wc + 16 * fq;
#pragma unroll
        for (int ai = 0; ai < 2; ++ai)
#pragma unroll
            for (int m = 0; m < 4; ++m) {
                const int row = u.pm * 256 + ai * 128 + wr * 64 + m * 16 + fr;
                const bool lat = u.pm < 256;
                const int b = lat ? (row >> 12) : ((row - NLAT) >> 8);
                const int key = lat ? (CTXL + (row & 4095)) : ((row - NLAT) & 255);
                const int pos = row & 4095;
                float v[16];
#pragma unroll
                for (int bj = 0; bj < 2; ++bj)
#pragma unroll
                    for (int n = 0; n < 2; ++n)
#pragma unroll
                        for (int j = 0; j < 4; ++j) v[8 * bj + 4 * n + j] = acc[ai][bj][m][n][j];
                if (pn == 0) {
                    float* d = U + (size_t)row * 256 + L0;
#pragma unroll
                    for (int q = 0; q < 4; ++q) *(f32x4*)(d + 4 * q) = (f32x4){v[4 * q], v[4 * q + 1], v[4 * q + 2], v[4 * q + 3]};
                } else if (pn <= 3) {
                    if (pn == 2 && wc >= 2) {
                        if (wc == 2 && fq < 2) {
                            if (lat) rope16(v, ROPEM + ((size_t)pos * 16 + 8 * fq) * 2);
#pragma unroll
                            for (int h = 0; h < 4; ++h) store16bf(KM + ((size_t)(b * 4 + h) * KVL + key) * 96 + 64 + 16 * fq, v);
                        }
                    } else {
                        float s = 0.f;
#pragma unroll
                        for (int e = 0; e < 16; ++e) s += v[e] * v[e];
                        { const int ln = fq * 16 + fr; s += shx(s, 16, ln); s += shx(s, 32, ln); }
                        if (pn < 3) { store16bf(CQ + (size_t)row * 384 + (pn - 1) * 256 + L0, v); if (fq == 0) SSQ[(size_t)row * 16 + (pn - 1) * 4 + wc] = s; }
                        else { store16bf(CKV + (size_t)row * 256 + L0, v); if (fq == 0) SSQ[(size_t)row * 16 + 8 + wc] = s; }
                    }
                } else if (pn <= 7) {
                    const int hd = 4 * ((pn - 4) & 1) + wc;
                    if (lat) rope16(v, ROPED + ((size_t)pos * 32 + 8 * fq) * 2);
                    if (pn <= 5) {
                        const float qs = 0.125f * LOG2E;
#pragma unroll
                        for (int e = 0; e < 16; ++e) v[e] *= qs;
                        store16bf(QD + (size_t)row * 512 + hd * 64 + 16 * fq, v);
                    } else store16bf(KD + ((size_t)(b * 8 + hd) * KVL + key) * 64 + 16 * fq, v);
                } else {
                    const int h = 2 * (pn - 8) + (wc >> 1);
                    store_vt(tl + (wr * 4 + wc) * 3072, v, fr, fq, VTD + ((size_t)(b * 4 + h) * 128 + 64 * (wc & 1)) * KVL + (key - fr));
                }
            }
    }
};
struct EpiQup {
    const float* __restrict__ SSQ; bf16_t* __restrict__ QM; const float* __restrict__ ROPEM;
    __device__ __forceinline__ void operator()(const f32x4 (&acc)[2][2][4][2], const Unit& u, int wr, int wc, int fr_, int fq_) const {
        const int tq_ = opaque_tid(); const int fr = tq_ & 15, fq = (tq_ >> 4) & 3; (void)fr_; (void)fq_;
        const int head = 2 * u.pn + (wc >> 1), part = wc & 1;
        if (part == 1 && fq >= 2) return;
#pragma unroll
        for (int ai = 0; ai < 2; ++ai)
#pragma unroll
            for (int m = 0; m < 4; ++m) {
                const int row = u.pm * 256 + ai * 128 + wr * 64 + m * 16 + fr;
                const f32x4 s4 = *(const f32x4*)(SSQ + (size_t)row * 16); const f32x2 s2 = *(const f32x2*)(SSQ + (size_t)row * 16 + 4);
                const float ss = (s4[0] + s4[1]) + (s4[2] + s4[3]) + (s2[0] + s2[1]);
                const float sc = rsqrtf(ss * (1.f / 384.f) + EPS) * (0.10206207261596577f * LOG2E);
                float v[16];
#pragma unroll
                for (int bj = 0; bj < 2; ++bj)
#pragma unroll
                    for (int n = 0; n < 2; ++n)
#pragma unroll
                        for (int j = 0; j < 4; ++j) v[8 * bj + 4 * n + j] = acc[ai][bj][m][n][j] * sc;
                if (part == 1 && u.pm < 256) rope16(v, ROPEM + ((size_t)(row & 4095) * 16 + 8 * fq) * 2);
                store16bf(QM + (size_t)row * 384 + head * 96 + 64 * part + 16 * fq, v);
            }
    }
};
struct EpiKVup {
    const float* __restrict__ SSQ; bf16_t* __restrict__ KM; bf16_t* __restrict__ VTM; LAS unsigned char* tl;
    __device__ __forceinline__ void operator()(const f32x4 (&acc)[2][2][4][2], const Unit& u, int wr, int wc, int fr_, int fq_) const {
        const int tq_ = opaque_tid(); const int fr = tq_ & 15, fq = (tq_ >> 4) & 3; (void)fr_; (void)fq_;
#pragma unroll
        for (int ai = 0; ai < 2; ++ai)
#pragma unroll
            for (int m = 0; m < 4; ++m) {
                const int row = u.pm * 256 + ai * 128 + wr * 64 + m * 16 + fr;
                const bool lat = u.pm < 256;
                const int b = lat ? (row >> 12) : ((row - NLAT) >> 8);
                const int key = lat ? (CTXL + (row & 4095)) : ((row - NLAT) & 255);
                const f32x4 s4 = *(const f32x4*)(SSQ + (size_t)row * 16 + 8);
                const float sc = rsqrtf(((s4[0] + s4[1]) + (s4[2] + s4[3])) * (1.f / 256.f) + EPS);
                float v[16];
#pragma unroll
                for (int bj = 0; bj < 2; ++bj)
#pragma unroll
                    for (int n = 0; n < 2; ++n)
#pragma unroll
                        for (int j = 0; j < 4; ++j) v[8 * bj + 4 * n + j] = acc[ai][bj][m][n][j] * sc;
                if (u.pn == 0) store16bf(KM + ((size_t)(b * 4 + wc) * KVL + key) * 96 + 16 * fq, v);
                else {
                    store_vt(tl + (wr * 4 + wc) * 3072, v, fr, fq, VTM + ((size_t)(b * 4 + wc) * 64) * KVL + (key - fr));
                }
            }
    }
};

__constant__ float c_invfreq[24] = {1.000000000e+00f, 5.623413324e-01f, 3.162277639e-01f, 1.778279394e-01f, 1.000000015e-01f, 5.623413250e-02f, 3.162277490e-02f, 1.778279431e-02f, 9.999999776e-03f, 5.623413250e-03f, 3.162277630e-03f, 1.778279431e-03f, 1.000000047e-03f, 5.623413017e-04f, 3.162277571e-04f, 1.778279402e-04f, 1.000000000e+00f, 3.162277639e-01f, 1.000000015e-01f, 3.162277490e-02f, 9.999999776e-03f, 3.162277630e-03f, 1.000000047e-03f, 3.162277571e-04f};
__device__ void phase_init(const Params& p, LAS unsigned char* lds) {
    const int tid = opaque_tid();
    const size_t gtid = (size_t)blockIdx.x * 512 + tid, gsz = (size_t)gridDim.x * 512;
    for (size_t i = gtid; i < (size_t)4096 * 48; i += gsz) {
        int pos, a, use_row; float* dst;
        if (i < (size_t)4096 * 32) { pos = (int)(i >> 5); const int ii = (int)(i & 31); a = ii & 15; use_row = ii < 16; dst = p.ROPED + 2 * i; }
        else { const size_t j = i - (size_t)4096 * 32; pos = (int)(j >> 4); const int ii = (int)(j & 15); a = 16 + (ii & 7); use_row = ii < 8; dst = p.ROPEM + 2 * j; }
        const float ang = (float)(use_row ? (pos >> 6) : (pos & 63)) * c_invfreq[a];
        const float kq = rintf(ang * 0.636619772f);
        float r = fmaf(-kq, 1.570770263671875f, ang); r = fmaf(-kq, 2.6063062250614166e-05f, r); r = fmaf(-kq, 6.077094383272197e-11f, r);
        const float r2 = r * r;
        const float sn = r * (1.f + r2 * (-1.6666667e-1f + r2 * (8.3333333e-3f + r2 * (-1.9841270e-4f + r2 * 2.7557319e-6f))));
        const float cs = 1.f + r2 * (-0.5f + r2 * (4.1666667e-2f + r2 * (-1.3888889e-3f + r2 * (2.4801587e-5f + r2 * (-2.7557319e-7f)))));
        const int qd = ((int)kq) & 3;
        dst[0] = qd == 0 ? cs : qd == 1 ? -sn : qd == 2 ? -cs : sn;
        dst[1] = qd == 0 ? sn : qd == 1 ? cs : qd == 2 ? -sn : -cs;
    }
    LAS float* sct = (LAS float*)lds;
    LAS float* red = (LAS float*)(lds + 81920);
    for (int i = tid; i < 17 * 1024; i += 512) { const int bi = i >> 10, k = i & 1023; const float cv = bi < 16 ? p.c[bi * 1024 + k] : p.c_ctx[k]; sct[k * 20 + bi] = cv / (1.f + __expf(-cv)); }
    __syncthreads();
    const int col = tid & 127, kg = tid >> 7;
    for (int u = blockIdx.x; u < DEPTH * 72; u += gridDim.x) {
        const int l = u / 72, n0 = (u % 72) * 128;
        const float* w = p.w_mod + (size_t)l * 1024 * 9216 + n0 + col;
        float a[17];
#pragma unroll
        for (int q = 0; q < 17; ++q) a[q] = 0.f;
#pragma unroll 4
        for (int k = kg * 256; k < kg * 256 + 256; ++k) {
            const float wv = w[(size_t)k * 9216];
            const f32x4 s0 = *(const LAS f32x4*)(sct + k * 20), s1 = *(const LAS f32x4*)(sct + k * 20 + 4), s2 = *(const LAS f32x4*)(sct + k * 20 + 8), s3 = *(const LAS f32x4*)(sct + k * 20 + 12);
            const float s16 = sct[k * 20 + 16];
#pragma unroll
            for (int q = 0; q < 4; ++q) { a[q] += s0[q] * wv; a[4 + q] += s1[q] * wv; a[8 + q] += s2[q] * wv; a[12 + q] += s3[q] * wv; }
            a[16] += s16 * wv;
        }
#pragma unroll
        for (int q = 0; q < 17; ++q) red[(kg * 17 + q) * 128 + col] = a[q];
        __syncthreads();
        for (int i = tid; i < 17 * 128; i += 512) { const int bi = i >> 7, cc = i & 127;
            const float s = (red[(0 * 17 + bi) * 128 + cc] + red[(1 * 17 + bi) * 128 + cc]) + (red[(2 * 17 + bi) * 128 + cc] + red[(3 * 17 + bi) * 128 + cc]);
            p.MODS[((size_t)l * 17 + bi) * 9216 + n0 + cc] = s + p.b_mod[(size_t)l * 9216 + n0 + cc]; }
        __syncthreads();
    }
}

__device__ void phase_norm(const float* H, const float* Hctx, int nrows, const float* gw, const float* mods_l, int shift_idx, int scale_idx, bf16_t* outb, float* outf,
                           const float* P4, const float* pgate, float psc, float* Hw) {
    const int tid = opaque_tid(); const int wid = tid >> 6, lane = tid & 63;
    for (int row = blockIdx.x * 8 + wid; row < nrows; row += gridDim.x * 8) {
        const float* hr = (row < NLAT ? H : Hctx) + (size_t)row * DM + lane * 4;
        f32x4 v[4]; float ss = 0.f;
#pragma unroll
        for (int q = 0; q < 4; ++q) v[q] = *(const f32x4*)(hr + q * 256);
        if (P4 && row >= NLAT) {
            const float* pr = P4 + (size_t)(row - NLAT) * DM + lane * 4;
#pragma unroll
            for (int q = 0; q < 4; ++q) { const f32x4 s4 = (*(const f32x4*)(pr + q * 256) + *(const f32x4*)(pr + (size_t)NCTX * DM + q * 256)) + (*(const f32x4*)(pr + (size_t)2 * NCTX * DM + q * 256) + *(const f32x4*)(pr + (size_t)3 * NCTX * DM + q * 256));
                v[q] += (*(const f32x4*)(pgate + lane * 4 + q * 256) * psc) * s4; *(f32x4*)(Hw + (size_t)row * DM + lane * 4 + q * 256) = v[q]; }
        }
#pragma unroll
        for (int q = 0; q < 4; ++q) ss += (v[q][0] * v[q][0] + v[q][1] * v[q][1]) + (v[q][2] * v[q][2] + v[q][3] * v[q][3]);
        ss += __builtin_bit_cast(float, __builtin_amdgcn_update_dpp(0, __builtin_bit_cast(int, ss), 0xB1, 0xF, 0xF, true));
        ss += __builtin_bit_cast(float, __builtin_amdgcn_update_dpp(0, __builtin_bit_cast(int, ss), 0x4E, 0xF, 0xF, true));
        ss += __builtin_bit_cast(float, __builtin_amdgcn_update_dpp(0, __builtin_bit_cast(int, ss), 0x141, 0xF, 0xF, true));
        ss += __builtin_bit_cast(float, __builtin_amdgcn_update_dpp(0, __builtin_bit_cast(int, ss), 0x140, 0xF, 0xF, true));
        ss += shx(ss, 16, lane); ss += shx(ss, 32, lane);
        const float rstd = rsqrtf(ss * (1.f / DM) + EPS);
        if (outb) {
            const int bi = row < NLAT ? (row >> 12) : 16;
            const float* sh = mods_l + (size_t)bi * 9216 + shift_idx * 1024 + lane * 4; const float* sc = mods_l + (size_t)bi * 9216 + scale_idx * 1024 + lane * 4;
#pragma unroll
            for (int q = 0; q < 4; ++q) {
                const f32x4 g = *(const f32x4*)(gw + lane * 4 + q * 256), s = *(const f32x4*)(sc + q * 256), t = *(const f32x4*)(sh + q * 256);
                const f32x4 y = (v[q] * rstd * g) * (s + 1.f) + t;
                u32x2 w; w.x = cvt_pk_bf16(y[0], y[1]); w.y = cvt_pk_bf16(y[2], y[3]);
                *(u32x2*)(outb + (size_t)row * DM + lane * 4 + q * 256) = w;
            }
        } else {
#pragma unroll
            for (int q = 0; q < 4; ++q) { const f32x4 g = *(const f32x4*)(gw + lane * 4 + q * 256); *(f32x4*)(outf + (size_t)row * DM + lane * 4 + q * 256) = v[q] * rstd * g; }
        }
    }
}

__device__ void phase_convert(const Params& p, int l, LAS unsigned char* lds) {
    LAS float* tile = (LAS float*)lds;
    const int tid = opaque_tid();
    for (int u = blockIdx.x; u < 5176; u += gridDim.x) {
        const float* src; int Nsrc, K; bf16_t* dst; int kind = KNAT, which = 0; const float* ksc = nullptr; int t = u;
        if (t < 4224) { const int j = t / 704; t %= 704; const int f = j / 3, mm = j % 3;
            if (mm < 2) { src = (f ? (mm ? p.ffn2_w3 : p.ffn2_w1) : (mm ? p.ffn1_w3 : p.ffn1_w1)) + (size_t)l * DM * DFF; Nsrc = DFF; K = DM; dst = f ? p.Bt13b : p.Bt13a; kind = KSWI; which = mm; }
            else { src = (f ? p.ffn2_w2 : p.ffn1_w2) + (size_t)l * DFF * DM; Nsrc = DM; K = DFF; dst = f ? p.Bt2b : p.Bt2a; } }
        else if ((t -= 4224) < 624) { src = p.w_in + (size_t)l * DM * INW; Nsrc = INW; K = DM; dst = p.Btin; kind = KIN; }
        else if ((t -= 624) < 256) { src = p.w_out + (size_t)l * DM * DM; Nsrc = DM; K = DM; dst = p.Btout; }
        else if ((t -= 256) < 36) { src = p.mla_w_uq + (size_t)l * 384 * 384; Nsrc = 384; K = 384; dst = p.Btuq; kind = KUQ; ksc = p.mla_q_norm + l * 384; }
        else if ((t -= 36) < 32) { src = p.mla_w_ukv + (size_t)l * 256 * 512; Nsrc = 512; K = 256; dst = p.Btukv; kind = KUKV; ksc = p.mla_kv_norm + l * 256; }
        else { t -= 32; src = p.pool_w + (size_t)(l * 4 + t) * 4096; Nsrc = 64; K = 64; dst = p.Btpool + t * 4096; t = 0; }
        const int nkt = K / 64; const int c0 = (t / nkt) * 64, k0 = (t % nkt) * 64;
        { const int cl = tid & 63, ks = tid >> 6; const int c = c0 + cl;
#pragma unroll
          for (int kk = 0; kk < 8; ++kk) { const int k = ks + 8 * kk; tile[k * 65 + cl] = c < Nsrc ? src[(size_t)(k0 + k) * Nsrc + c] : 0.f; } }
        __syncthreads();
        { const int cl = tid >> 3, kseg = tid & 7; const int c = c0 + cl;
          if (c < Nsrc) { const int row = dstrow(kind, which, c); float v[8];
#pragma unroll
              for (int i = 0; i < 8; ++i) v[i] = tile[(kseg * 8 + i) * 65 + cl] * (ksc ? ksc[k0 + kseg * 8 + i] : 1.f);
              u32x4 w; w.x = cvt_pk_bf16(v[0], v[1]); w.y = cvt_pk_bf16(v[2], v[3]); w.z = cvt_pk_bf16(v[4], v[5]); w.w = cvt_pk_bf16(v[6], v[7]);
              *(u32x4*)(dst + (size_t)row * K + k0 + kseg * 8) = w; } }
        __syncthreads();
    }
}

template <int K> __device__ __forceinline__ void win_sum(const float* base, size_t stride, int cnt, f32x4& s0, f32x4& s1) {
    f32x4 v0[K], v1[K];
#pragma unroll
    for (int i = 0; i < K; ++i) { const float* q = base + (size_t)min(i, cnt - 1) * stride; v0[i] = *(const f32x4*)q; v1[i] = *(const f32x4*)(q + 4); }
#pragma unroll
    for (int i = 0; i < K; ++i) { const float w = i < cnt ? 1.f : 0.f; s0 += v0[i] * w; s1 += v1[i] * w; }
}
__device__ __forceinline__ void win_sum_g(int g, const float* base, size_t stride, int cnt, f32x4& s0, f32x4& s1) {
    if (g == 0) win_sum<2>(base, stride, cnt, s0, s1); else if (g == 1) win_sum<4>(base, stride, cnt, s0, s1); else if (g == 2) win_sum<8>(base, stride, cnt, s0, s1); else win_sum<16>(base, stride, cnt, s0, s1);
}
__device__ void phase_pool(const Params& p, int l, bool with_ctx, LAS unsigned char* lds) {
    LAS float* V = (LAS float*)lds;
    LAS bf16_t* Dm = (LAS bf16_t*)(lds + 17408);
    const int tid = opaque_tid(), wid = tid >> 6, lane = tid & 63, c16 = lane & 15, gq = lane >> 4;
    const int c = tid >> 3, ch0 = (tid & 7) * 8;
    const int nunits = 4096 + (with_ctx ? 256 : 0);
    const float* ps = p.pool_scale + l * 256;
    for (int u = blockIdx.x; u < nunits; u += gridDim.x) {
        const bool lat = u < 4096; int b, g, r, tok0;
        if (lat) { b = u >> 8; g = (u >> 6) & 3; r = u & 63; tok0 = b * 4096 + r * 64; }
        else { const int uu = u - 4096; b = uu >> 4; g = (uu >> 2) & 3; r = uu & 3; tok0 = NLAT + b * 256 + r * 64; }
        const int k = 2 << g, lo = k >> 1, hi = k - 1 - lo;
        const float* Ug = p.U + g * 64 + ch0;
        f32x4 m0 = (f32x4){0.f, 0.f, 0.f, 0.f}, m1 = m0; float inv;
        if (lat) {
            const int r0 = max(r - lo, 0), r1 = min(r + hi, 63);
            f32x4 a0 = m0, a1 = m0;
            win_sum_g(g, Ug + (size_t)(b * 4096 + r0 * 64 + c) * 256, (size_t)64 * 256, r1 - r0 + 1, a0, a1);
            const float ir = 1.f / (float)(r1 - r0 + 1);
            *(LAS f32x4*)(V + c * 68 + ch0) = a0 * ir; *(LAS f32x4*)(V + c * 68 + ch0 + 4) = a1 * ir;
            __syncthreads();
            const int cc0 = max(c - lo, 0), cc1 = min(c + hi, 63);
            for (int cc = cc0; cc <= cc1; ++cc) { m0 += *(const LAS f32x4*)(V + cc * 68 + ch0); m1 += *(const LAS f32x4*)(V + cc * 68 + ch0 + 4); }
            inv = 1.f / (float)(cc1 - cc0 + 1);
        } else {
            const int i = r * 64 + c, i0 = max(i - lo, 0), i1 = min(i + hi, 255);
            win_sum_g(g, Ug + (size_t)(NLAT + b * 256 + i0) * 256, (size_t)256, i1 - i0 + 1, m0, m1);
            inv = 1.f / (float)(i1 - i0 + 1);
        }
        { const float* q = Ug + (size_t)(tok0 + c) * 256; const f32x4 u0 = *(const f32x4*)q, u1 = *(const f32x4*)(q + 4);
          const f32x4 d0 = m0 * inv - u0, d1 = m1 * inv - u1;
          u32x4 w; w.x = cvt_pk_bf16(d0[0], d0[1]); w.y = cvt_pk_bf16(d0[2], d0[3]); w.z = cvt_pk_bf16(d1[0], d1[1]); w.w = cvt_pk_bf16(d1[2], d1[3]);
          *(LAS u32x4*)(Dm + c * 72 + ch0) = w; }
        __syncthreads();
        const int tb = wid >> 1;
#pragma unroll
        for (int o = 0; o < 2; ++o) {
            const int ob = (wid & 1) * 2 + o; f32x4 acc = (f32x4){0.f, 0.f, 0.f, 0.f};
#pragma unroll
            for (int ks = 0; ks < 2; ++ks) {
                const bf16x8 a = *(const bf16x8*)(p.Btpool + g * 4096 + (ob * 16 + c16) * 64 + ks * 32 + gq * 8);
                const bf16x8 bb = *(const LAS bf16x8*)(Dm + (tb * 16 + c16) * 72 + ks * 32 + gq * 8);
                acc = __builtin_amdgcn_mfma_f32_16x16x32_bf16(a, bb, acc, 0, 0, 0);
            }
            const int tok = tok0 + tb * 16 + c16, oc = g * 64 + ob * 16 + 4 * gq;
            const f32x4 sc = *(const f32x4*)(ps + oc);
            u32x2 w; w.x = cvt_pk_bf16(acc[0] * sc[0], acc[1] * sc[1]); w.y = cvt_pk_bf16(acc[2] * sc[2], acc[3] * sc[3]);
            *(u32x2*)(p.XN + (size_t)tok * DM + oc) = w;
        }
        __syncthreads();
    }
}

typedef float f32x16 __attribute__((ext_vector_type(16)));
#define ROWMAX32(out, A, B) do { \
    asm("v_max3_f32 %0, %1, %2, %3\n\tv_max3_f32 %0, %0, %4, %5\n\tv_max3_f32 %0, %0, %6, %7\n\tv_max3_f32 %0, %0, %8, %9\n\tv_max3_f32 %0, %0, %10, %11\n\tv_max3_f32 %0, %0, %12, %13\n\tv_max3_f32 %0, %0, %14, %15\n\tv_max3_f32 %0, %0, %16, %16" \
        : "=&v"(out) : "v"((A)[0]), "v"((A)[1]), "v"((A)[2]), "v"((A)[3]), "v"((A)[4]), "v"((A)[5]), "v"((A)[6]), "v"((A)[7]), "v"((A)[8]), "v"((A)[9]), "v"((A)[10]), "v"((A)[11]), "v"((A)[12]), "v"((A)[13]), "v"((A)[14]), "v"((A)[15])); \
    asm("v_max3_f32 %0, %0, %1, %2\n\tv_max3_f32 %0, %0, %3, %4\n\tv_max3_f32 %0, %0, %5, %6\n\tv_max3_f32 %0, %0, %7, %8\n\tv_max3_f32 %0, %0, %9, %10\n\tv_max3_f32 %0, %0, %11, %12\n\tv_max3_f32 %0, %0, %13, %14\n\tv_max3_f32 %0, %0, %15, %16" \
        : "+v"(out) : "v"((B)[0]), "v"((B)[1]), "v"((B)[2]), "v"((B)[3]), "v"((B)[4]), "v"((B)[5]), "v"((B)[6]), "v"((B)[7]), "v"((B)[8]), "v"((B)[9]), "v"((B)[10]), "v"((B)[11]), "v"((B)[12]), "v"((B)[13]), "v"((B)[14]), "v"((B)[15])); } while (0)

template <int DQK, int DV, bool DIFF>
__device__ __forceinline__ void attn_unit(LAS unsigned char* lds, const bf16_t* Qp, int ldq, const bf16_t* Kp, size_t kmap_stride, const bf16_t* Vtp, int kv_len,
                                          bf16_t* outp  , float lam, float post, const float* subln) {
    constexpr int NMAP = DIFF ? 2 : 1;
    constexpr int KROW = DQK * 2 + 16, VROW = 144, KBYTES = 64 * KROW, VBYTES = DV * VROW, KBUF = NMAP * KBYTES, OFFV = 2 * KBUF;
    constexpr int KC8 = DQK / 8, KCH = NMAP * 64 * KC8, VCH = DV * 8, NLK = (KCH + 511) / 512, NLV = (VCH + 511) / 512, NKS = DQK / 16, NDB = DV / 32;
    const int tid = opaque_tid(), wid = tid >> 6, lane = tid & 63, q32 = lane & 31, h = lane >> 5;
    const int qg = DIFF ? (wid >> 1) : wid, mp = DIFF ? (wid & 1) : 0;
    bf16x8 qf[NKS];
    { const bf16_t* qr = Qp + (size_t)(qg * 32 + q32) * ldq + mp * 64 + h * 8;
#pragma unroll
      for (int ks = 0; ks < NKS; ++ks) qf[ks] = *(const bf16x8*)(qr + ks * 16); }
    f32x16 O[NDB];
#pragma unroll
    for (int db = 0; db < NDB; ++db)
#pragma unroll
        for (int j = 0; j < 16; ++j) O[db][j] = 0.f;
    float lsum = 0.f;
    f32x16 mneg;
#pragma unroll
    for (int j = 0; j < 16; ++j) mneg[j] = 0.f;
    u32x4 stk[NLK], stv[NLV];
    auto kchunk = [&](int i) { const int ch = tid + i * 512; return ch < KCH ? ch : ch - 256; };
    auto gloadK = [&](int t) {
#pragma unroll
        for (int i = 0; i < NLK; ++i) { const int ch = kchunk(i), mpc = ch / (64 * KC8), cc = ch % (64 * KC8); stk[i] = *(const u32x4*)(Kp + (size_t)mpc * kmap_stride + (size_t)t * 64 * DQK + cc * 8); } };
    auto lstoreK = [&](int t) {
#pragma unroll
        for (int i = 0; i < NLK; ++i) { const int ch = kchunk(i), mpc = ch / (64 * KC8), cc = ch % (64 * KC8); *(LAS u32x4*)(lds + (t & 1) * KBUF + mpc * KBYTES + (cc / KC8) * KROW + (cc % KC8) * 16) = stk[i]; } };
    static_assert(VCH % 512 == 0 && KCH >= 512 && KCH - 256 >= 0, "chunk maps");
    auto gloadV = [&](int t) {
#pragma unroll
        for (int i = 0; i < NLV; ++i) { const int cc = tid + i * 512; stv[i] = *(const u32x4*)(Vtp + (size_t)(cc >> 3) * KVL + t * 64 + (cc & 7) * 8); } };
    auto lstoreV = [&](int t) {
#pragma unroll
        for (int i = 0; i < NLV; ++i) { const int cc = tid + i * 512; *(LAS u32x4*)(lds + OFFV + (t & 1) * VBYTES + (cc >> 3) * VROW + (cc & 7) * 16) = stv[i]; } };
    const int nt = kv_len / 64;
    gloadK(0); gloadV(0); lstoreK(0); lstoreV(1);
    gloadK(1); lstoreK(1);
    __syncthreads();
    f32x16 Sc[2], Sn[2];
    {
        const LAS unsigned char* kb_ = lds + mp * KBYTES + q32 * KROW + h * 16;
#pragma unroll
        for (int kb = 0; kb < 2; ++kb) {
#pragma unroll
            for (int j = 0; j < 16; ++j) Sc[kb][j] = 0.f;
#pragma unroll
            for (int ks = 0; ks < NKS; ++ks) { const bf16x8 a = *(const LAS bf16x8*)(kb_ + kb * 32 * KROW + ks * 32); Sc[kb] = __builtin_amdgcn_mfma_f32_32x32x16_bf16(a, qf[ks], Sc[kb], 0, 0, 0); }
        }
    }
    __syncthreads();
    __builtin_amdgcn_sched_barrier(0);
    asm volatile("s_nop 15\n\ts_nop 15\n\ts_nop 15\n\ts_nop 15\n\ts_nop 15\n\ts_nop 15" ::: "memory");
    __builtin_amdgcn_sched_barrier(0);
    float lm_cur;
    ROWMAX32(lm_cur, Sc[0], Sc[1]);
    bf16x8 Pa[2][2], Pb[2][2];
#pragma unroll
    for (int kb = 0; kb < 2; ++kb)
#pragma unroll
        for (int s = 0; s < 2; ++s)
#pragma unroll
            for (int e = 0; e < 8; ++e) Pa[kb][s][e] = 0;
    auto step = [&](f32x16 (&Sa)[2], f32x16 (&Sb)[2], bf16x8 (&Pp)[2][2], bf16x8 (&Pn)[2][2], int t) {
        const float lm = lm_cur;
        if (t == 0 || __builtin_amdgcn_ballot_w64(lm > 8.f) != 0) {
            const float mx = fmaxf(lm, shx(lm, 32, lane));
            const float delta = (t == 0 || mx > 8.f) ? mx : 0.f;
            const float alpha = t == 0 ? 1.f : fast_exp2(-delta);
            lsum *= alpha;
#pragma unroll
            for (int j = 0; j < 16; ++j) { mneg[j] -= delta; Sa[0][j] -= delta; Sa[1][j] -= delta; }
#pragma unroll
            for (int db = 0; db < NDB; ++db) O[db] *= alpha;
#pragma unroll
            for (int kb = 0; kb < 2; ++kb)
#pragma unroll
                for (int s = 0; s < 2; ++s) { u32x4 w = __builtin_bit_cast(u32x4, Pp[kb][s]);
#pragma unroll
                    for (int e = 0; e < 4; ++e) w[e] = cvt_pk_bf16(__uint_as_float(w[e] << 16) * alpha, __uint_as_float(w[e] & 0xffff0000u) * alpha);
                    Pp[kb][s] = __builtin_bit_cast(bf16x8, w); }
        }
        gloadK(min(t + 2, nt - 1)); gloadV(t);
        const LAS unsigned char* kb_ = lds + ((t + 1) & 1) * KBUF + mp * KBYTES + q32 * KROW + h * 16;
        const LAS unsigned char* vb_ = lds + OFFV + ((t + 1) & 1) * VBYTES + q32 * VROW + h * 16;
        constexpr int NQK = 2 * NKS, NM = NQK + 4 * NDB, NG = NM / 4, PPG = (16 + NG - 1) / NG;
        static_assert(NM % 4 == 0, "MFMA groups of four");
        bf16x8 fr[2][4];
        float ps0 = 0.f;
        unsigned pk[2][8];
#define ATT_LOADGRP(g) _Pragma("unroll") for (int q_ = 0; q_ < 4; ++q_) { const int i_ = 4 * (g) + q_; \
            fr[(g) & 1][q_] = (i_ < NQK) ? *(const LAS bf16x8*)(kb_ + (i_ / NKS) * 32 * KROW + (i_ % NKS) * 32) \
                                         : *(const LAS bf16x8*)(vb_ + ((i_ - NQK) / 4) * 32 * VROW + (((i_ - NQK) / 2) & 1) * 64 + ((i_ - NQK) & 1) * 32); }
        ATT_LOADGRP(0);
#pragma unroll
        for (int g = 0; g < NG; ++g) {
            if (g + 1 < NG) { ATT_LOADGRP(g + 1); }
#pragma unroll
            for (int q_ = 0; q_ < 4; ++q_) { const int i_ = 4 * g + q_;
                if (i_ < NQK) { const int kb = i_ / NKS, ks = i_ % NKS;
                    if (ks == 0) Sb[kb] = __builtin_amdgcn_mfma_f32_32x32x16_bf16(fr[g & 1][q_], qf[ks], mneg, 0, 0, 0);
                    else Sb[kb] = __builtin_amdgcn_mfma_f32_32x32x16_bf16(fr[g & 1][q_], qf[ks], Sb[kb], 0, 0, 0); }
                else { const int j_ = i_ - NQK, db = j_ / 4, kb = (j_ / 2) & 1, sx = j_ & 1; O[db] = __builtin_amdgcn_mfma_f32_32x32x16_bf16(fr[g & 1][q_], Pp[kb][sx], O[db], 0, 0, 0); } }
#pragma unroll
            for (int pp = g * PPG; pp < (g + 1) * PPG && pp < 16; ++pp) { const int kb = pp / 8, j = pp % 8;
                Sa[kb][2 * j] = fast_exp2(Sa[kb][2 * j]); Sa[kb][2 * j + 1] = fast_exp2(Sa[kb][2 * j + 1]); }
            if (g > 0) {
#pragma unroll
                for (int pp = (g - 1) * PPG; pp < g * PPG && pp < 16; ++pp) { const int kb = pp / 8, j = pp % 8;
                    asm("v_add_f32 %0, %1, %2" : "=v"(ps0) : "v"(ps0), "v"(Sa[kb][2 * j])); asm("v_add_f32 %0, %1, %2" : "=v"(ps0) : "v"(ps0), "v"(Sa[kb][2 * j + 1]));
                    pk[kb][j] = cvt_pk_bf16(Sa[kb][2 * j], Sa[kb][2 * j + 1]); }
            }
            if (g == NG - 2) { lstoreK(t + 2); lstoreV(t); }
            if (g == NG - 1) {
                float lmn;
                ROWMAX32(lmn, Sb[0], Sb[1]);
                lm_cur = lmn;
            }
            __builtin_amdgcn_sched_barrier(0);
        }
#pragma unroll
        for (int pp = (NG - 1) * PPG; pp < 16; ++pp) { const int kb = pp / 8, j = pp % 8;
            asm("v_add_f32 %0, %1, %2" : "=v"(ps0) : "v"(ps0), "v"(Sa[kb][2 * j])); asm("v_add_f32 %0, %1, %2" : "=v"(ps0) : "v"(ps0), "v"(Sa[kb][2 * j + 1]));
            pk[kb][j] = cvt_pk_bf16(Sa[kb][2 * j], Sa[kb][2 * j + 1]); }
#undef ATT_LOADGRP
#pragma unroll
        for (int kb = 0; kb < 2; ++kb) { Pn[kb][0] = __builtin_bit_cast(bf16x8, (u32x4){pk[kb][0], pk[kb][1], pk[kb][2], pk[kb][3]}); Pn[kb][1] = __builtin_bit_cast(bf16x8, (u32x4){pk[kb][4], pk[kb][5], pk[kb][6], pk[kb][7]}); }
        lsum += ps0;
        __syncthreads();
    };
    for (int t = 0; t < nt; t += 2) { step(Sc, Sn, Pa, Pb, t); step(Sn, Sc, Pb, Pa, t + 1); }
    bf16x8 (&pfp)[2][2] = Pa;
    { const LAS unsigned char* vb_ = lds + OFFV + ((nt - 1) & 1) * VBYTES + q32 * VROW + h * 16;
#pragma unroll
      for (int db = 0; db < NDB; ++db)
#pragma unroll
          for (int kb = 0; kb < 2; ++kb)
#pragma unroll
              for (int s = 0; s < 2; ++s) { const bf16x8 a = *(const LAS bf16x8*)(vb_ + db * 32 * VROW + kb * 64 + s * 32); O[db] = __builtin_amdgcn_mfma_f32_32x32x16_bf16(a, pfp[kb][s], O[db], 0, 0, 0); } }
    __syncthreads();
    const float ltot = lsum + shx(lsum, 32, lane);
    const float inv = 1.f / ltot;
    bf16_t* orow = outp + (size_t)(qg * 32 + q32) * DM + 4 * h;
    if constexpr (!DIFF) {
#pragma unroll
        for (int db = 0; db < NDB; ++db)
#pragma unroll
            for (int jj = 0; jj < 4; ++jj) { u32x2 w; w.x = cvt_pk_bf16(O[db][4 * jj] * inv, O[db][4 * jj + 1] * inv); w.y = cvt_pk_bf16(O[db][4 * jj + 2] * inv, O[db][4 * jj + 3] * inv);
                *(u32x2*)(orow + db * 32 + jj * 8) = w; }
    } else {
        LAS float* X = (LAS float*)lds + (qg * 32 + q32) * 132 + 4 * h;
        if (mp == 1) { const float sc = lam * inv;
#pragma unroll
            for (int db = 0; db < NDB; ++db)
#pragma unroll
                for (int jj = 0; jj < 4; ++jj) *(LAS f32x4*)(X + db * 32 + jj * 8) = (f32x4){O[db][4 * jj] * sc, O[db][4 * jj + 1] * sc, O[db][4 * jj + 2] * sc, O[db][4 * jj + 3] * sc}; }
        __syncthreads();
        if (mp == 0) {
            float ss = 0.f;
#pragma unroll
            for (int db = 0; db < NDB; ++db)
#pragma unroll
                for (int jj = 0; jj < 4; ++jj) { const f32x4 x = *(const LAS f32x4*)(X + db * 32 + jj * 8);
#pragma unroll
                    for (int e = 0; e < 4; ++e) { const float o = O[db][4 * jj + e] * inv - x[e]; O[db][4 * jj + e] = o; ss += o * o; } }
            ss += shx(ss, 32, lane);
            float li_ = post; asm volatile("" : "+v"(li_));
            const float r = rsqrtf(ss * (1.f / DV) + EPS) * (1.f - li_);
#pragma unroll
            for (int db = 0; db < NDB; ++db)
#pragma unroll
                for (int jj = 0; jj < 4; ++jj) { const f32x4 gsub = *(const f32x4*)(subln + db * 32 + jj * 8 + 4 * h);
                    u32x2 w; w.x = cvt_pk_bf16(O[db][4 * jj] * r * gsub[0], O[db][4 * jj + 1] * r * gsub[1]); w.y = cvt_pk_bf16(O[db][4 * jj + 2] * r * gsub[2], O[db][4 * jj + 3] * r * gsub[3]);
                    *(u32x2*)(orow + db * 32 + jj * 8) = w; }
        }
        __syncthreads();
    }
}

__device__ void phase_attn(const Params& p, int l, bool with_ctx, LAS unsigned char* lds) {
    const float lam_init = 0.8f - 0.6f * expf(-0.3f * (float)l);
    const float* dl = p.diff_lambda + l * 256;
    float s1 = 0.f, s2 = 0.f;
    for (int i = 0; i < 64; ++i) { s1 += dl[i] * dl[64 + i]; s2 += dl[128 + i] * dl[192 + i]; }
    const float lam = __builtin_bit_cast(float, __builtin_amdgcn_readfirstlane(__builtin_bit_cast(int, expf(s1) - expf(s2) + lam_init)));
    const float post_scale = __builtin_bit_cast(float, __builtin_amdgcn_readfirstlane(__builtin_bit_cast(int, 1.f - lam_init)));
    const int total = 3072 + (with_ctx ? 192 : 0);
    for (int u = blockIdx.x; u < total; u += gridDim.x) {
        bool diff; int b, h, row0, kvlen;
        if (u < 2048) { diff = true; const int i = u >> 8, blk = u & 255, bh = i * 8 + (blk & 7), qb = blk >> 3; b = bh >> 2; h = bh & 3; row0 = b * 4096 + qb * 128; kvlen = KVL; }
        else if (u < 3072) { diff = false; const int uu = u - 2048, i = uu >> 8, blk = uu & 255, slot = blk >> 3, bh = i * 16 + 2 * (blk & 7) + (slot >> 4), qb = slot & 15; b = bh >> 2; h = bh & 3; row0 = b * 4096 + qb * 256; kvlen = KVL; }
        else if (u < 3200) { diff = true; const int uu = u - 3072, bh = uu >> 1; b = bh >> 2; h = bh & 3; row0 = NLAT + b * 256 + (uu & 1) * 128; kvlen = CTXL; }
        else { diff = false; const int bh = u - 3200; b = bh >> 2; h = bh & 3; row0 = NLAT + b * 256; kvlen = CTXL; }
        if (diff) attn_unit<64, 128, true>(lds, p.QD + (size_t)row0 * 512 + (2 * h) * 64, 512, p.KD + (size_t)(b * 8 + 2 * h) * KVL * 64, (size_t)KVL * 64, p.VTD + (size_t)(b * 4 + h) * 128 * KVL, kvlen,
                                           p.XN + (size_t)row0 * DM + 512 + h * 128, lam, lam_init, p.diff_subln + l * 128);
        else attn_unit<96, 64, false>(lds, p.QM + (size_t)row0 * 384 + h * 96, 384, p.KM + (size_t)(b * 4 + h) * KVL * 96, 0, p.VTM + (size_t)(b * 4 + h) * 64 * KVL, kvlen,
                                      p.XN + (size_t)row0 * DM + 256 + h * 64, 0.f, 1.f, nullptr);
    }
}

constexpr int NPHASE = 2 + DEPTH * 11;
__device__ __forceinline__ void run_phase(const Params& p, int ph, LAS unsigned char* lds) {
    const int G = (int)gridDim.x, cb = (int)blockIdx.x;
    if (ph == 0) { phase_init(p, lds); return; }
    if (ph == NPHASE - 1) { phase_norm(p.H, p.H, NLAT, p.final_norm, nullptr, 0, 0, nullptr, p.out, nullptr, nullptr, 0.f, nullptr); return; }
    const int l = (ph - 1) / 11, k = (ph - 1) % 11; const bool last = l == DEPTH - 1;
    const float* mods_l = p.MODS + (size_t)l * 17 * 9216;
    const int Mlate = last ? NLAT : NT;
    pg8::StaticOrder S;
    if (k == 0 || k == 3 || k == 8) {
        const float* gw = (k == 0 ? p.ffn1_norm : k == 3 ? p.mix_norm : p.ffn2_norm) + l * DM;
        const int si = k == 8 ? 6 : k;
        const bool first = (l == 0 && k == 0);
        const bool pend = !first && !(k == 8 && last);
        const float* pgate = (k == 0 ? mods_l - 17 * 9216 + 8 * 1024 : k == 3 ? mods_l + 2 * 1024 : mods_l + 5 * 1024) + (size_t)16 * 9216;
        const bool ctx_in = (l == 0 && k <= 3);
        phase_norm(first ? p.x : p.H, ctx_in ? p.ctx - (size_t)NLAT * DM : p.H, k == 8 ? Mlate : NT, gw, mods_l, si, si + 1, p.XN, nullptr, pend ? p.P4 : nullptr, pgate, k == 8 ? 1.f : 0.5f, p.H);
        if (k == 0) phase_convert(p, l, lds);
    } else if (k == 1 || k == 9) {
        pg8::Gemm g{p.XN, k == 1 ? p.Bt13a : p.Bt13b, k == 1 ? NT : Mlate, 2 * DFF, DM, DM};
        S.init(g.M, g.N, G, cb); EpiSwiGLU E{p.G};
        pg8::gemm_phase(lds, g, S, E);
    } else if (k == 2 || k == 7 || k == 10) {
        const int Kf = k == 7 ? DM : DFF;
        const bf16_t* Ap = k == 7 ? p.XN : p.G; const bf16_t* Bp = k == 2 ? p.Bt2a : k == 7 ? p.Btout : p.Bt2b;
        const bool first = (l == 0 && k == 2);
        { pg8::Gemm g{Ap, Bp, NLAT, DM, Kf, Kf};
          S.init(g.M, g.N, G, cb); EpiResid E{first ? p.x : p.H, p.H, p.H, mods_l + (k == 2 ? 2 : k == 7 ? 5 : 8) * 1024, k == 7 ? 1.f : 0.5f};
          pg8::gemm_phase(lds, g, S, E); }
        if (k == 2 || !last) {
            const int kt = Kf / 128, q0 = kt / 4, r0 = kt % 4;
            for (int idx = cb; idx < 256; idx += G) {
                const int unit = idx >> 2, sl = idx & 3;
                const int kb0 = sl * q0 + (sl < r0 ? sl : r0), kl = q0 + (sl < r0 ? 1 : 0);
                pg8::Gemm g{Ap + (size_t)NLAT * Kf + kb0 * 128, Bp + kb0 * 128, NCTX, DM, kl * 128, Kf};
                S.init(g.M, g.N, G, cb); S.fixed = unit;
                EpiPartial E{p.P4 + (size_t)sl * NCTX * DM};
                __syncthreads();
                pg8::gemm_phase(lds, g, S, E);
            }
        }
    } else if (k == 4) {
        pg8::Gemm g{p.XN, p.Btin, NT, 2560, DM, DM};
        S.init(g.M, g.N, G, cb); EpiIn E{p.U, p.CQ, p.CKV, p.SSQ, p.QD, p.KD, p.VTD, p.KM, p.ROPED, p.ROPEM, lds + 131072};
        pg8::gemm_phase(lds, g, S, E);
    } else if (k == 5) {
        { pg8::Gemm g{p.CQ, p.Btuq, NT, 512, 384, 384}; S.init(g.M, g.N, G, cb); EpiQup E{p.SSQ, p.QM, p.ROPEM}; pg8::gemm_phase(lds, g, S, E); }
        { pg8::Gemm g{p.CKV, p.Btukv, NT, 512, 256, 256}; S.init(g.M, g.N, G, (cb + 32) % G); EpiKVup E{p.SSQ, p.KM, p.VTM, lds + 131072}; pg8::gemm_phase(lds, g, S, E); }
        __syncthreads();
        phase_pool(p, l, !last, lds);
    } else if (k == 6) {
        phase_attn(p, l, !last, lds);
    }
}

__device__ __forceinline__ void grid_barrier(unsigned* ctr, unsigned target) {
    asm volatile("s_waitcnt vmcnt(0) lgkmcnt(0)" ::: "memory");
    __syncthreads();
    if (threadIdx.x == 0) {
        __builtin_amdgcn_fence(__ATOMIC_RELEASE, "agent");
        asm volatile("s_waitcnt vmcnt(0)" ::: "memory");
        __hip_atomic_fetch_add(ctr, 1u, __ATOMIC_RELAXED, __HIP_MEMORY_SCOPE_AGENT);
        while (__hip_atomic_load(ctr, __ATOMIC_RELAXED, __HIP_MEMORY_SCOPE_AGENT) < target) __builtin_amdgcn_s_sleep(2);
        __builtin_amdgcn_fence(__ATOMIC_ACQUIRE, "agent");
        asm volatile("s_waitcnt vmcnt(0)" ::: "memory");
    }
    __syncthreads();
}

__global__ __launch_bounds__(512, 2) void hymba_mega(Params p) {
    extern __shared__ __attribute__((aligned(16))) unsigned char smem[];
    LAS unsigned char* lds = (LAS unsigned char*)smem;
    cg::grid_group grid = cg::this_grid();
    unsigned nbar = 0;
    for (int ph = p.ph_lo; ph < p.ph_hi; ++ph) {
        run_phase(p, ph, lds);
        if (ph + 1 < p.ph_hi) {
            if (ph == p.ph_lo) grid.sync();
            else grid_barrier(p.BAR, ++nbar * gridDim.x);
        }
    }
}

extern "C" void kernel_launch(void* const* d_in, const int* in_sizes, int n_in, void* d_out, int out_size, void* d_ws, size_t ws_size, hipStream_t stream) {
    static int grid_blocks = 0;
    if (!grid_blocks) {
        int dev = 0, cus = 0, per_cu = 0;
        hipGetDevice(&dev);
        hipDeviceGetAttribute(&cus, hipDeviceAttributeMultiprocessorCount, dev);
        if (hipFuncSetAttribute((const void*)hymba_mega, hipFuncAttributeMaxDynamicSharedMemorySize, LDS_BYTES) != hipSuccess) fprintf(stderr, "hipFuncSetAttribute failed\n");
        if (hipOccupancyMaxActiveBlocksPerMultiprocessor(&per_cu, (const void*)hymba_mega, 512, LDS_BYTES) != hipSuccess || per_cu < 1) { per_cu = 1; (void)hipGetLastError(); }
        grid_blocks = cus * per_cu;
        if (grid_blocks <= 0) grid_blocks = 256;
    }
    Params p{};
    const float** in = (const float**)&p;
    for (int i = 0; i < 26 && i < n_in; ++i) in[i] = (const float*)d_in[i];
    p.out = (float*)d_out;
    unsigned char* w = (unsigned char*)d_ws; size_t off = 0;
    auto take = [&](size_t bytes) { unsigned char* r = w + off; off += (bytes + 255) & ~(size_t)255; return r; };
    p.H = (float*)take((size_t)NT * DM * 4);
    p.XN = (bf16_t*)take((size_t)NT * DM * 2);
    unsigned char* big = w + off; size_t boff = 0;
    auto takeb = [&](size_t bytes) { unsigned char* r = big + boff; boff += (bytes + 255) & ~(size_t)255; return r; };
    p.U = (float*)takeb((size_t)NT * 256 * 4);
    p.CQ = (bf16_t*)takeb((size_t)NT * 384 * 2);
    p.CKV = (bf16_t*)takeb((size_t)NT * 256 * 2);
    p.SSQ = (float*)takeb((size_t)NT * 16 * 4);
    p.QD = (bf16_t*)takeb((size_t)NT * 512 * 2);
    p.KD = (bf16_t*)takeb((size_t)NB * 8 * KVL * 64 * 2);
    p.VTD = (bf16_t*)takeb((size_t)NB * 4 * 128 * KVL * 2);
    p.QM = (bf16_t*)takeb((size_t)NT * 384 * 2);
    p.KM = (bf16_t*)takeb((size_t)NB * 4 * KVL * 96 * 2);
    p.VTM = (bf16_t*)takeb((size_t)NB * 4 * 64 * KVL * 2);
    p.G = (bf16_t*)big;
    p.P4 = (float*)(big + (((size_t)NT * DFF * 2 + 255) & ~(size_t)255));
    const size_t gbytes = (size_t)NT * DFF * 2;
    off += (boff > gbytes ? boff : gbytes); off = (off + 255) & ~(size_t)255;
    p.Bt13a = (bf16_t*)take((size_t)2 * DFF * DM * 2); p.Bt2a = (bf16_t*)take((size_t)DM * DFF * 2);
    p.Bt13b = (bf16_t*)take((size_t)2 * DFF * DM * 2); p.Bt2b = (bf16_t*)take((size_t)DM * DFF * 2);
    p.Btin = (bf16_t*)take((size_t)2560 * DM * 2); p.Btout = (bf16_t*)take((size_t)DM * DM * 2);
    p.Btuq = (bf16_t*)take((size_t)512 * 384 * 2); p.Btukv = (bf16_t*)take((size_t)512 * 256 * 2); p.Btpool = (bf16_t*)take((size_t)4 * 64 * 64 * 2);
    p.MODS = (float*)take((size_t)DEPTH * 17 * 9216 * 4);
    p.BAR = (unsigned*)take(256);
    p.ROPED = (float*)take((size_t)4096 * 32 * 2 * 4); p.ROPEM = (float*)take((size_t)4096 * 16 * 2 * 4);
    if (off > ws_size) { fprintf(stderr, "kernel_launch: workspace too small: need %zu have %zu\n", off, ws_size); return; }
    (void)hipMemsetAsync(p.BAR, 0, 256, stream);
#if MULTI_LAUNCH
    for (int ph = 0; ph < NPHASE; ++ph) { p.ph_lo = ph; p.ph_hi = ph + 1; hipLaunchKernelGGL(hymba_mega, dim3(grid_blocks), dim3(512), LDS_BYTES, stream, p); }
#else
    p.ph_lo = 0; p.ph_hi = NPHASE;
    void* args[] = {&p};
    hipError_t e = hipLaunchCooperativeKernel((const void*)hymba_mega, dim3(grid_blocks), dim3(512), args, LDS_BYTES, stream);
    if (e != hipSuccess) fprintf(stderr, "cooperative launch failed: %s (grid %d)\n", hipGetErrorString(e), grid_blocks);
#endif
}
```

```cpp
#include <hip/hip_runtime.h>
#include <hip/hip_cooperative_groups.h>
#include <cstdio>
namespace cg = cooperative_groups;

#define LAS __attribute__((address_space(3)))
typedef unsigned short bf16_t;
typedef short bf16x8 __attribute__((ext_vector_type(8)));
typedef float f32x4 __attribute__((ext_vector_type(4)));
typedef float f32x2 __attribute__((ext_vector_type(2)));
typedef unsigned u32x4 __attribute__((ext_vector_type(4)));
typedef unsigned u32x2 __attribute__((ext_vector_type(2)));

constexpr int DM = 1024, NB = 16, SEQ = 4096, DEPTH = 4, CTXL = 256, DFF = 2816;
constexpr int NLAT = NB * SEQ, NCTX = NB * CTXL, NT = NLAT + NCTX, KVL = SEQ + CTXL;
constexpr int INW = 2464;
constexpr float EPS = 1e-6f;
constexpr float LOG2E = 1.4426950408889634f;
constexpr int LDS_BYTES = 131072 + 8 * 3072;
#ifndef MULTI_LAUNCH
#define MULTI_LAUNCH 0
#endif

struct Params {
    const float *x, *c, *ctx, *c_ctx, *w_mod, *b_mod, *ffn1_norm, *ffn1_w1, *ffn1_w3, *ffn1_w2, *mix_norm, *w_in, *w_out, *pool_w, *pool_scale,
        *mla_q_norm, *mla_w_uq, *mla_kv_norm, *mla_w_ukv, *diff_lambda, *diff_subln, *ffn2_norm, *ffn2_w1, *ffn2_w3, *ffn2_w2, *final_norm;
    float* out;
    float* H; bf16_t* XN; bf16_t* G; float* U; bf16_t* CQ; bf16_t* CKV; float* SSQ; bf16_t* QD; bf16_t* KD; bf16_t* VTD; bf16_t* QM; bf16_t* KM; bf16_t* VTM;
    bf16_t *Bt13a, *Bt2a, *Bt13b, *Bt2b, *Btin, *Btout, *Btuq, *Btukv, *Btpool;
    float *MODS, *ROPED, *ROPEM;
    float* P4;
    unsigned* BAR;
    int ph_lo, ph_hi;
};

typedef __bf16 bf16x2_t __attribute__((ext_vector_type(2)));
__device__ __forceinline__ unsigned cvt_pk_bf16(float lo, float hi) { const f32x2 v = {lo, hi}; const bf16x2_t b = __builtin_convertvector(v, bf16x2_t); return __builtin_bit_cast(unsigned, b); }
__device__ __forceinline__ bf16_t f2bf(float v) { return (bf16_t)(cvt_pk_bf16(v, 0.f) & 0xffffu); }
__device__ __forceinline__ int opaque_tid() { int t = threadIdx.x; asm volatile("" : "+v"(t)); return t; }
__device__ __forceinline__ float shx(float v, int mask, int lane) { return __int_as_float(__builtin_amdgcn_ds_bpermute((lane ^ mask) << 2, __float_as_int(v))); }
__device__ __forceinline__ float fast_exp2(float x) { return __builtin_amdgcn_exp2f(x); }
__device__ __forceinline__ float fast_rcp(float x) { return __builtin_amdgcn_rcpf(x); }

namespace pg8 {
constexpr int BM = 256, BK = 64, HALF = 128, HTB = HALF * BK * 2, STAGE_BYTES = 8 * HTB, NXCD = 8, WGM = 4;
__host__ __device__ __forceinline__ int lds_byte(int r, int c) { const int st = (r >> 4) * 2 + (c >> 5), rr = r & 15, cc = c & 31, ob = rr * 64 + cc * 2; return st * 1024 + (ob ^ (((ob >> 9) & 1) << 5)); }
__host__ __device__ __forceinline__ void stage_rc(int b, int& R, int& C) { const int st = b / 1024, sb = b % 1024, swz = sb ^ (((sb >> 9) & 1) << 5); R = (st >> 1) * 16 + swz / 64; C = (st & 1) * 32 + (swz % 64) / 2; }
struct Unit { int pm, pn; };
struct Gemm { const bf16_t* A; const bf16_t* Bt; int M, N, K, ld; };
struct StaticOrder {
    int nM, nN, nwg, G, c, fixed;
    __device__ void init(int M, int N, int G_, int c_) { nM = M / BM; nN = N / BM; nwg = nM * nN; G = G_; c = c_; fixed = -1; }
    __device__ bool next(int i, Unit& u) const {
        if (fixed >= 0) { if (i > 0) return false; u.pm = fixed / nN; u.pn = fixed % nN; return true; }
        const long L = (long)i * G + c; if (L >= nwg) return false;
        int wgid = (int)L; { const int q = nwg / NXCD, r = nwg % NXCD, xcd = wgid % NXCD, off = wgid / NXCD; wgid = (xcd < r ? xcd * (q + 1) : r * (q + 1) + (xcd - r) * q) + off; }
        const int nig = WGM * nN, gid = wgid / nig, fm = gid * WGM, gsz = (nM - fm) < WGM ? (nM - fm) : WGM;
        u.pm = fm + ((wgid % nig) % gsz); u.pn = (wgid % nig) / gsz; return true;
    }
};
template <class Epi>
__device__ __forceinline__ void gemm_phase(LAS unsigned char* lds, const Gemm g, const StaticOrder& S, const Epi& E) {
    const int tid = opaque_tid(), wid = __builtin_amdgcn_readfirstlane(tid >> 6), lane = tid & 63, wr = wid >> 2, wc = wid & 3, fr = lane & 15, fq = lane >> 4;
    const int K = g.K, LD = g.ld, nt = K / BK;
    unsigned voffA[2];
#pragma unroll
    for (int i = 0; i < 2; ++i) { int R, C; stage_rc(tid * 16 + i * 8192, R, C); voffA[i] = (unsigned)(R * LD + C) * 2u; }
    const size_t kstep = (size_t)(BK * 2);
    const size_t hstep = (size_t)HALF * LD * 2;
    const size_t tstep = 2 * hstep;
    const unsigned ldsw = (unsigned)wid * 1024u;
    const int aoff = lds_byte(wr * 64 + fr, fq * 8), boff = lds_byte(wc * 32 + fr, fq * 8);
#define PG8_SA(b, h) (((b) * 2 + (h)) * HTB)
#define PG8_SB(b, h) ((4 + (b) * 2 + (h)) * HTB)
#define PG8_STAGE(bufoff, gbase, voff) do { _Pragma("unroll") for (int _i = 0; _i < 2; ++_i) \
        __builtin_amdgcn_global_load_lds((const unsigned*)((const char*)(gbase) + (voff)[_i]), (LAS unsigned*)(lds + (bufoff) + ldsw + _i * 8192), 16, 0, 0); } while (0)
#define PG8_LDA(dst, b, h) do { _Pragma("unroll") for (int m = 0; m < 4; ++m) _Pragma("unroll") for (int k = 0; k < 2; ++k) dst[m][k] = *(const LAS bf16x8*)(lds + PG8_SA(b, h) + aoff + m * 2048 + k * 1024); } while (0)
#define PG8_LDB(dst, b, h) do { _Pragma("unroll") for (int n = 0; n < 2; ++n) _Pragma("unroll") for (int k = 0; k < 2; ++k) dst[n][k] = *(const LAS bf16x8*)(lds + PG8_SB(b, h) + boff + n * 2048 + k * 1024); } while (0)
#define PG8_MMA(ai, bj, At, Bt) do { __builtin_amdgcn_s_setprio(1); _Pragma("unroll") for (int m = 0; m < 4; ++m) _Pragma("unroll") for (int n = 0; n < 2; ++n) _Pragma("unroll") for (int k = 0; k < 2; ++k) \
        acc[ai][bj][m][n] = __builtin_amdgcn_mfma_f32_16x16x32_bf16(Bt[n][k], At[m][k], acc[ai][bj][m][n], 0, 0, 0); __builtin_amdgcn_s_setprio(0); } while (0)
#define PG8_WAIT_V(n) asm volatile("s_waitcnt vmcnt(" #n ")" ::: "memory")
#define PG8_WAIT_L(n) asm volatile("s_waitcnt lgkmcnt(" #n ")" ::: "memory")
#define PG8_BAR __builtin_amdgcn_s_barrier()
#define PG8_SCHED __builtin_amdgcn_sched_barrier(0)
    Unit cur, nxt; int ui = 0;
    if (!S.next(0, cur)) return;
    f32x4 acc[2][2][4][2];
#pragma unroll
    for (int a = 0; a < 2; ++a)
#pragma unroll
        for (int b = 0; b < 2; ++b)
#pragma unroll
            for (int m = 0; m < 4; ++m)
#pragma unroll
                for (int n = 0; n < 2; ++n) acc[a][b][m][n] = (f32x4){0.f, 0.f, 0.f, 0.f};
    bf16x8 At[4][2], B0[2][2], B1[2][2];
    const char* cA = (const char*)g.A + (size_t)cur.pm * tstep; const char* cB = (const char*)g.Bt + (size_t)cur.pn * tstep;
    PG8_STAGE(PG8_SB(0, 0), cB, voffA); PG8_STAGE(PG8_SA(0, 0), cA, voffA); PG8_STAGE(PG8_SB(0, 1), cB + hstep, voffA); PG8_STAGE(PG8_SA(0, 1), cA + hstep, voffA);
    if (wr == 1) PG8_BAR;
    PG8_WAIT_V(4); PG8_BAR;
    PG8_STAGE(PG8_SB(1, 0), cB + kstep, voffA); PG8_STAGE(PG8_SA(1, 0), cA + kstep, voffA); PG8_STAGE(PG8_SB(1, 1), cB + hstep + kstep, voffA);
    PG8_WAIT_V(6); PG8_BAR;
    for (;;) {
        const bool has_next = S.next(ui + 1, nxt);
        const char* nA = has_next ? (const char*)g.A + (size_t)nxt.pm * tstep : cA; const char* nB = has_next ? (const char*)g.Bt + (size_t)nxt.pn * tstep : cB;
        for (int t = 0; t < nt; t += 2) {
            const bool last = (t == nt - 2);
            const char* a1 = cA + (size_t)(t + 1) * kstep;
            const char* a2 = last ? nA : cA + (size_t)(t + 2) * kstep; const char* b2 = last ? nB : cB + (size_t)(t + 2) * kstep;
            const char* a3 = a2 + kstep; const char* b3 = b2 + kstep;
            PG8_LDB(B0, 0, 0); PG8_SCHED; PG8_LDA(At, 0, 0); PG8_STAGE(PG8_SA(1, 1), a1 + hstep, voffA);
            PG8_WAIT_L(8); PG8_BAR; PG8_WAIT_L(0); PG8_MMA(0, 0, At, B0); PG8_BAR; PG8_SCHED;
            PG8_LDB(B1, 0, 1); PG8_STAGE(PG8_SB(0, 0), b2, voffA);
            PG8_BAR; PG8_WAIT_L(0); PG8_MMA(0, 1, At, B1); PG8_BAR;
            PG8_LDA(At, 0, 1); PG8_STAGE(PG8_SA(0, 0), a2, voffA);
            PG8_BAR; PG8_WAIT_L(0); PG8_MMA(1, 0, At, B0); PG8_BAR; PG8_SCHED;
            PG8_STAGE(PG8_SB(0, 1), b2 + hstep, voffA);
            PG8_WAIT_V(6); PG8_BAR; PG8_MMA(1, 1, At, B1); PG8_BAR;
            PG8_LDB(B0, 1, 0); PG8_SCHED; PG8_LDA(At, 1, 0); PG8_STAGE(PG8_SA(0, 1), a2 + hstep, voffA);
            PG8_WAIT_L(8); PG8_BAR; PG8_WAIT_L(0); PG8_MMA(0, 0, At, B0); PG8_BAR; PG8_SCHED;
            PG8_LDB(B1, 1, 1); PG8_STAGE(PG8_SB(1, 0), b3, voffA);
            PG8_BAR; PG8_WAIT_L(0); PG8_MMA(0, 1, At, B1); PG8_BAR;
            PG8_LDA(At, 1, 1); PG8_STAGE(PG8_SA(1, 0), a3, voffA);
            PG8_BAR; PG8_WAIT_L(0); PG8_MMA(1, 0, At, B0); PG8_BAR; PG8_SCHED;
            PG8_STAGE(PG8_SB(1, 1), b3 + hstep, voffA);
            PG8_WAIT_V(6); PG8_BAR; PG8_MMA(1, 1, At, B1); PG8_BAR;
        }
        E(acc, cur, wr, wc, fr, fq);
        if (!has_next) break;
#pragma unroll
        for (int a = 0; a < 2; ++a)
#pragma unroll
            for (int b = 0; b < 2; ++b)
#pragma unroll
                for (int m = 0; m < 4; ++m)
#pragma unroll
                    for (int n = 0; n < 2; ++n) acc[a][b][m][n] = (f32x4){0.f, 0.f, 0.f, 0.f};
        cur = nxt; cA = nA; cB = nB; ++ui;
    }
    PG8_WAIT_V(0);
    if (wr == 0) PG8_BAR;
    PG8_BAR;
#undef PG8_SA
#undef PG8_SB
#undef PG8_STAGE
#undef PG8_LDA
#undef PG8_LDB
#undef PG8_MMA
#undef PG8_WAIT_V
#undef PG8_WAIT_L
#undef PG8_BAR
#undef PG8_SCHED
}
}
using pg8::Unit;

__device__ __forceinline__ int slot_of_L(int L) { return (((L >> 3) & 1) << 7) | (((L >> 6) & 3) << 5) | (((L >> 2) & 1) << 4) | (((L >> 4) & 3) << 2) | (L & 3); }
__device__ __forceinline__ int rope_lambda(int dd, int half) { const int hf = dd / half, i = dd % half; return 16 * (i >> 3) + 8 * hf + (i & 7); }
__device__ __forceinline__ int keypos_of(int key) { return (key & ~12) | ((key & 4) << 1) | ((key & 8) >> 1); }
enum { KNAT = 0, KSWI = 1, KIN = 2, KUQ = 3, KUKV = 4 };
__device__ __forceinline__ int dstrow(int kind, int which, int c) {
    if (kind == KNAT) return c;
    if (kind == KSWI) { const int pn = c >> 7, cg = c & 127; return pn * 256 + ((((cg >> 2) & 1) << 7) | (((cg >> 5) & 3) << 5) | (which << 4) | (((cg >> 3) & 3) << 2) | (cg & 3)); }
    if (kind == KIN) {
        int tile, L;
        if (c < 256) { tile = 0; L = c; }
        else if (c < 640) { const int q = c - 256; tile = 1 + (q >> 8); L = q & 255; }
        else if (c < 896) { tile = 3; L = c - 640; }
        else if (c < 928) { tile = 2; L = 128 + rope_lambda(c - 896, 16); }
        else if (c < 1952) { int qq = c - 928; const int isk = qq >= 512 ? 1 : 0; qq &= 511; const int hd = qq >> 6; tile = 4 + 2 * isk + (hd >> 2); L = 64 * (hd & 3) + rope_lambda(qq & 63, 32); }
        else { const int vv = c - 1952; tile = 8 + (vv >> 8); L = vv & 255; }
        return tile * 256 + slot_of_L(L);
    }
    if (kind == KUQ) { const int head = c / 96, dd = c % 96; const int Lh = dd < 64 ? dd : 64 + rope_lambda(dd - 64, 16); const int L = 128 * (head & 1) + Lh; return (head >> 1) * 256 + slot_of_L(L); }
      { const int head = c >> 7, dd = c & 127; const int tile = dd >> 6; const int L = 64 * head + (dd & 63); return tile * 256 + slot_of_L(L); }
}

struct EpiSwiGLU {
    bf16_t* __restrict__ G;
    __device__ __forceinline__ void operator()(const f32x4 (&acc)[2][2][4][2], const Unit& u, int wr, int wc, int fr_, int fq_) const {
        const int tq_ = opaque_tid(); const int fr = tq_ & 15, fq = (tq_ >> 4) & 3; (void)fr_; (void)fq_;
        const int row0 = u.pm * 256 + wr * 64 + fr, col0 = u.pn * 128 + wc * 32 + fq * 8;
#pragma unroll
        for (int ai = 0; ai < 2; ++ai)
#pragma unroll
            for (int m = 0; m < 4; ++m) {
                float o[8];
#pragma unroll
                for (int bj = 0; bj < 2; ++bj)
#pragma unroll
                    for (int j = 0; j < 4; ++j) { const float a = acc[ai][bj][m][0][j], b = acc[ai][bj][m][1][j]; o[bj * 4 + j] = a * fast_rcp(1.f + fast_exp2(-a * LOG2E)) * b; }
                u32x4 w; w.x = cvt_pk_bf16(o[0], o[1]); w.y = cvt_pk_bf16(o[2], o[3]); w.z = cvt_pk_bf16(o[4], o[5]); w.w = cvt_pk_bf16(o[6], o[7]);
                *(u32x4*)(G + (size_t)(row0 + ai * 128 + m * 16) * DFF + col0) = w;
            }
    }
};
struct EpiResid {
    const float* Hin; const float* Hin_ctx; float* Hout; const float* gate_l; float sc;
    __device__ __forceinline__ void operator()(const f32x4 (&acc)[2][2][4][2], const Unit& u, int wr, int wc, int fr_, int fq_) const {
        const int tq_ = opaque_tid(); const int fr = tq_ & 15, fq = (tq_ >> 4) & 3; (void)fr_; (void)fq_;
        const int bi = u.pm < 256 ? (u.pm >> 4) : 16;
        const int row0 = u.pm * 256 + wr * 64 + fr, col0 = u.pn * 256 + wc * 32 + 4 * fq;
        const float* gate = gate_l + (size_t)bi * 9216 + col0;
        const float* hin = u.pm < 256 ? Hin : Hin_ctx;
        f32x4 gv[2][2];
#pragma unroll
        for (int bj = 0; bj < 2; ++bj)
#pragma unroll
            for (int n = 0; n < 2; ++n) gv[bj][n] = *(const f32x4*)(gate + bj * 128 + n * 16) * sc;
        f32x4 hb[3][2][2];
#define RES_LOAD(g_, st_) { const size_t base_ = (size_t)(row0 + ((g_) >> 2) * 128 + ((g_) & 3) * 16) * DM + col0; \
            _Pragma("unroll") for (int bj = 0; bj < 2; ++bj) _Pragma("unroll") for (int n = 0; n < 2; ++n) hb[st_][bj][n] = *(const f32x4*)(hin + base_ + bj * 128 + n * 16); }
        RES_LOAD(0, 0); RES_LOAD(1, 1);
#pragma unroll
        for (int g = 0; g < 8; ++g) {
            if (g + 2 < 8) { RES_LOAD(g + 2, (g + 2) % 3); }
            const int ai = g >> 2, m = g & 3;
            const size_t base = (size_t)(row0 + ai * 128 + m * 16) * DM + col0;
#pragma unroll
            for (int bj = 0; bj < 2; ++bj)
#pragma unroll
                for (int n = 0; n < 2; ++n) *(f32x4*)(Hout + base + bj * 128 + n * 16) = hb[g % 3][bj][n] + gv[bj][n] * acc[ai][bj][m][n];
        }
#undef RES_LOAD
    }
};
struct EpiPartial {
    float* __restrict__ P;
    __device__ __forceinline__ void operator()(const f32x4 (&acc)[2][2][4][2], const Unit& u, int wr, int wc, int fr_, int fq_) const {
        const int tq_ = opaque_tid(); const int fr = tq_ & 15, fq = (tq_ >> 4) & 3; (void)fr_; (void)fq_;
        const int row0 = u.pm * 256 + wr * 64 + fr, col0 = u.pn * 256 + wc * 32 + 4 * fq;
#pragma unroll
        for (int ai = 0; ai < 2; ++ai)
#pragma unroll
            for (int m = 0; m < 4; ++m) {
                float* hp = P + (size_t)(row0 + ai * 128 + m * 16) * DM + col0;
#pragma unroll
                for (int bj = 0; bj < 2; ++bj)
#pragma unroll
                    for (int n = 0; n < 2; ++n) *(f32x4*)(hp + bj * 128 + n * 16) = acc[ai][bj][m][n];
            }
    }
};
__device__ __forceinline__ void store16bf(bf16_t* dst, const float (&v)[16]) {
    u32x4 w0, w1;
    w0.x = cvt_pk_bf16(v[0], v[1]); w0.y = cvt_pk_bf16(v[2], v[3]); w0.z = cvt_pk_bf16(v[4], v[5]); w0.w = cvt_pk_bf16(v[6], v[7]);
    w1.x = cvt_pk_bf16(v[8], v[9]); w1.y = cvt_pk_bf16(v[10], v[11]); w1.z = cvt_pk_bf16(v[12], v[13]); w1.w = cvt_pk_bf16(v[14], v[15]);
    *(u32x4*)dst = w0; *(u32x4*)(dst + 8) = w1;
}
__device__ __forceinline__ void rope16(float (&v)[16], const float* tab) {
#pragma unroll
    for (int q = 0; q < 4; ++q) {
        const f32x4 cs = *(const f32x4*)(tab + q * 4);
        { const float x1 = v[2 * q], x2 = v[8 + 2 * q]; v[2 * q] = x1 * cs[0] - x2 * cs[1]; v[8 + 2 * q] = x1 * cs[1] + x2 * cs[0]; }
        { const float x1 = v[2 * q + 1], x2 = v[9 + 2 * q]; v[2 * q + 1] = x1 * cs[2] - x2 * cs[3]; v[9 + 2 * q] = x1 * cs[3] + x2 * cs[2]; }
    }
}
__device__ __forceinline__ void store_vt(LAS unsigned char* tw, const float (&v)[16], int fr, int fq, bf16_t* vt) {
    const int pos = ((fr & 4) << 1) | ((fr & 8) >> 1) | (fr & 3);
#pragma unroll
    for (int e = 0; e < 16; ++e) *(LAS bf16_t*)(tw + (16 * fq + e) * 48 + pos * 2) = f2bf(v[e]);
    const int lane = fq * 16 + fr;
#pragma unroll
    for (int i = 0; i < 2; ++i) { const int ch = lane + 64 * i, col = ch >> 1, half = ch & 1;
        const u32x4 w = *(const LAS u32x4*)(tw + col * 48 + half * 16);
        *(u32x4*)(vt + (size_t)col * KVL + half * 8) = w; }
}
struct EpiIn {
    float* __restrict__ U; bf16_t* __restrict__ CQ; bf16_t* __restrict__ CKV; float* __restrict__ SSQ; bf16_t* __restrict__ QD; bf16_t* __restrict__ KD; bf16_t* __restrict__ VTD; bf16_t* __restrict__ KM; const float* __restrict__ ROPED; const float* __restrict__ ROPEM; LAS unsigned char* tl;
    __device__ __forceinline__ void operator()(const f32x4 (&acc)[2][2][4][2], const Unit& u, int wr, int wc, int fr_, int fq_) const {
        const int tq_ = opaque_tid(); const int fr = tq_ & 15, fq = (tq_ >> 4) & 3; (void)fr_; (void)fq_;
        const int pn = u.pn, L0 = 64 * wc + 16 * fq;
#pragma unroll
        for (int ai = 0; ai < 2; ++ai)
#pragma unroll
            for (int m = 0; m < 4; ++m) {
                const int row = u.pm * 256 + ai * 128 + wr * 64 + m * 16 + fr;
                const bool lat = u.pm < 256;
                const int b = lat ? (row >> 12) : ((row - NLAT) >> 8);
                const int key = lat ? (CTXL + (row & 4095)) : ((row - NLAT) & 255);
                const int pos = row & 4095;
                float v[16];
#pragma unroll
                for (int bj = 0; bj < 2; ++bj)
#pragma unroll
                    for (int n = 0; n < 2; ++n)
#pragma unroll
                        for (int j = 0; j < 4; ++j) v[8 * bj + 4 * n + j] = acc[ai][bj][m][n][j];
                if (pn == 0) {
                    float* d = U + (size_t)row * 256 + L0;
#pragma unroll
                    for (int q = 0; q < 4; ++q) *(f32x4*)(d + 4 * q) = (f32x4){v[4 * q], v[4 * q + 1], v[4 * q + 2], v[4 * q + 3]};
                } else if (pn <= 3) {
                    if (pn == 2 && wc >= 2) {
                        if (wc == 2 && fq < 2) {
                            if (lat) rope16(v, ROPEM + ((size_t)pos * 16 + 8 * fq) * 2);
#pragma unroll
                            for (int h = 0; h < 4; ++h) store16bf(KM + ((size_t)(b * 4 + h) * KVL + key) * 96 + 64 + 16 * fq, v);
                        }
                    } else {
                        float s = 0.f;
#pragma unroll
                        for (int e = 0; e < 16; ++e) s += v[e] * v[e];
                        { const int ln = fq * 16 + fr; s += shx(s, 16, ln); s += shx(s, 32, ln); }
                        if (pn < 3) { store16bf(CQ + (size_t)row * 384 + (pn - 1) * 256 + L0, v); if (fq == 0) SSQ[(size_t)row * 16 + (pn - 1) * 4 + wc] = s; }
                        else { store16bf(CKV + (size_t)row * 256 + L0, v); if (fq == 0) SSQ[(size_t)row * 16 + 8 + wc] = s; }
                    }
                } else if (pn <= 7) {
                    const int hd = 4 * ((pn - 4) & 1) + wc;
                    if (lat) rope16(v, ROPED + ((size_t)pos * 32 + 8 * fq) * 2);
                    if (pn <= 5) {
                        const float qs = 0.125f * LOG2E;
#pragma unroll
                        for (int e = 0; e < 16; ++e) v[e] *= qs;
                        store16bf(QD + (size_t)row * 512 + hd * 64 + 16 * fq, v);
                    } else store16bf(KD + ((size_t)(b * 8 + hd) * KVL + key) * 64 + 16 * fq, v);
                } else {
                    const int h = 2 * (pn - 8) + (wc >> 1);
                    store_vt(tl + (wr * 4 + wc) * 3072, v, fr, fq, VTD + ((size_t)(b * 4 + h) * 128 + 64 * (wc & 1)) * KVL + (key - fr));
                }
            }
    }
};
struct EpiQup {
    const float* __restrict__ SSQ; bf16_t* __restrict__ QM; const float* __restrict__ ROPEM;
    __device__ __forceinline__ void operator()(const f32x4 (&acc)[2][2][4][2], const Unit& u, int wr, int wc, int fr_, int fq_) const {
        const int tq_ = opaque_tid(); const int fr = tq_ & 15, fq = (tq_ >> 4) & 3; (void)fr_; (void)fq_;
        const int head = 2 * u.pn + (wc >> 1), part = wc & 1;
        if (part == 1 && fq >= 2) return;
#pragma unroll
        for (int ai = 0; ai < 2; ++ai)
#pragma unroll
            for (int m = 0; m < 4; ++m) {
                const int row = u.pm * 256 + ai * 128 + wr * 64 + m * 16 + fr;
                const f32x4 s4 = *(const f32x4*)(SSQ + (size_t)row * 16); const f32x2 s2 = *(const f32x2*)(SSQ + (size_t)row * 16 + 4);
                const float ss = (s4[0] + s4[1]) + (s4[2] + s4[3]) + (s2[0] + s2[1]);
                const float sc = rsqrtf(ss * (1.f / 384.f) + EPS) * (0.10206207261596577f * LOG2E);
                float v[16];
#pragma unroll
                for (int bj = 0; bj < 2; ++bj)
#pragma unroll
                    for (int n = 0; n < 2; ++n)
#pragma unroll
                        for (int j = 0; j < 4; ++j) v[8 * bj + 4 * n + j] = acc[ai][bj][m][n][j] * sc;
                if (part == 1 && u.pm < 256) rope16(v, ROPEM + ((size_t)(row & 4095) * 16 + 8 * fq) * 2);
                store16bf(QM + (size_t)row * 384 + head * 96 + 64 * part + 16 * fq, v);
            }
    }
};
struct EpiKVup {
    const float* __restrict__ SSQ; bf16_t* __restrict__ KM; bf16_t* __restrict__ VTM; LAS unsigned char* tl;
    __device__ __forceinline__ void operator()(const f32x4 (&acc)[2][2][4][2], const Unit& u, int wr, int wc, int fr_, int fq_) const {
        const int tq_ = opaque_tid(); const int fr = tq_ & 15, fq = (tq_ >> 4) & 3; (void)fr_; (void)fq_;
#pragma unroll
        for (int ai = 0; ai < 2; ++ai)
#pragma unroll
            for (int m = 0; m < 4; ++m) {
                const int row = u.pm * 256 + ai * 128 + wr * 64 + m * 16 + fr;
                const bool lat = u.pm < 256;
                const int b = lat ? (row >> 12) : ((row - NLAT) >> 8);
                const int key = lat ? (CTXL + (row & 4095)) : ((row - NLAT) & 255);
                const f32x4 s4 = *(const f32x4*)(SSQ + (size_t)row * 16 + 8);
                const float sc = rsqrtf(((s4[0] + s4[1]) + (s4[2] + s4[3])) * (1.f / 256.f) + EPS);
                float v[16];
#pragma unroll
                for (int bj = 0; bj < 2; ++bj)
#pragma unroll
                    for (int n = 0; n < 2; ++n)
#pragma unroll
                        for (int j = 0; j < 4; ++j) v[8 * bj + 4 * n + j] = acc[ai][bj][m][n][j] * sc;
                if (u.pn == 0) store16bf(KM + ((size_t)(b * 4 + wc) * KVL + key) * 96 + 16 * fq, v);
                else {
                    store_vt(tl + (wr * 4 + wc) * 3072, v, fr, fq, VTM + ((size_t)(b * 4 + wc) * 64) * KVL + (key - fr));
                }
            }
    }
};

__constant__ float c_invfreq[24] = {1.000000000e+00f, 5.623413324e-01f, 3.162277639e-01f, 1.778279394e-01f, 1.000000015e-01f, 5.623413250e-02f, 3.162277490e-02f, 1.778279431e-02f, 9.999999776e-03f, 5.623413250e-03f, 3.162277630e-03f, 1.778279431e-03f, 1.000000047e-03f, 5.623413017e-04f, 3.162277571e-04f, 1.778279402e-04f, 1.000000000e+00f, 3.162277639e-01f, 1.000000015e-01f, 3.162277490e-02f, 9.999999776e-03f, 3.162277630e-03f, 1.000000047e-03f, 3.162277571e-04f};
__device__ void phase_init(const Params& p, LAS unsigned char* lds) {
    const int tid = opaque_tid();
    const size_t gtid = (size_t)blockIdx.x * 512 + tid, gsz = (size_t)gridDim.x * 512;
    for (size_t i = gtid; i < (size_t)4096 * 48; i += gsz) {
        int pos, a, use_row; float* dst;
        if (i < (size_t)4096 * 32) { pos = (int)(i >> 5); const int ii = (int)(i & 31); a = ii & 15; use_row = ii < 16; dst = p.ROPED + 2 * i; }
        else { const size_t j = i - (size_t)4096 * 32; pos = (int)(j >> 4); const int ii = (int)(j & 15); a = 16 + (ii & 7); use_row = ii < 8; dst = p.ROPEM + 2 * j; }
        const float ang = (float)(use_row ? (pos >> 6) : (pos & 63)) * c_invfreq[a];
        const float kq = rintf(ang * 0.636619772f);
        float r = fmaf(-kq, 1.570770263671875f, ang); r = fmaf(-kq, 2.6063062250614166e-05f, r); r = fmaf(-kq, 6.077094383272197e-11f, r);
        const float r2 = r * r;
        const float sn = r * (1.f + r2 * (-1.6666667e-1f + r2 * (8.3333333e-3f + r2 * (-1.9841270e-4f + r2 * 2.7557319e-6f))));
        const float cs = 1.f + r2 * (-0.5f + r2 * (4.1666667e-2f + r2 * (-1.3888889e-3f + r2 * (2.4801587e-5f + r2 * (-2.7557319e-7f)))));
        const int qd = ((int)kq) & 3;
        dst[0] = qd == 0 ? cs : qd == 1 ? -sn : qd == 2 ? -cs : sn;
        dst[1] = qd == 0 ? sn : qd == 1 ? cs : qd == 2 ? -sn : -cs;
    }
    LAS float* sct = (LAS float*)lds;
    LAS float* red = (LAS float*)(lds + 81920);
    for (int i = tid; i < 17 * 1024; i += 512) { const int bi = i >> 10, k = i & 1023; const float cv = bi < 16 ? p.c[bi * 1024 + k] : p.c_ctx[k]; sct[k * 20 + bi] = cv / (1.f + __expf(-cv)); }
    __syncthreads();
    const int col = tid & 127, kg = tid >> 7;
    for (int u = blockIdx.x; u < DEPTH * 72; u += gridDim.x) {
        const int l = u / 72, n0 = (u % 72) * 128;
        const float* w = p.w_mod + (size_t)l * 1024 * 9216 + n0 + col;
        float a[17];
#pragma unroll
        for (int q = 0; q < 17; ++q) a[q] = 0.f;
#pragma unroll 4
        for (int k = kg * 256; k < kg * 256 + 256; ++k) {
            const float wv = w[(size_t)k * 9216];
            const f32x4 s0 = *(const LAS f32x4*)(sct + k * 20), s1 = *(const LAS f32x4*)(sct + k * 20 + 4), s2 = *(const LAS f32x4*)(sct + k * 20 + 8), s3 = *(const LAS f32x4*)(sct + k * 20 + 12);
            const float s16 = sct[k * 20 + 16];
#pragma unroll
            for (int q = 0; q < 4; ++q) { a[q] += s0[q] * wv; a[4 + q] += s1[q] * wv; a[8 + q] += s2[q] * wv; a[12 + q] += s3[q] * wv; }
            a[16] += s16 * wv;
        }
#pragma unroll
        for (int q = 0; q < 17; ++q) red[(kg * 17 + q) * 128 + col] = a[q];
        __syncthreads();
        for (int i = tid; i < 17 * 128; i += 512) { const int bi = i >> 7, cc = i & 127;
            const float s = (red[(0 * 17 + bi) * 128 + cc] + red[(1 * 17 + bi) * 128 + cc]) + (red[(2 * 17 + bi) * 128 + cc] + red[(3 * 17 + bi) * 128 + cc]);
            p.MODS[((size_t)l * 17 + bi) * 9216 + n0 + cc] = s + p.b_mod[(size_t)l * 9216 + n0 + cc]; }
        __syncthreads();
    }
}

__device__ void phase_norm(const float* H, const float* Hctx, int nrows, const float* gw, const float* mods_l, int shift_idx, int scale_idx, bf16_t* outb, float* outf,
                           const float* P4, const float* pgate, float psc, float* Hw) {
    const int tid = opaque_tid(); const int wid = tid >> 6, lane = tid & 63;
    for (int row = blockIdx.x * 8 + wid; row < nrows; row += gridDim.x * 8) {
        const float* hr = (row < NLAT ? H : Hctx) + (size_t)row * DM + lane * 4;
        f32x4 v[4]; float ss = 0.f;
#pragma unroll
        for (int q = 0; q < 4; ++q) v[q] = *(const f32x4*)(hr + q * 256);
        if (P4 && row >= NLAT) {
            const float* pr = P4 + (size_t)(row - NLAT) * DM + lane * 4;
#pragma unroll
            for (int q = 0; q < 4; ++q) { const f32x4 s4 = (*(const f32x4*)(pr + q * 256) + *(const f32x4*)(pr + (size_t)NCTX * DM + q * 256)) + (*(const f32x4*)(pr + (size_t)2 * NCTX * DM + q * 256) + *(const f32x4*)(pr + (size_t)3 * NCTX * DM + q * 256));
                v[q] += (*(const f32x4*)(pgate + lane * 4 + q * 256) * psc) * s4; *(f32x4*)(Hw + (size_t)row * DM + lane * 4 + q * 256) = v[q]; }
        }
#pragma unroll
        for (int q = 0; q < 4; ++q) ss += (v[q][0] * v[q][0] + v[q][1] * v[q][1]) + (v[q][2] * v[q][2] + v[q][3] * v[q][3]);
        ss += __builtin_bit_cast(float, __builtin_amdgcn_update_dpp(0, __builtin_bit_cast(int, ss), 0xB1, 0xF, 0xF, true));
        ss += __builtin_bit_cast(float, __builtin_amdgcn_update_dpp(0, __builtin_bit_cast(int, ss), 0x4E, 0xF, 0xF, true));
        ss += __builtin_bit_cast(float, __builtin_amdgcn_update_dpp(0, __builtin_bit_cast(int, ss), 0x141, 0xF, 0xF, true));
        ss += __builtin_bit_cast(float, __builtin_amdgcn_update_dpp(0, __builtin_bit_cast(int, ss), 0x140, 0xF, 0xF, true));
        ss += shx(ss, 16, lane); ss += shx(ss, 32, lane);
        const float rstd = rsqrtf(ss * (1.f / DM) + EPS);
        if (outb) {
            const int bi = row < NLAT ? (row >> 12) : 16;
            const float* sh = mods_l + (size_t)bi * 9216 + shift_idx * 1024 + lane * 4; const float* sc = mods_l + (size_t)bi * 9216 + scale_idx * 1024 + lane * 4;
#pragma unroll
            for (int q = 0; q < 4; ++q) {
                const f32x4 g = *(const f32x4*)(gw + lane * 4 + q * 256), s = *(const f32x4*)(sc + q * 256), t = *(const f32x4*)(sh + q * 256);
                const f32x4 y = (v[q] * rstd * g) * (s + 1.f) + t;
                u32x2 w; w.x = cvt_pk_bf16(y[0], y[1]); w.y = cvt_pk_bf16(y[2], y[3]);
                *(u32x2*)(outb + (size_t)row * DM + lane * 4 + q * 256) = w;
            }
        } else {
#pragma unroll
            for (int q = 0; q < 4; ++q) { const f32x4 g = *(const f32x4*)(gw + lane * 4 + q * 256); *(f32x4*)(outf + (size_t)row * DM + lane * 4 + q * 256) = v[q] * rstd * g; }
        }
    }
}

__device__ void phase_convert(const Params& p, int l, LAS unsigned char* lds) {
    LAS float* tile = (LAS float*)lds;
    const int tid = opaque_tid();
    for (int u = blockIdx.x; u < 5176; u += gridDim.x) {
        const float* src; int Nsrc, K; bf16_t* dst; int kind = KNAT, which = 0; const float* ksc = nullptr; int t = u;
        if (t < 4224) { const int j = t / 704; t %= 704; const int f = j / 3, mm = j % 3;
            if (mm < 2) { src = (f ? (mm ? p.ffn2_w3 : p.ffn2_w1) : (mm ? p.ffn1_w3 : p.ffn1_w1)) + (size_t)l * DM * DFF; Nsrc = DFF; K = DM; dst = f ? p.Bt13b : p.Bt13a; kind = KSWI; which = mm; }
            else { src = (f ? p.ffn2_w2 : p.ffn1_w2) + (size_t)l * DFF * DM; Nsrc = DM; K = DFF; dst = f ? p.Bt2b : p.Bt2a; } }
        else if ((t -= 4224) < 624) { src = p.w_in + (size_t)l * DM * INW; Nsrc = INW; K = DM; dst = p.Btin; kind = KIN; }
        else if ((t -= 624) < 256) { src = p.w_out + (size_t)l * DM * DM; Nsrc = DM; K = DM; dst = p.Btout; }
        else if ((t -= 256) < 36) { src = p.mla_w_uq + (size_t)l * 384 * 384; Nsrc = 384; K = 384; dst = p.Btuq; kind = KUQ; ksc = p.mla_q_norm + l * 384; }
        else if ((t -= 36) < 32) { src = p.mla_w_ukv + (size_t)l * 256 * 512; Nsrc = 512; K = 256; dst = p.Btukv; kind = KUKV; ksc = p.mla_kv_norm + l * 256; }
        else { t -= 32; src = p.pool_w + (size_t)(l * 4 + t) * 4096; Nsrc = 64; K = 64; dst = p.Btpool + t * 4096; t = 0; }
        const int nkt = K / 64; const int c0 = (t / nkt) * 64, k0 = (t % nkt) * 64;
        { const int cl = tid & 63, ks = tid >> 6; const int c = c0 + cl;
#pragma unroll
          for (int kk = 0; kk < 8; ++kk) { const int k = ks + 8 * kk; tile[k * 65 + cl] = c < Nsrc ? src[(size_t)(k0 + k) * Nsrc + c] : 0.f; } }
        __syncthreads();
        { const int cl = tid >> 3, kseg = tid & 7; const int c = c0 + cl;
          if (c < Nsrc) { const int row = dstrow(kind, which, c); float v[8];
#pragma unroll
              for (int i = 0; i < 8; ++i) v[i] = tile[(kseg * 8 + i) * 65 + cl] * (ksc ? ksc[k0 + kseg * 8 + i] : 1.f);
              u32x4 w; w.x = cvt_pk_bf16(v[0], v[1]); w.y = cvt_pk_bf16(v[2], v[3]); w.z = cvt_pk_bf16(v[4], v[5]); w.w = cvt_pk_bf16(v[6], v[7]);
              *(u32x4*)(dst + (size_t)row * K + k0 + kseg * 8) = w; } }
        __syncthreads();
    }
}

template <int K> __device__ __forceinline__ void win_sum(const float* base, size_t stride, int cnt, f32x4& s0, f32x4& s1) {
    f32x4 v0[K], v1[K];
#pragma unroll
    for (int i = 0; i < K; ++i) { const float* q = base + (size_t)min(i, cnt - 1) * stride; v0[i] = *(const f32x4*)q; v1[i] = *(const f32x4*)(q + 4); }
#pragma unroll
    for (int i = 0; i < K; ++i) { const float w = i < cnt ? 1.f : 0.f; s0 += v0[i] * w; s1 += v1[i] * w; }
}
__device__ __forceinline__ void win_sum_g(int g, const float* base, size_t stride, int cnt, f32x4& s0, f32x4& s1) {
    if (g == 0) win_sum<2>(base, stride, cnt, s0, s1); else if (g == 1) win_sum<4>(base, stride, cnt, s0, s1); else if (g == 2) win_sum<8>(base, stride, cnt, s0, s1); else win_sum<16>(base, stride, cnt, s0, s1);
}
__device__ void phase_pool(const Params& p, int l, bool with_ctx, LAS unsigned char* lds) {
    LAS float* V = (LAS float*)lds;
    LAS bf16_t* Dm = (LAS bf16_t*)(lds + 17408);
    const int tid = opaque_tid(), wid = tid >> 6, lane = tid & 63, c16 = lane & 15, gq = lane >> 4;
    const int c = tid >> 3, ch0 = (tid & 7) * 8;
    const int nunits = 4096 + (with_ctx ? 256 : 0);
    const float* ps = p.pool_scale + l * 256;
    for (int uu = blockIdx.x; uu < nunits; uu += gridDim.x) {
        const int u = (uu & ~255) | ((uu & 7) << 5) | ((uu & 255) >> 3);
        const bool lat = u < 4096; int b, g, r, tok0;
        if (lat) { b = u >> 8; g = (u >> 6) & 3; r = u & 63; tok0 = b * 4096 + r * 64; }
        else { const int uu = u - 4096; b = uu >> 4; g = (uu >> 2) & 3; r = uu & 3; tok0 = NLAT + b * 256 + r * 64; }
        const int k = 2 << g, lo = k >> 1, hi = k - 1 - lo;
        const float* Ug = p.U + g * 64 + ch0;
        f32x4 m0 = (f32x4){0.f, 0.f, 0.f, 0.f}, m1 = m0; float inv;
        if (lat) {
            const int r0 = max(r - lo, 0), r1 = min(r + hi, 63);
            f32x4 a0 = m0, a1 = m0;
            win_sum_g(g, Ug + (size_t)(b * 4096 + r0 * 64 + c) * 256, (size_t)64 * 256, r1 - r0 + 1, a0, a1);
            const float ir = 1.f / (float)(r1 - r0 + 1);
            *(LAS f32x4*)(V + c * 68 + ch0) = a0 * ir; *(LAS f32x4*)(V + c * 68 + ch0 + 4) = a1 * ir;
            __syncthreads();
            const int cc0 = max(c - lo, 0), cc1 = min(c + hi, 63);
            for (int cc = cc0; cc <= cc1; ++cc) { m0 += *(const LAS f32x4*)(V + cc * 68 + ch0); m1 += *(const LAS f32x4*)(V + cc * 68 + ch0 + 4); }
            inv = 1.f / (float)(cc1 - cc0 + 1);
        } else {
            const int i = r * 64 + c, i0 = max(i - lo, 0), i1 = min(i + hi, 255);
            win_sum_g(g, Ug + (size_t)(NLAT + b * 256 + i0) * 256, (size_t)256, i1 - i0 + 1, m0, m1);
            inv = 1.f / (float)(i1 - i0 + 1);
        }
        { const float* q = Ug + (size_t)(tok0 + c) * 256; const f32x4 u0 = *(const f32x4*)q, u1 = *(const f32x4*)(q + 4);
          const f32x4 d0 = m0 * inv - u0, d1 = m1 * inv - u1;
          u32x4 w; w.x = cvt_pk_bf16(d0[0], d0[1]); w.y = cvt_pk_bf16(d0[2], d0[3]); w.z = cvt_pk_bf16(d1[0], d1[1]); w.w = cvt_pk_bf16(d1[2], d1[3]);
          *(LAS u32x4*)(Dm + c * 72 + ch0) = w; }
        __syncthreads();
        const int tb = wid >> 1;
#pragma unroll
        for (int o = 0; o < 2; ++o) {
            const int ob = (wid & 1) * 2 + o; f32x4 acc = (f32x4){0.f, 0.f, 0.f, 0.f};
#pragma unroll
            for (int ks = 0; ks < 2; ++ks) {
                const bf16x8 a = *(const bf16x8*)(p.Btpool + g * 4096 + (ob * 16 + c16) * 64 + ks * 32 + gq * 8);
                const bf16x8 bb = *(const LAS bf16x8*)(Dm + (tb * 16 + c16) * 72 + ks * 32 + gq * 8);
                acc = __builtin_amdgcn_mfma_f32_16x16x32_bf16(a, bb, acc, 0, 0, 0);
            }
            const int tok = tok0 + tb * 16 + c16, oc = g * 64 + ob * 16 + 4 * gq;
            const f32x4 sc = *(const f32x4*)(ps + oc);
            u32x2 w; w.x = cvt_pk_bf16(acc[0] * sc[0], acc[1] * sc[1]); w.y = cvt_pk_bf16(acc[2] * sc[2], acc[3] * sc[3]);
            *(u32x2*)(p.XN + (size_t)tok * DM + oc) = w;
        }
        __syncthreads();
    }
}

typedef float f32x16 __attribute__((ext_vector_type(16)));
#define ROWMAX32(out, A, B) do { \
    asm("v_max3_f32 %0, %1, %2, %3\n\tv_max3_f32 %0, %0, %4, %5\n\tv_max3_f32 %0, %0, %6, %7\n\tv_max3_f32 %0, %0, %8, %9\n\tv_max3_f32 %0, %0, %10, %11\n\tv_max3_f32 %0, %0, %12, %13\n\tv_max3_f32 %0, %0, %14, %15\n\tv_max3_f32 %0, %0, %16, %16" \
        : "=&v"(out) : "v"((A)[0]), "v"((A)[1]), "v"((A)[2]), "v"((A)[3]), "v"((A)[4]), "v"((A)[5]), "v"((A)[6]), "v"((A)[7]), "v"((A)[8]), "v"((A)[9]), "v"((A)[10]), "v"((A)[11]), "v"((A)[12]), "v"((A)[13]), "v"((A)[14]), "v"((A)[15])); \
    asm("v_max3_f32 %0, %0, %1, %2\n\tv_max3_f32 %0, %0, %3, %4\n\tv_max3_f32 %0, %0, %5, %6\n\tv_max3_f32 %0, %0, %7, %8\n\tv_max3_f32 %0, %0, %9, %10\n\tv_max3_f32 %0, %0, %11, %12\n\tv_max3_f32 %0, %0, %13, %14\n\tv_max3_f32 %0, %0, %15, %16" \
        : "+v"(out) : "v"((B)[0]), "v"((B)[1]), "v"((B)[2]), "v"((B)[3]), "v"((B)[4]), "v"((B)[5]), "v"((B)[6]), "v"((B)[7]), "v"((B)[8]), "v"((B)[9]), "v"((B)[10]), "v"((B)[11]), "v"((B)[12]), "v"((B)[13]), "v"((B)[14]), "v"((B)[15])); } while (0)

template <int DQK, int DV, bool DIFF>
__device__ __forceinline__ void attn_unit(LAS unsigned char* lds, const bf16_t* Qp, int ldq, const bf16_t* Kp, size_t kmap_stride, const bf16_t* Vtp, int kv_len,
                                          bf16_t* outp  , float lam, float post, const float* subln) {
    constexpr int NMAP = DIFF ? 2 : 1;
    constexpr int KROW = DQK * 2 + 16, VROW = 144, KBYTES = 64 * KROW, VBYTES = DV * VROW, KBUF = NMAP * KBYTES, OFFV = 2 * KBUF;
    constexpr int KC8 = DQK / 8, KCH = NMAP * 64 * KC8, VCH = DV * 8, NLK = (KCH + 511) / 512, NLV = (VCH + 511) / 512, NKS = DQK / 16, NDB = DV / 32;
    const int tid = opaque_tid(), wid = tid >> 6, lane = tid & 63, q32 = lane & 31, h = lane >> 5;
    const int qg = DIFF ? (wid >> 1) : wid, mp = DIFF ? (wid & 1) : 0;
    bf16x8 qf[NKS];
    { const bf16_t* qr = Qp + (size_t)(qg * 32 + q32) * ldq + mp * 64 + h * 8;
#pragma unroll
      for (int ks = 0; ks < NKS; ++ks) qf[ks] = *(const bf16x8*)(qr + ks * 16); }
    f32x16 O[NDB];
#pragma unroll
    for (int db = 0; db < NDB; ++db)
#pragma unroll
        for (int j = 0; j < 16; ++j) O[db][j] = 0.f;
    float lsum = 0.f;
    f32x16 mneg;
#pragma unroll
    for (int j = 0; j < 16; ++j) mneg[j] = 0.f;
    u32x4 stk[NLK], stv[NLV];
    auto kchunk = [&](int i) { const int ch = tid + i * 512; return ch < KCH ? ch : ch - 256; };
    auto gloadK = [&](int t) {
#pragma unroll
        for (int i = 0; i < NLK; ++i) { const int ch = kchunk(i), mpc = ch / (64 * KC8), cc = ch % (64 * KC8); stk[i] = *(const u32x4*)(Kp + (size_t)mpc * kmap_stride + (size_t)t * 64 * DQK + cc * 8); } };
    auto lstoreK = [&](int t) {
#pragma unroll
        for (int i = 0; i < NLK; ++i) { const int ch = kchunk(i), mpc = ch / (64 * KC8), cc = ch % (64 * KC8); *(LAS u32x4*)(lds + (t & 1) * KBUF + mpc * KBYTES + (cc / KC8) * KROW + (cc % KC8) * 16) = stk[i]; } };
    static_assert(VCH % 512 == 0 && KCH >= 512 && KCH - 256 >= 0, "chunk maps");
    auto gloadV = [&](int t) {
#pragma unroll
        for (int i = 0; i < NLV; ++i) { const int cc = tid + i * 512; stv[i] = *(const u32x4*)(Vtp + (size_t)(cc >> 3) * KVL + t * 64 + (cc & 7) * 8); } };
    auto lstoreV = [&](int t) {
#pragma unroll
        for (int i = 0; i < NLV; ++i) { const int cc = tid + i * 512; *(LAS u32x4*)(lds + OFFV + (t & 1) * VBYTES + (cc >> 3) * VROW + (cc & 7) * 16) = stv[i]; } };
    const int nt = kv_len / 64;
    gloadK(0); gloadV(0); lstoreK(0); lstoreV(1);
    gloadK(1); lstoreK(1);
    __syncthreads();
    f32x16 Sc[2], Sn[2];
    {
        const LAS unsigned char* kb_ = lds + mp * KBYTES + q32 * KROW + h * 16;
#pragma unroll
        for (int kb = 0; kb < 2; ++kb) {
#pragma unroll
            for (int j = 0; j < 16; ++j) Sc[kb][j] = 0.f;
#pragma unroll
            for (int ks = 0; ks < NKS; ++ks) { const bf16x8 a = *(const LAS bf16x8*)(kb_ + kb * 32 * KROW + ks * 32); Sc[kb] = __builtin_amdgcn_mfma_f32_32x32x16_bf16(a, qf[ks], Sc[kb], 0, 0, 0); }
        }
    }
    __syncthreads();
    __builtin_amdgcn_sched_barrier(0);
    asm volatile("s_nop 15\n\ts_nop 15\n\ts_nop 15\n\ts_nop 15\n\ts_nop 15\n\ts_nop 15" ::: "memory");
    __builtin_amdgcn_sched_barrier(0);
    float lm_cur;
    ROWMAX32(lm_cur, Sc[0], Sc[1]);
    bf16x8 Pa[2][2], Pb[2][2];
#pragma unroll
    for (int kb = 0; kb < 2; ++kb)
#pragma unroll
        for (int s = 0; s < 2; ++s)
#pragma unroll
            for (int e = 0; e < 8; ++e) Pa[kb][s][e] = 0;
    auto step = [&](f32x16 (&Sa)[2], f32x16 (&Sb)[2], bf16x8 (&Pp)[2][2], bf16x8 (&Pn)[2][2], int t) {
        const float lm = lm_cur;
        if (t == 0 || __builtin_amdgcn_ballot_w64(lm > 8.f) != 0) {
            const float mx = fmaxf(lm, shx(lm, 32, lane));
            const float delta = (t == 0 || mx > 8.f) ? mx : 0.f;
            const float alpha = t == 0 ? 1.f : fast_exp2(-delta);
            lsum *= alpha;
#pragma unroll
            for (int j = 0; j < 16; ++j) { mneg[j] -= delta; Sa[0][j] -= delta; Sa[1][j] -= delta; }
#pragma unroll
            for (int db = 0; db < NDB; ++db) O[db] *= alpha;
#pragma unroll
            for (int kb = 0; kb < 2; ++kb)
#pragma unroll
                for (int s = 0; s < 2; ++s) { u32x4 w = __builtin_bit_cast(u32x4, Pp[kb][s]);
#pragma unroll
                    for (int e = 0; e < 4; ++e) w[e] = cvt_pk_bf16(__uint_as_float(w[e] << 16) * alpha, __uint_as_float(w[e] & 0xffff0000u) * alpha);
                    Pp[kb][s] = __builtin_bit_cast(bf16x8, w); }
        }
        gloadK(min(t + 2, nt - 1)); gloadV(t);
        const LAS unsigned char* kb_ = lds + ((t + 1) & 1) * KBUF + mp * KBYTES + q32 * KROW + h * 16;
        const LAS unsigned char* vb_ = lds + OFFV + ((t + 1) & 1) * VBYTES + q32 * VROW + h * 16;
        constexpr int NQK = 2 * NKS, NM = NQK + 4 * NDB, NG = NM / 4, PPG = (16 + NG - 1) / NG;
        static_assert(NM % 4 == 0, "MFMA groups of four");
        bf16x8 fr[2][4];
        float ps0 = 0.f;
        unsigned pk[2][8];
#define ATT_LOADGRP(g) _Pragma("unroll") for (int q_ = 0; q_ < 4; ++q_) { const int i_ = 4 * (g) + q_; \
            fr[(g) & 1][q_] = (i_ < NQK) ? *(const LAS bf16x8*)(kb_ + (i_ / NKS) * 32 * KROW + (i_ % NKS) * 32) \
                                         : *(const LAS bf16x8*)(vb_ + ((i_ - NQK) / 4) * 32 * VROW + (((i_ - NQK) / 2) & 1) * 64 + ((i_ - NQK) & 1) * 32); }
        ATT_LOADGRP(0);
#pragma unroll
        for (int g = 0; g < NG; ++g) {
            if (g + 1 < NG) { ATT_LOADGRP(g + 1); }
#pragma unroll
            for (int q_ = 0; q_ < 4; ++q_) { const int i_ = 4 * g + q_;
                if (i_ < NQK) { const int kb = i_ / NKS, ks = i_ % NKS;
                    if (ks == 0) Sb[kb] = __builtin_amdgcn_mfma_f32_32x32x16_bf16(fr[g & 1][q_], qf[ks], mneg, 0, 0, 0);
                    else Sb[kb] = __builtin_amdgcn_mfma_f32_32x32x16_bf16(fr[g & 1][q_], qf[ks], Sb[kb], 0, 0, 0); }
                else { const int j_ = i_ - NQK, db = j_ / 4, kb = (j_ / 2) & 1, sx = j_ & 1; O[db] = __builtin_amdgcn_mfma_f32_32x32x16_bf16(fr[g & 1][q_], Pp[kb][sx], O[db], 0, 0, 0); } }
#pragma unroll
            for (int pp = g * PPG; pp < (g + 1) * PPG && pp < 16; ++pp) { const int kb = pp / 8, j = pp % 8;
                Sa[kb][2 * j] = fast_exp2(Sa[kb][2 * j]); Sa[kb][2 * j + 1] = fast_exp2(Sa[kb][2 * j + 1]); }
            if (g > 0) {
#pragma unroll
                for (int pp = (g - 1) * PPG; pp < g * PPG && pp < 16; ++pp) { const int kb = pp / 8, j = pp % 8;
                    asm("v_add_f32 %0, %1, %2" : "=v"(ps0) : "v"(ps0), "v"(Sa[kb][2 * j])); asm("v_add_f32 %0, %1, %2" : "=v"(ps0) : "v"(ps0), "v"(Sa[kb][2 * j + 1]));
                    pk[kb][j] = cvt_pk_bf16(Sa[kb][2 * j], Sa[kb][2 * j + 1]); }
            }
            if (g == NG - 2) { lstoreK(t + 2); lstoreV(t); }
            if (g == NG - 1) {
                float lmn;
                ROWMAX32(lmn, Sb[0], Sb[1]);
                lm_cur = lmn;
            }
            __builtin_amdgcn_sched_barrier(0);
        }
#pragma unroll
        for (int pp = (NG - 1) * PPG; pp < 16; ++pp) { const int kb = pp / 8, j = pp % 8;
            asm("v_add_f32 %0, %1, %2" : "=v"(ps0) : "v"(ps0), "v"(Sa[kb][2 * j])); asm("v_add_f32 %0, %1, %2" : "=v"(ps0) : "v"(ps0), "v"(Sa[kb][2 * j + 1]));
            pk[kb][j] = cvt_pk_bf16(Sa[kb][2 * j], Sa[kb][2 * j + 1]); }
#undef ATT_LOADGRP
#pragma unroll
        for (int kb = 0; kb < 2; ++kb) { Pn[kb][0] = __builtin_bit_cast(bf16x8, (u32x4){pk[kb][0], pk[kb][1], pk[kb][2], pk[kb][3]}); Pn[kb][1] = __builtin_bit_cast(bf16x8, (u32x4){pk[kb][4], pk[kb][5], pk[kb][6], pk[kb][7]}); }
        lsum += ps0;
        __syncthreads();
    };
    for (int t = 0; t < nt; t += 2) { step(Sc, Sn, Pa, Pb, t); step(Sn, Sc, Pb, Pa, t + 1); }
    bf16x8 (&pfp)[2][2] = Pa;
    { const LAS unsigned char* vb_ = lds + OFFV + ((nt - 1) & 1) * VBYTES + q32 * VROW + h * 16;
#pragma unroll
      for (int db = 0; db < NDB; ++db)
#pragma unroll
          for (int kb = 0; kb < 2; ++kb)
#pragma unroll
              for (int s = 0; s < 2; ++s) { const bf16x8 a = *(const LAS bf16x8*)(vb_ + db * 32 * VROW + kb * 64 + s * 32); O[db] = __builtin_amdgcn_mfma_f32_32x32x16_bf16(a, pfp[kb][s], O[db], 0, 0, 0); } }
    __syncthreads();
    const float ltot = lsum + shx(lsum, 32, lane);
    const float inv = 1.f / ltot;
    bf16_t* orow = outp + (size_t)(qg * 32 + q32) * DM + 4 * h;
    if constexpr (!DIFF) {
#pragma unroll
        for (int db = 0; db < NDB; ++db)
#pragma unroll
            for (int jj = 0; jj < 4; ++jj) { u32x2 w; w.x = cvt_pk_bf16(O[db][4 * jj] * inv, O[db][4 * jj + 1] * inv); w.y = cvt_pk_bf16(O[db][4 * jj + 2] * inv, O[db][4 * jj + 3] * inv);
                *(u32x2*)(orow + db * 32 + jj * 8) = w; }
    } else {
        LAS float* X = (LAS float*)lds + (qg * 32 + q32) * 132 + 4 * h;
        if (mp == 1) { const float sc = lam * inv;
#pragma unroll
            for (int db = 0; db < NDB; ++db)
#pragma unroll
                for (int jj = 0; jj < 4; ++jj) *(LAS f32x4*)(X + db * 32 + jj * 8) = (f32x4){O[db][4 * jj] * sc, O[db][4 * jj + 1] * sc, O[db][4 * jj + 2] * sc, O[db][4 * jj + 3] * sc}; }
        __syncthreads();
        if (mp == 0) {
            float ss = 0.f;
#pragma unroll
            for (int db = 0; db < NDB; ++db)
#pragma unroll
                for (int jj = 0; jj < 4; ++jj) { const f32x4 x = *(const LAS f32x4*)(X + db * 32 + jj * 8);
#pragma unroll
                    for (int e = 0; e < 4; ++e) { const float o = O[db][4 * jj + e] * inv - x[e]; O[db][4 * jj + e] = o; ss += o * o; } }
            ss += shx(ss, 32, lane);
            float li_ = post; asm volatile("" : "+v"(li_));
            const float r = rsqrtf(ss * (1.f / DV) + EPS) * (1.f - li_);
#pragma unroll
            for (int db = 0; db < NDB; ++db)
#pragma unroll
                for (int jj = 0; jj < 4; ++jj) { const f32x4 gsub = *(const f32x4*)(subln + db * 32 + jj * 8 + 4 * h);
                    u32x2 w; w.x = cvt_pk_bf16(O[db][4 * jj] * r * gsub[0], O[db][4 * jj + 1] * r * gsub[1]); w.y = cvt_pk_bf16(O[db][4 * jj + 2] * r * gsub[2], O[db][4 * jj + 3] * r * gsub[3]);
                    *(u32x2*)(orow + db * 32 + jj * 8) = w; }
        }
        __syncthreads();
    }
}

__device__ void phase_attn(const Params& p, int l, bool with_ctx, LAS unsigned char* lds) {
    const float lam_init = 0.8f - 0.6f * expf(-0.3f * (float)l);
    const float* dl = p.diff_lambda + l * 256;
    float s1 = 0.f, s2 = 0.f;
    for (int i = 0; i < 64; ++i) { s1 += dl[i] * dl[64 + i]; s2 += dl[128 + i] * dl[192 + i]; }
    const float lam = __builtin_bit_cast(float, __builtin_amdgcn_readfirstlane(__builtin_bit_cast(int, expf(s1) - expf(s2) + lam_init)));
    const float post_scale = __builtin_bit_cast(float, __builtin_amdgcn_readfirstlane(__builtin_bit_cast(int, 1.f - lam_init)));
    const int total = 3072 + (with_ctx ? 192 : 0);
    for (int u = blockIdx.x; u < total; u += gridDim.x) {
        bool diff; int b, h, row0, kvlen;
        if (u < 2048) { diff = true; const int i = u >> 8, blk = u & 255, bh = i * 8 + (blk & 7), qb = blk >> 3; b = bh >> 2; h = bh & 3; row0 = b * 4096 + qb * 128; kvlen = KVL; }
        else if (u < 3072) { diff = false; const int uu = u - 2048, i = uu >> 8, blk = uu & 255, slot = blk >> 3, bh = i * 16 + 2 * (blk & 7) + (slot >> 4), qb = slot & 15; b = bh >> 2; h = bh & 3; row0 = b * 4096 + qb * 256; kvlen = KVL; }
        else if (u < 3200) { diff = true; const int uu = u - 3072, bh = uu >> 1; b = bh >> 2; h = bh & 3; row0 = NLAT + b * 256 + (uu & 1) * 128; kvlen = CTXL; }
        else { diff = false; const int bh = u - 3200; b = bh >> 2; h = bh & 3; row0 = NLAT + b * 256; kvlen = CTXL; }
        if (diff) attn_unit<64, 128, true>(lds, p.QD + (size_t)row0 * 512 + (2 * h) * 64, 512, p.KD + (size_t)(b * 8 + 2 * h) * KVL * 64, (size_t)KVL * 64, p.VTD + (size_t)(b * 4 + h) * 128 * KVL, kvlen,
                                           p.XN + (size_t)row0 * DM + 512 + h * 128, lam, lam_init, p.diff_subln + l * 128);
        else attn_unit<96, 64, false>(lds, p.QM + (size_t)row0 * 384 + h * 96, 384, p.KM + (size_t)(b * 4 + h) * KVL * 96, 0, p.VTM + (size_t)(b * 4 + h) * 64 * KVL, kvlen,
                                      p.XN + (size_t)row0 * DM + 256 + h * 64, 0.f, 1.f, nullptr);
    }
}

constexpr int NPHASE = 2 + DEPTH * 11;
__device__ __forceinline__ void run_phase(const Params& p, int ph, LAS unsigned char* lds) {
    const int G = (int)gridDim.x, cb = (int)blockIdx.x;
    if (ph == 0) { phase_init(p, lds); return; }
    if (ph == NPHASE - 1) { phase_norm(p.H, p.H, NLAT, p.final_norm, nullptr, 0, 0, nullptr, p.out, nullptr, nullptr, 0.f, nullptr); return; }
    const int l = (ph - 1) / 11, k = (ph - 1) % 11; const bool last = l == DEPTH - 1;
    const float* mods_l = p.MODS + (size_t)l * 17 * 9216;
    const int Mlate = last ? NLAT : NT;
    pg8::StaticOrder S;
    if (k == 0 || k == 3 || k == 8) {
        const float* gw = (k == 0 ? p.ffn1_norm : k == 3 ? p.mix_norm : p.ffn2_norm) + l * DM;
        const int si = k == 8 ? 6 : k;
        const bool first = (l == 0 && k == 0);
        const bool pend = !first && !(k == 8 && last);
        const float* pgate = (k == 0 ? mods_l - 17 * 9216 + 8 * 1024 : k == 3 ? mods_l + 2 * 1024 : mods_l + 5 * 1024) + (size_t)16 * 9216;
        const bool ctx_in = (l == 0 && k <= 3);
        phase_norm(first ? p.x : p.H, ctx_in ? p.ctx - (size_t)NLAT * DM : p.H, k == 8 ? Mlate : NT, gw, mods_l, si, si + 1, p.XN, nullptr, pend ? p.P4 : nullptr, pgate, k == 8 ? 1.f : 0.5f, p.H);
        if (k == 0) phase_convert(p, l, lds);
    } else if (k == 1 || k == 9) {
        pg8::Gemm g{p.XN, k == 1 ? p.Bt13a : p.Bt13b, k == 1 ? NT : Mlate, 2 * DFF, DM, DM};
        S.init(g.M, g.N, G, cb); EpiSwiGLU E{p.G};
        pg8::gemm_phase(lds, g, S, E);
    } else if (k == 2 || k == 7 || k == 10) {
        const int Kf = k == 7 ? DM : DFF;
        const bf16_t* Ap = k == 7 ? p.XN : p.G; const bf16_t* Bp = k == 2 ? p.Bt2a : k == 7 ? p.Btout : p.Bt2b;
        const bool first = (l == 0 && k == 2);
        { pg8::Gemm g{Ap, Bp, NLAT, DM, Kf, Kf};
          S.init(g.M, g.N, G, cb); EpiResid E{first ? p.x : p.H, p.H, p.H, mods_l + (k == 2 ? 2 : k == 7 ? 5 : 8) * 1024, k == 7 ? 1.f : 0.5f};
          pg8::gemm_phase(lds, g, S, E); }
        if (k == 2 || !last) {
            const int kt = Kf / 128, q0 = kt / 4, r0 = kt % 4;
            for (int idx = cb; idx < 256; idx += G) {
                const int unit = idx >> 2, sl = idx & 3;
                const int kb0 = sl * q0 + (sl < r0 ? sl : r0), kl = q0 + (sl < r0 ? 1 : 0);
                pg8::Gemm g{Ap + (size_t)NLAT * Kf + kb0 * 128, Bp + kb0 * 128, NCTX, DM, kl * 128, Kf};
                S.init(g.M, g.N, G, cb); S.fixed = unit;
                EpiPartial E{p.P4 + (size_t)sl * NCTX * DM};
                __syncthreads();
                pg8::gemm_phase(lds, g, S, E);
            }
        }
    } else if (k == 4) {
        pg8::Gemm g{p.XN, p.Btin, NT, 2560, DM, DM};
        S.init(g.M, g.N, G, cb); EpiIn E{p.U, p.CQ, p.CKV, p.SSQ, p.QD, p.KD, p.VTD, p.KM, p.ROPED, p.ROPEM, lds + 131072};
        pg8::gemm_phase(lds, g, S, E);
    } else if (k == 5) {
        { pg8::Gemm g{p.CQ, p.Btuq, NT, 512, 384, 384}; S.init(g.M, g.N, G, cb); EpiQup E{p.SSQ, p.QM, p.ROPEM}; pg8::gemm_phase(lds, g, S, E); }
        { pg8::Gemm g{p.CKV, p.Btukv, NT, 512, 256, 256}; S.init(g.M, g.N, G, (cb + 32) % G); EpiKVup E{p.SSQ, p.KM, p.VTM, lds + 131072}; pg8::gemm_phase(lds, g, S, E); }
        __syncthreads();
        phase_pool(p, l, !last, lds);
    } else if (k == 6) {
        phase_attn(p, l, !last, lds);
    }
}

__device__ __forceinline__ void grid_barrier(unsigned* ctr, unsigned target) {
    asm volatile("s_waitcnt vmcnt(0) lgkmcnt(0)" ::: "memory");
    __syncthreads();
    if (threadIdx.x == 0) {
        __builtin_amdgcn_fence(__ATOMIC_RELEASE, "agent");
        asm volatile("s_waitcnt vmcnt(0)" ::: "memory");
        __hip_atomic_fetch_add(ctr, 1u, __ATOMIC_RELAXED, __HIP_MEMORY_SCOPE_AGENT);
        while (__hip_atomic_load(ctr, __ATOMIC_RELAXED, __HIP_MEMORY_SCOPE_AGENT) < target) __builtin_amdgcn_s_sleep(2);
        __builtin_amdgcn_fence(__ATOMIC_ACQUIRE, "agent");
        asm volatile("s_waitcnt vmcnt(0)" ::: "memory");
    }
    __syncthreads();
}

__global__ __launch_bounds__(512, 2) void hymba_mega(Params p) {
    extern __shared__ __attribute__((aligned(16))) unsigned char smem[];
    LAS unsigned char* lds = (LAS unsigned char*)smem;
    cg::grid_group grid = cg::this_grid();
    unsigned nbar = 0;
    for (int ph = p.ph_lo; ph < p.ph_hi; ++ph) {
        run_phase(p, ph, lds);
        if (ph + 1 < p.ph_hi) {
            if (ph == p.ph_lo) grid.sync();
            else grid_barrier(p.BAR, ++nbar * gridDim.x);
        }
    }
}

extern "C" void kernel_launch(void* const* d_in, const int* in_sizes, int n_in, void* d_out, int out_size, void* d_ws, size_t ws_size, hipStream_t stream) {
    static int grid_blocks = 0;
    if (!grid_blocks) {
        int dev = 0, cus = 0, per_cu = 0;
        hipGetDevice(&dev);
        hipDeviceGetAttribute(&cus, hipDeviceAttributeMultiprocessorCount, dev);
        if (hipFuncSetAttribute((const void*)hymba_mega, hipFuncAttributeMaxDynamicSharedMemorySize, LDS_BYTES) != hipSuccess) fprintf(stderr, "hipFuncSetAttribute failed\n");
        if (hipOccupancyMaxActiveBlocksPerMultiprocessor(&per_cu, (const void*)hymba_mega, 512, LDS_BYTES) != hipSuccess || per_cu < 1) { per_cu = 1; (void)hipGetLastError(); }
        grid_blocks = cus * per_cu;
        if (grid_blocks <= 0) grid_blocks = 256;
    }
    Params p{};
    const float** in = (const float**)&p;
    for (int i = 0; i < 26 && i < n_in; ++i) in[i] = (const float*)d_in[i];
    p.out = (float*)d_out;
    unsigned char* w = (unsigned char*)d_ws; size_t off = 0;
    auto take = [&](size_t bytes) { unsigned char* r = w + off; off += (bytes + 255) & ~(size_t)255; return r; };
    p.H = (float*)take((size_t)NT * DM * 4);
    p.XN = (bf16_t*)take((size_t)NT * DM * 2);
    unsigned char* big = w + off; size_t boff = 0;
    auto takeb = [&](size_t bytes) { unsigned char* r = big + boff; boff += (bytes + 255) & ~(size_t)255; return r; };
    p.U = (float*)takeb((size_t)NT * 256 * 4);
    p.CQ = (bf16_t*)takeb((size_t)NT * 384 * 2);
    p.CKV = (bf16_t*)takeb((size_t)NT * 256 * 2);
    p.SSQ = (float*)takeb((size_t)NT * 16 * 4);
    p.QD = (bf16_t*)takeb((size_t)NT * 512 * 2);
    p.KD = (bf16_t*)takeb((size_t)NB * 8 * KVL * 64 * 2);
    p.VTD = (bf16_t*)takeb((size_t)NB * 4 * 128 * KVL * 2);
    p.QM = (bf16_t*)takeb((size_t)NT * 384 * 2);
    p.KM = (bf16_t*)takeb((size_t)NB * 4 * KVL * 96 * 2);
    p.VTM = (bf16_t*)takeb((size_t)NB * 4 * 64 * KVL * 2);
    p.G = (bf16_t*)big;
    p.P4 = (float*)(big + (((size_t)NT * DFF * 2 + 255) & ~(size_t)255));
    const size_t gbytes = (size_t)NT * DFF * 2;
    off += (boff > gbytes ? boff : gbytes); off = (off + 255) & ~(size_t)255;
    p.Bt13a = (bf16_t*)take((size_t)2 * DFF * DM * 2); p.Bt2a = (bf16_t*)take((size_t)DM * DFF * 2);
    p.Bt13b = (bf16_t*)take((size_t)2 * DFF * DM * 2); p.Bt2b = (bf16_t*)take((size_t)DM * DFF * 2);
    p.Btin = (bf16_t*)take((size_t)2560 * DM * 2); p.Btout = (bf16_t*)take((size_t)DM * DM * 2);
    p.Btuq = (bf16_t*)take((size_t)512 * 384 * 2); p.Btukv = (bf16_t*)take((size_t)512 * 256 * 2); p.Btpool = (bf16_t*)take((size_t)4 * 64 * 64 * 2);
    p.MODS = (float*)take((size_t)DEPTH * 17 * 9216 * 4);
    p.BAR = (unsigned*)take(256);
    p.ROPED = (float*)take((size_t)4096 * 32 * 2 * 4); p.ROPEM = (float*)take((size_t)4096 * 16 * 2 * 4);
    if (off > ws_size) { fprintf(stderr, "kernel_launch: workspace too small: need %zu have %zu\n", off, ws_size); return; }
    (void)hipMemsetAsync(p.BAR, 0, 256, stream);
#if MULTI_LAUNCH
    for (int ph = 0; ph < NPHASE; ++ph) { p.ph_lo = ph; p.ph_hi = ph + 1; hipLaunchKernelGGL(hymba_mega, dim3(grid_blocks), dim3(512), LDS_BYTES, stream, p); }
#else
    p.ph_lo = 0; p.ph_hi = NPHASE;
    void* args[] = {&p};
    hipError_t e = hipLaunchCooperativeKernel((const void*)hymba_mega, dim3(grid_blocks), dim3(512), args, LDS_BYTES, stream);
    if (e != hipSuccess) fprintf(stderr, "cooperative launch failed: %s (grid %d)\n", hipGetErrorString(e), grid_blocks);
#endif
}
```

```cpp
#include <hip/hip_runtime.h>
#include <hip/hip_cooperative_groups.h>
#include <cstdio>
namespace cg = cooperative_groups;

#define LAS __attribute__((address_space(3)))
typedef unsigned short bf16_t;
typedef short bf16x8 __attribute__((ext_vector_type(8)));
typedef float f32x4 __attribute__((ext_vector_type(4)));
typedef float f32x2 __attribute__((ext_vector_type(2)));
typedef unsigned u32x4 __attribute__((ext_vector_type(4)));
typedef unsigned u32x2 __attribute__((ext_vector_type(2)));

constexpr int DM = 1024, NB = 16, SEQ = 4096, DEPTH = 4, CTXL = 256, DFF = 2816;
constexpr int NLAT = NB * SEQ, NCTX = NB * CTXL, NT = NLAT + NCTX, KVL = SEQ + CTXL;
constexpr int INW = 2464;
constexpr float EPS = 1e-6f;
constexpr float LOG2E = 1.4426950408889634f;
constexpr int LDS_BYTES = 131072 + 8 * 3072;
#ifndef MULTI_LAUNCH
#define MULTI_LAUNCH 0
#endif

struct Params {
    const float *x, *c, *ctx, *c_ctx, *w_mod, *b_mod, *ffn1_norm, *ffn1_w1, *ffn1_w3, *ffn1_w2, *mix_norm, *w_in, *w_out, *pool_w, *pool_scale,
        *mla_q_norm, *mla_w_uq, *mla_kv_norm, *mla_w_ukv, *diff_lambda, *diff_subln, *ffn2_norm, *ffn2_w1, *ffn2_w3, *ffn2_w2, *final_norm;
    float* out;
    float* H; bf16_t* XN; bf16_t* G; float* U; bf16_t* CQ; bf16_t* CKV; float* SSQ; bf16_t* QD; bf16_t* KD; bf16_t* VTD; bf16_t* QM; bf16_t* KM; bf16_t* VTM;
    bf16_t *Bt13a, *Bt2a, *Bt13b, *Bt2b, *Btin, *Btout, *Btuq, *Btukv, *Btpool;
    float *MODS, *ROPED, *ROPEM;
    float* P4;
    unsigned* BAR;
    int ph_lo, ph_hi;
};

typedef __bf16 bf16x2_t __attribute__((ext_vector_type(2)));
__device__ __forceinline__ unsigned cvt_pk_bf16(float lo, float hi) { const f32x2 v = {lo, hi}; const bf16x2_t b = __builtin_convertvector(v, bf16x2_t); return __builtin_bit_cast(unsigned, b); }
__device__ __forceinline__ bf16_t f2bf(float v) { return (bf16_t)(cvt_pk_bf16(v, 0.f) & 0xffffu); }
__device__ __forceinline__ int opaque_tid() { int t = threadIdx.x; asm volatile("" : "+v"(t)); return t; }
__device__ __forceinline__ float shx(float v, int mask, int lane) { return __int_as_float(__builtin_amdgcn_ds_bpermute((lane ^ mask) << 2, __float_as_int(v))); }
__device__ __forceinline__ float fast_exp2(float x) { return __builtin_amdgcn_exp2f(x); }
__device__ __forceinline__ float fast_rcp(float x) { return __builtin_amdgcn_rcpf(x); }

namespace pg8 {
constexpr int BM = 256, BK = 64, HALF = 128, HTB = HALF * BK * 2, STAGE_BYTES = 8 * HTB, NXCD = 8, WGM = 4;
__host__ __device__ __forceinline__ int lds_byte(int r, int c) { const int st = (r >> 4) * 2 + (c >> 5), rr = r & 15, cc = c & 31, ob = rr * 64 + cc * 2; return st * 1024 + (ob ^ (((ob >> 9) & 1) << 5)); }
__host__ __device__ __forceinline__ void stage_rc(int b, int& R, int& C) { const int st = b / 1024, sb = b % 1024, swz = sb ^ (((sb >> 9) & 1) << 5); R = (st >> 1) * 16 + swz / 64; C = (st & 1) * 32 + (swz % 64) / 2; }
struct Unit { int pm, pn; };
struct Gemm { const bf16_t* A; const bf16_t* Bt; int M, N, K, ld; };
struct StaticOrder {
    int nM, nN, nwg, G, c, fixed;
    __device__ void init(int M, int N, int G_, int c_) { nM = M / BM; nN = N / BM; nwg = nM * nN; G = G_; c = c_; fixed = -1; }
    __device__ bool next(int i, Unit& u) const {
        if (fixed >= 0) { if (i > 0) return false; u.pm = fixed / nN; u.pn = fixed % nN; return true; }
        const long L = (long)i * G + c; if (L >= nwg) return false;
        int wgid = (int)L; { const int q = nwg / NXCD, r = nwg % NXCD, xcd = wgid % NXCD, off = wgid / NXCD; wgid = (xcd < r ? xcd * (q + 1) : r * (q + 1) + (xcd - r) * q) + off; }
        const int nig = WGM * nN, gid = wgid / nig, fm = gid * WGM, gsz = (nM - fm) < WGM ? (nM - fm) : WGM;
        u.pm = fm + ((wgid % nig) % gsz); u.pn = (wgid % nig) / gsz; return true;
    }
};
template <class Epi>
__device__ __forceinline__ void gemm_phase(LAS unsigned char* lds, const Gemm g, const StaticOrder& S, const Epi& E) {
    const int tid = opaque_tid(), wid = __builtin_amdgcn_readfirstlane(tid >> 6), lane = tid & 63, wr = wid >> 2, wc = wid & 3, fr = lane & 15, fq = lane >> 4;
    const int K = g.K, LD = g.ld, nt = K / BK;
    unsigned voffA[2];
#pragma unroll
    for (int i = 0; i < 2; ++i) { int R, C; stage_rc(tid * 16 + i * 8192, R, C); voffA[i] = (unsigned)(R * LD + C) * 2u; }
    const size_t kstep = (size_t)(BK * 2);
    const size_t hstep = (size_t)HALF * LD * 2;
    const size_t tstep = 2 * hstep;
    const unsigned ldsw = (unsigned)wid * 1024u;
    const int aoff = lds_byte(wr * 64 + fr, fq * 8), boff = lds_byte(wc * 32 + fr, fq * 8);
#define PG8_SA(b, h) (((b) * 2 + (h)) * HTB)
#define PG8_SB(b, h) ((4 + (b) * 2 + (h)) * HTB)
#define PG8_STAGE(bufoff, gbase, voff) do { _Pragma("unroll") for (int _i = 0; _i < 2; ++_i) \
        __builtin_amdgcn_global_load_lds((const unsigned*)((const char*)(gbase) + (voff)[_i]), (LAS unsigned*)(lds + (bufoff) + ldsw + _i * 8192), 16, 0, 0); } while (0)
#define PG8_LDA(dst, b, h) do { _Pragma("unroll") for (int m = 0; m < 4; ++m) _Pragma("unroll") for (int k = 0; k < 2; ++k) dst[m][k] = *(const LAS bf16x8*)(lds + PG8_SA(b, h) + aoff + m * 2048 + k * 1024); } while (0)
#define PG8_LDB(dst, b, h) do { _Pragma("unroll") for (int n = 0; n < 2; ++n) _Pragma("unroll") for (int k = 0; k < 2; ++k) dst[n][k] = *(const LAS bf16x8*)(lds + PG8_SB(b, h) + boff + n * 2048 + k * 1024); } while (0)
#define PG8_MMA(ai, bj, At, Bt) do { __builtin_amdgcn_s_setprio(1); _Pragma("unroll") for (int m = 0; m < 4; ++m) _Pragma("unroll") for (int n = 0; n < 2; ++n) _Pragma("unroll") for (int k = 0; k < 2; ++k) \
        acc[ai][bj][m][n] = __builtin_amdgcn_mfma_f32_16x16x32_bf16(Bt[n][k], At[m][k], acc[ai][bj][m][n], 0, 0, 0); __builtin_amdgcn_s_setprio(0); } while (0)
#define PG8_WAIT_V(n) asm volatile("s_waitcnt vmcnt(" #n ")" ::: "memory")
#define PG8_WAIT_L(n) asm volatile("s_waitcnt lgkmcnt(" #n ")" ::: "memory")
#define PG8_BAR __builtin_amdgcn_s_barrier()
#define PG8_SCHED __builtin_amdgcn_sched_barrier(0)
    Unit cur, nxt; int ui = 0;
    if (!S.next(0, cur)) return;
    f32x4 acc[2][2][4][2];
#pragma unroll
    for (int a = 0; a < 2; ++a)
#pragma unroll
        for (int b = 0; b < 2; ++b)
#pragma unroll
            for (int m = 0; m < 4; ++m)
#pragma unroll
                for (int n = 0; n < 2; ++n) acc[a][b][m][n] = (f32x4){0.f, 0.f, 0.f, 0.f};
    bf16x8 At[4][2], B0[2][2], B1[2][2];
    const char* cA = (const char*)g.A + (size_t)cur.pm * tstep; const char* cB = (const char*)g.Bt + (size_t)cur.pn * tstep;
    PG8_STAGE(PG8_SB(0, 0), cB, voffA); PG8_STAGE(PG8_SA(0, 0), cA, voffA); PG8_STAGE(PG8_SB(0, 1), cB + hstep, voffA); PG8_STAGE(PG8_SA(0, 1), cA + hstep, voffA);
    if (wr == 1) PG8_BAR;
    PG8_WAIT_V(4); PG8_BAR;
    PG8_STAGE(PG8_SB(1, 0), cB + kstep, voffA); PG8_STAGE(PG8_SA(1, 0), cA + kstep, voffA); PG8_STAGE(PG8_SB(1, 1), cB + hstep + kstep, voffA);
    PG8_WAIT_V(6); PG8_BAR;
    for (;;) {
        const bool has_next = S.next(ui + 1, nxt);
        const char* nA = has_next ? (const char*)g.A + (size_t)nxt.pm * tstep : cA; const char* nB = has_next ? (const char*)g.Bt + (size_t)nxt.pn * tstep : cB;
        for (int t = 0; t < nt; t += 2) {
            const bool last = (t == nt - 2);
            const char* a1 = cA + (size_t)(t + 1) * kstep;
            const char* a2 = last ? nA : cA + (size_t)(t + 2) * kstep; const char* b2 = last ? nB : cB + (size_t)(t + 2) * kstep;
            const char* a3 = a2 + kstep; const char* b3 = b2 + kstep;
            PG8_LDB(B0, 0, 0); PG8_SCHED; PG8_LDA(At, 0, 0); PG8_STAGE(PG8_SA(1, 1), a1 + hstep, voffA);
            PG8_WAIT_L(8); PG8_BAR; PG8_WAIT_L(0); PG8_MMA(0, 0, At, B0); PG8_BAR; PG8_SCHED;
            PG8_LDB(B1, 0, 1); PG8_STAGE(PG8_SB(0, 0), b2, voffA);
            PG8_BAR; PG8_WAIT_L(0); PG8_MMA(0, 1, At, B1); PG8_BAR;
            PG8_LDA(At, 0, 1); PG8_STAGE(PG8_SA(0, 0), a2, voffA);
            PG8_BAR; PG8_WAIT_L(0); PG8_MMA(1, 0, At, B0); PG8_BAR; PG8_SCHED;
            PG8_STAGE(PG8_SB(0, 1), b2 + hstep, voffA);
            PG8_WAIT_V(6); PG8_BAR; PG8_MMA(1, 1, At, B1); PG8_BAR;
            PG8_LDB(B0, 1, 0); PG8_SCHED; PG8_LDA(At, 1, 0); PG8_STAGE(PG8_SA(0, 1), a2 + hstep, voffA);
            PG8_WAIT_L(8); PG8_BAR; PG8_WAIT_L(0); PG8_MMA(0, 0, At, B0); PG8_BAR; PG8_SCHED;
            PG8_LDB(B1, 1, 1); PG8_STAGE(PG8_SB(1, 0), b3, voffA);
            PG8_BAR; PG8_WAIT_L(0); PG8_MMA(0, 1, At, B1); PG8_BAR;
            PG8_LDA(At, 1, 1); PG8_STAGE(PG8_SA(1, 0), a3, voffA);
            PG8_BAR; PG8_WAIT_L(0); PG8_MMA(1, 0, At, B0); PG8_BAR; PG8_SCHED;
            PG8_STAGE(PG8_SB(1, 1), b3 + hstep, voffA);
            PG8_WAIT_V(6); PG8_BAR; PG8_MMA(1, 1, At, B1); PG8_BAR;
        }
        E(acc, cur, wr, wc, fr, fq);
        if (!has_next) break;
#pragma unroll
        for (int a = 0; a < 2; ++a)
#pragma unroll
            for (int b = 0; b < 2; ++b)
#pragma unroll
                for (int m = 0; m < 4; ++m)
#pragma unroll
                    for (int n = 0; n < 2; ++n) acc[a][b][m][n] = (f32x4){0.f, 0.f, 0.f, 0.f};
        cur = nxt; cA = nA; cB = nB; ++ui;
    }
    PG8_WAIT_V(0);
    if (wr == 0) PG8_BAR;
    PG8_BAR;
#undef PG8_SA
#undef PG8_SB
#undef PG8_STAGE
#undef PG8_LDA
#undef PG8_LDB
#undef PG8_MMA
#undef PG8_WAIT_V
#undef PG8_WAIT_L
#undef PG8_BAR
#undef PG8_SCHED
}
}
using pg8::Unit;

__device__ __forceinline__ int slot_of_L(int L) { return (((L >> 3) & 1) << 7) | (((L >> 6) & 3) << 5) | (((L >> 2) & 1) << 4) | (((L >> 4) & 3) << 2) | (L & 3); }
__device__ __forceinline__ int rope_lambda(int dd, int half) { const int hf = dd / half, i = dd % half; return 16 * (i >> 3) + 8 * hf + (i & 7); }
__device__ __forceinline__ int keypos_of(int key) { return (key & ~12) | ((key & 4) << 1) | ((key & 8) >> 1); }
enum { KNAT = 0, KSWI = 1, KIN = 2, KUQ = 3, KUKV = 4 };
__device__ __forceinline__ int dstrow(int kind, int which, int c) {
    if (kind == KNAT) return c;
    if (kind == KSWI) { const int pn = c >> 7, cg = c & 127; return pn * 256 + ((((cg >> 2) & 1) << 7) | (((cg >> 5) & 3) << 5) | (which << 4) | (((cg >> 3) & 3) << 2) | (cg & 3)); }
    if (kind == KIN) {
        int tile, L;
        if (c < 256) { tile = 0; L = c; }
        else if (c < 640) { const int q = c - 256; tile = 1 + (q >> 8); L = q & 255; }
        else if (c < 896) { tile = 3; L = c - 640; }
        else if (c < 928) { tile = 2; L = 128 + rope_lambda(c - 896, 16); }
        else if (c < 1952) { int qq = c - 928; const int isk = qq >= 512 ? 1 : 0; qq &= 511; const int hd = qq >> 6; tile = 4 + 2 * isk + (hd >> 2); L = 64 * (hd & 3) + rope_lambda(qq & 63, 32); }
        else { const int vv = c - 1952; tile = 8 + (vv >> 8); L = vv & 255; }
        return tile * 256 + slot_of_L(L);
    }
    if (kind == KUQ) { const int head = c / 96, dd = c % 96; const int Lh = dd < 64 ? dd : 64 + rope_lambda(dd - 64, 16); const int L = 128 * (head & 1) + Lh; return (head >> 1) * 256 + slot_of_L(L); }
      { const int head = c >> 7, dd = c & 127; const int tile = dd >> 6; const int L = 64 * head + (dd & 63); return tile * 256 + slot_of_L(L); }
}

struct EpiSwiGLU {
    bf16_t* __restrict__ G;
    __device__ __forceinline__ void operator()(const f32x4 (&acc)[2][2][4][2], const Unit& u, int wr, int wc, int fr_, int fq_) const {
        const int tq_ = opaque_tid(); const int fr = tq_ & 15, fq = (tq_ >> 4) & 3; (void)fr_; (void)fq_;
        const int row0 = u.pm * 256 + wr * 64 + fr, col0 = u.pn * 128 + wc * 32 + fq * 8;
#pragma unroll
        for (int ai = 0; ai < 2; ++ai)
#pragma unroll
            for (int m = 0; m < 4; ++m) {
                float o[8];
#pragma unroll
                for (int bj = 0; bj < 2; ++bj)
#pragma unroll
                    for (int j = 0; j < 4; ++j) { const float a = acc[ai][bj][m][0][j], b = acc[ai][bj][m][1][j]; o[bj * 4 + j] = a * fast_rcp(1.f + fast_exp2(-a * LOG2E)) * b; }
                u32x4 w; w.x = cvt_pk_bf16(o[0], o[1]); w.y = cvt_pk_bf16(o[2], o[3]); w.z = cvt_pk_bf16(o[4], o[5]); w.w = cvt_pk_bf16(o[6], o[7]);
                *(u32x4*)(G + (size_t)(row0 + ai * 128 + m * 16) * DFF + col0) = w;
            }
    }
};
struct EpiResid {
    const float* Hin; const float* Hin_ctx; float* Hout; const float* gate_l; float sc;
    __device__ __forceinline__ void operator()(const f32x4 (&acc)[2][2][4][2], const Unit& u, int wr, int wc, int fr_, int fq_) const {
        const int tq_ = opaque_tid(); const int fr = tq_ & 15, fq = (tq_ >> 4) & 3; (void)fr_; (void)fq_;
        const int bi = u.pm < 256 ? (u.pm >> 4) : 16;
        const int row0 = u.pm * 256 + wr * 64 + fr, col0 = u.pn * 256 + wc * 32 + 4 * fq;
        const float* gate = gate_l + (size_t)bi * 9216 + col0;
        const float* hin = u.pm < 256 ? Hin : Hin_ctx;
        f32x4 gv[2][2];
#pragma unroll
        for (int bj = 0; bj < 2; ++bj)
#pragma unroll
            for (int n = 0; n < 2; ++n) gv[bj][n] = *(const f32x4*)(gate + bj * 128 + n * 16) * sc;
        f32x4 hb[3][2][2];
#define RES_LOAD(g_, st_) { const size_t base_ = (size_t)(row0 + ((g_) >> 2) * 128 + ((g_) & 3) * 16) * DM + col0; \
            _Pragma("unroll") for (int bj = 0; bj < 2; ++bj) _Pragma("unroll") for (int n = 0; n < 2; ++n) hb[st_][bj][n] = *(const f32x4*)(hin + base_ + bj * 128 + n * 16); }
        RES_LOAD(0, 0); RES_LOAD(1, 1);
#pragma unroll
        for (int g = 0; g < 8; ++g) {
            if (g + 2 < 8) { RES_LOAD(g + 2, (g + 2) % 3); }
            const int ai = g >> 2, m = g & 3;
            const size_t base = (size_t)(row0 + ai * 128 + m * 16) * DM + col0;
#pragma unroll
            for (int bj = 0; bj < 2; ++bj)
#pragma unroll
                for (int n = 0; n < 2; ++n) *(f32x4*)(Hout + base + bj * 128 + n * 16) = hb[g % 3][bj][n] + gv[bj][n] * acc[ai][bj][m][n];
        }
#undef RES_LOAD
    }
};
struct EpiPartial {
    float* __restrict__ P;
    __device__ __forceinline__ void operator()(const f32x4 (&acc)[2][2][4][2], const Unit& u, int wr, int wc, int fr_, int fq_) const {
        const int tq_ = opaque_tid(); const int fr = tq_ & 15, fq = (tq_ >> 4) & 3; (void)fr_; (void)fq_;
        const int row0 = u.pm * 256 + wr * 64 + fr, col0 = u.pn * 256 + wc * 32 + 4 * fq;
#pragma unroll
        for (int ai = 0; ai < 2; ++ai)
#pragma unroll
            for (int m = 0; m < 4; ++m) {
                float* hp = P + (size_t)(row0 + ai * 128 + m * 16) * DM + col0;
#pragma unroll
                for (int bj = 0; bj < 2; ++bj)
#pragma unroll
                    for (int n = 0; n < 2; ++n) *(f32x4*)(hp + bj * 128 + n * 16) = acc[ai][bj][m][n];
            }
    }
};
__device__ __forceinline__ void store16bf(bf16_t* dst, const float (&v)[16]) {
    u32x4 w0, w1;
    w0.x = cvt_pk_bf16(v[0], v[1]); w0.y = cvt_pk_bf16(v[2], v[3]); w0.z = cvt_pk_bf16(v[4], v[5]); w0.w = cvt_pk_bf16(v[6], v[7]);
    w1.x = cvt_pk_bf16(v[8], v[9]); w1.y = cvt_pk_bf16(v[10], v[11]); w1.z = cvt_pk_bf16(v[12], v[13]); w1.w = cvt_pk_bf16(v[14], v[15]);
    *(u32x4*)dst = w0; *(u32x4*)(dst + 8) = w1;
}
__device__ __forceinline__ void rope16(float (&v)[16], const float* tab) {
#pragma unroll
    for (int q = 0; q < 4; ++q) {
        const f32x4 cs = *(const f32x4*)(tab + q * 4);
        { const float x1 = v[2 * q], x2 = v[8 + 2 * q]; v[2 * q] = x1 * cs[0] - x2 * cs[1]; v[8 + 2 * q] = x1 * cs[1] + x2 * cs[0]; }
        { const float x1 = v[2 * q + 1], x2 = v[9 + 2 * q]; v[2 * q + 1] = x1 * cs[2] - x2 * cs[3]; v[9 + 2 * q] = x1 * cs[3] + x2 * cs[2]; }
    }
}
__device__ __forceinline__ void store_vt(LAS unsigned char* tw, const float (&v)[16], int fr, int fq, bf16_t* vt) {
    const int pos = ((fr & 4) << 1) | ((fr & 8) >> 1) | (fr & 3);
#pragma unroll
    for (int e = 0; e < 16; ++e) *(LAS bf16_t*)(tw + (16 * fq + e) * 48 + pos * 2) = f2bf(v[e]);
    const int lane = fq * 16 + fr;
#pragma unroll
    for (int i = 0; i < 2; ++i) { const int ch = lane + 64 * i, col = ch >> 1, half = ch & 1;
        const u32x4 w = *(const LAS u32x4*)(tw + col * 48 + half * 16);
        *(u32x4*)(vt + (size_t)col * KVL + half * 8) = w; }
}
struct EpiIn {
    float* __restrict__ U; bf16_t* __restrict__ CQ; bf16_t* __restrict__ CKV; float* __restrict__ SSQ; bf16_t* __restrict__ QD; bf16_t* __restrict__ KD; bf16_t* __restrict__ VTD; bf16_t* __restrict__ KM; const float* __restrict__ ROPED; const float* __restrict__ ROPEM; LAS unsigned char* tl;
    __device__ __forceinline__ void operator()(const f32x4 (&acc)[2][2][4][2], const Unit& u, int wr, int wc, int fr_, int fq_) const {
        const int tq_ = opaque_tid(); const int fr = tq_ & 15, fq = (tq_ >> 4) & 3; (void)fr_; (void)fq_;
        const int pn = u.pn, L0 = 64 * wc + 16 * fq;
#pragma unroll
        for (int ai = 0; ai < 2; ++ai)
#pragma unroll
            for (int m = 0; m < 4; ++m) {
                const int row = u.pm * 256 + ai * 128 + wr * 64 + m * 16 + fr;
                const bool lat = u.pm < 256;
                const int b = lat ? (row >> 12) : ((row - NLAT) >> 8);
                const int key = lat ? (CTXL + (row & 4095)) : ((row - NLAT) & 255);
                const int pos = row & 4095;
                float v[16];
#pragma unroll
                for (int bj = 0; bj < 2; ++bj)
#pragma unroll
                    for (int n = 0; n < 2; ++n)
#pragma unroll
                        for (int j = 0; j < 4; ++j) v[8 * bj + 4 * n + j] = acc[ai][bj][m][n][j];
                if (pn == 0) {
                    float* d = U + (size_t)row * 256 + L0;
#pragma unroll
                    for (int q = 0; q < 4; ++q) *(f32x4*)(d + 4 * q) = (f32x4){v[4 * q], v[4 * q + 1], v[4 * q + 2], v[4 * q + 3]};
                } else if (pn <= 3) {
                    if (pn == 2 && wc >= 2) {
                        if (wc == 2 && fq < 2) {
                            if (lat) rope16(v, ROPEM + ((size_t)pos * 16 + 8 * fq) * 2);
#pragma unroll
                            for (int h = 0; h < 4; ++h) store16bf(KM + ((size_t)(b * 4 + h) * KVL + key) * 96 + 64 + 16 * fq, v);
                        }
                    } else {
                        float s = 0.f;
#pragma unroll
                        for (int e = 0; e < 16; ++e) s += v[e] * v[e];
                        { const int ln = fq * 16 + fr; s += shx(s, 16, ln); s += shx(s, 32, ln); }
                        if (pn < 3) { store16bf(CQ + (size_t)row * 384 + (pn - 1) * 256 + L0, v); if (fq == 0) SSQ[(size_t)row * 16 + (pn - 1) * 4 + wc] = s; }
                        else { store16bf(CKV + (size_t)row * 256 + L0, v); if (fq == 0) SSQ[(size_t)row * 16 + 8 + wc] = s; }
                    }
                } else if (pn <= 7) {
                    const int hd = 4 * ((pn - 4) & 1) + wc;
                    if (lat) rope16(v, ROPED + ((size_t)pos * 32 + 8 * fq) * 2);
                    if (pn <= 5) {
                        const float qs = 0.125f * LOG2E;
#pragma unroll
                        for (int e = 0; e < 16; ++e) v[e] *= qs;
                        store16bf(QD + (size_t)row * 512 + hd * 64 + 16 * fq, v);
                    } else store16bf(KD + ((size_t)(b * 8 + hd) * KVL + key) * 64 + 16 * fq, v);
                } else {
                    const int h = 2 * (pn - 8) + (wc >> 1);
                    store_vt(tl + (wr * 4 + wc) * 3072, v, fr, fq, VTD + ((size_t)(b * 4 + h) * 128 + 64 * (wc & 1)) * KVL + (key - fr));
                }
            }
    }
};
struct EpiQup {
    const float* __restrict__ SSQ; bf16_t* __restrict__ QM; const float* __restrict__ ROPEM;
    __device__ __forceinline__ void operator()(const f32x4 (&acc)[2][2][4][2], const Unit& u, int wr, int wc, int fr_, int fq_) const {
        const int tq_ = opaque_tid(); const int fr = tq_ & 15, fq = (tq_ >> 4) & 3; (void)fr_; (void)fq_;
        const int head = 2 * u.pn + (wc >> 1), part = wc & 1;
        if (part == 1 && fq >= 2) return;
#pragma unroll
        for (int ai = 0; ai < 2; ++ai)
#pragma unroll
            for (int m = 0; m < 4; ++m) {
                const int row = u.pm * 256 + ai * 128 + wr * 64 + m * 16 + fr;
                const f32x4 s4 = *(const f32x4*)(SSQ + (size_t)row * 16); const f32x2 s2 = *(const f32x2*)(SSQ + (size_t)row * 16 + 4);
                const float ss = (s4[0] + s4[1]) + (s4[2] + s4[3]) + (s2[0] + s2[1]);
                const float sc = rsqrtf(ss * (1.f / 384.f) + EPS) * (0.10206207261596577f * LOG2E);
                float v[16];
#pragma unroll
                for (int bj = 0; bj < 2; ++bj)
#pragma unroll
                    for (int n = 0; n < 2; ++n)
#pragma unroll
                        for (int j = 0; j < 4; ++j) v[8 * bj + 4 * n + j] = acc[ai][bj][m][n][j] * sc;
                if (part == 1 && u.pm < 256) rope16(v, ROPEM + ((size_t)(row & 4095) * 16 + 8 * fq) * 2);
                store16bf(QM + (size_t)row * 384 + head * 96 + 64 * part + 16 * fq, v);
            }
    }
};
struct EpiKVup {
    const float* __restrict__ SSQ; bf16_t* __restrict__ KM; bf16_t* __restrict__ VTM; LAS unsigned char* tl;
    __device__ __forceinline__ void operator()(const f32x4 (&acc)[2][2][4][2], const Unit& u, int wr, int wc, int fr_, int fq_) const {
        const int tq_ = opaque_tid(); const int fr = tq_ & 15, fq = (tq_ >> 4) & 3; (void)fr_; (void)fq_;
#pragma unroll
        for (int ai = 0; ai < 2; ++ai)
#pragma unroll
            for (int m = 0; m < 4; ++m) {
                const int row = u.pm * 256 + ai * 128 + wr * 64 + m * 16 + fr;
                const bool lat = u.pm < 256;
                const int b = lat ? (row >> 12) : ((row - NLAT) >> 8);
                const int key = lat ? (CTXL + (row & 4095)) : ((row - NLAT) & 255);
                const f32x4 s4 = *(const f32x4*)(SSQ + (size_t)row * 16 + 8);
                const float sc = rsqrtf(((s4[0] + s4[1]) + (s4[2] + s4[3])) * (1.f / 256.f) + EPS);
                float v[16];
#pragma unroll
                for (int bj = 0; bj < 2; ++bj)
#pragma unroll
                    for (int n = 0; n < 2; ++n)
#pragma unroll
                        for (int j = 0; j < 4; ++j) v[8 * bj + 4 * n + j] = acc[ai][bj][m][n][j] * sc;
                if (u.pn == 0) store16bf(KM + ((size_t)(b * 4 + wc) * KVL + key) * 96 + 16 * fq, v);
                else {
                    store_vt(tl + (wr * 4 + wc) * 3072, v, fr, fq, VTM + ((size_t)(b * 4 + wc) * 64) * KVL + (key - fr));
                }
            }
    }
};

__constant__ float c_invfreq[24] = {1.000000000e+00f, 5.623413324e-01f, 3.162277639e-01f, 1.778279394e-01f, 1.000000015e-01f, 5.623413250e-02f, 3.162277490e-02f, 1.778279431e-02f, 9.999999776e-03f, 5.623413250e-03f, 3.162277630e-03f, 1.778279431e-03f, 1.000000047e-03f, 5.623413017e-04f, 3.162277571e-04f, 1.778279402e-04f, 1.000000000e+00f, 3.162277639e-01f, 1.000000015e-01f, 3.162277490e-02f, 9.999999776e-03f, 3.162277630e-03f, 1.000000047e-03f, 3.162277571e-04f};
__device__ void phase_init(const Params& p, LAS unsigned char* lds) {
    const int tid = opaque_tid();
    const size_t gtid = (size_t)blockIdx.x * 512 + tid, gsz = (size_t)gridDim.x * 512;
    for (size_t i = gtid; i < (size_t)4096 * 48; i += gsz) {
        int pos, a, use_row; float* dst;
        if (i < (size_t)4096 * 32) { pos = (int)(i >> 5); const int ii = (int)(i & 31); a = ii & 15; use_row = ii < 16; dst = p.ROPED + 2 * i; }
        else { const size_t j = i - (size_t)4096 * 32; pos = (int)(j >> 4); const int ii = (int)(j & 15); a = 16 + (ii & 7); use_row = ii < 8; dst = p.ROPEM + 2 * j; }
        const float ang = (float)(use_row ? (pos >> 6) : (pos & 63)) * c_invfreq[a];
        const float kq = rintf(ang * 0.636619772f);
        float r = fmaf(-kq, 1.570770263671875f, ang); r = fmaf(-kq, 2.6063062250614166e-05f, r); r = fmaf(-kq, 6.077094383272197e-11f, r);
        const float r2 = r * r;
        const float sn = r * (1.f + r2 * (-1.6666667e-1f + r2 * (8.3333333e-3f + r2 * (-1.9841270e-4f + r2 * 2.7557319e-6f))));
        const float cs = 1.f + r2 * (-0.5f + r2 * (4.1666667e-2f + r2 * (-1.3888889e-3f + r2 * (2.4801587e-5f + r2 * (-2.7557319e-7f)))));
        const int qd = ((int)kq) & 3;
        dst[0] = qd == 0 ? cs : qd == 1 ? -sn : qd == 2 ? -cs : sn;
        dst[1] = qd == 0 ? sn : qd == 1 ? cs : qd == 2 ? -sn : -cs;
    }
    LAS float* sct = (LAS float*)lds;
    LAS float* red = (LAS float*)(lds + 81920);
    for (int i = tid; i < 17 * 1024; i += 512) { const int bi = i >> 10, k = i & 1023; const float cv = bi < 16 ? p.c[bi * 1024 + k] : p.c_ctx[k]; sct[k * 20 + bi] = cv / (1.f + __expf(-cv)); }
    __syncthreads();
    const int col = tid & 127, kg = tid >> 7;
    for (int u = blockIdx.x; u < DEPTH * 72; u += gridDim.x) {
        const int l = u / 72, n0 = (u % 72) * 128;
        const float* w = p.w_mod + (size_t)l * 1024 * 9216 + n0 + col;
        float a[17];
#pragma unroll
        for (int q = 0; q < 17; ++q) a[q] = 0.f;
#pragma unroll 4
        for (int k = kg * 256; k < kg * 256 + 256; ++k) {
            const float wv = w[(size_t)k * 9216];
            const f32x4 s0 = *(const LAS f32x4*)(sct + k * 20), s1 = *(const LAS f32x4*)(sct + k * 20 + 4), s2 = *(const LAS f32x4*)(sct + k * 20 + 8), s3 = *(const LAS f32x4*)(sct + k * 20 + 12);
            const float s16 = sct[k * 20 + 16];
#pragma unroll
            for (int q = 0; q < 4; ++q) { a[q] += s0[q] * wv; a[4 + q] += s1[q] * wv; a[8 + q] += s2[q] * wv; a[12 + q] += s3[q] * wv; }
            a[16] += s16 * wv;
        }
#pragma unroll
        for (int q = 0; q < 17; ++q) red[(kg * 17 + q) * 128 + col] = a[q];
        __syncthreads();
        for (int i = tid; i < 17 * 128; i += 512) { const int bi = i >> 7, cc = i & 127;
            const float s = (red[(0 * 17 + bi) * 128 + cc] + red[(1 * 17 + bi) * 128 + cc]) + (red[(2 * 17 + bi) * 128 + cc] + red[(3 * 17 + bi) * 128 + cc]);
            p.MODS[((size_t)l * 17 + bi) * 9216 + n0 + cc] = s + p.b_mod[(size_t)l * 9216 + n0 + cc]; }
        __syncthreads();
    }
}

__device__ void phase_norm(const float* H, const float* Hctx, int nrows, const float* gw, const float* mods_l, int shift_idx, int scale_idx, bf16_t* outb, float* outf,
                           const float* P4, const float* pgate, float psc, float* Hw) {
    const int tid = opaque_tid(); const int wid = tid >> 6, lane = tid & 63;
    for (int row = blockIdx.x * 8 + wid; row < nrows; row += gridDim.x * 8) {
        const float* hr = (row < NLAT ? H : Hctx) + (size_t)row * DM + lane * 4;
        f32x4 v[4]; float ss = 0.f;
#pragma unroll
        for (int q = 0; q < 4; ++q) v[q] = *(const f32x4*)(hr + q * 256);
        if (P4 && row >= NLAT) {
            const float* pr = P4 + (size_t)(row - NLAT) * DM + lane * 4;
#pragma unroll
            for (int q = 0; q < 4; ++q) { const f32x4 s4 = (*(const f32x4*)(pr + q * 256) + *(const f32x4*)(pr + (size_t)NCTX * DM + q * 256)) + (*(const f32x4*)(pr + (size_t)2 * NCTX * DM + q * 256) + *(const f32x4*)(pr + (size_t)3 * NCTX * DM + q * 256));
                v[q] += (*(const f32x4*)(pgate + lane * 4 + q * 256) * psc) * s4; *(f32x4*)(Hw + (size_t)row * DM + lane * 4 + q * 256) = v[q]; }
        }
#pragma unroll
        for (int q = 0; q < 4; ++q) ss += (v[q][0] * v[q][0] + v[q][1] * v[q][1]) + (v[q][2] * v[q][2] + v[q][3] * v[q][3]);
        ss += __builtin_bit_cast(float, __builtin_amdgcn_update_dpp(0, __builtin_bit_cast(int, ss), 0xB1, 0xF, 0xF, true));
        ss += __builtin_bit_cast(float, __builtin_amdgcn_update_dpp(0, __builtin_bit_cast(int, ss), 0x4E, 0xF, 0xF, true));
        ss += __builtin_bit_cast(float, __builtin_amdgcn_update_dpp(0, __builtin_bit_cast(int, ss), 0x141, 0xF, 0xF, true));
        ss += __builtin_bit_cast(float, __builtin_amdgcn_update_dpp(0, __builtin_bit_cast(int, ss), 0x140, 0xF, 0xF, true));
        ss += shx(ss, 16, lane); ss += shx(ss, 32, lane);
        const float rstd = rsqrtf(ss * (1.f / DM) + EPS);
        if (outb) {
            const int bi = row < NLAT ? (row >> 12) : 16;
            const float* sh = mods_l + (size_t)bi * 9216 + shift_idx * 1024 + lane * 4; const float* sc = mods_l + (size_t)bi * 9216 + scale_idx * 1024 + lane * 4;
#pragma unroll
            for (int q = 0; q < 4; ++q) {
                const f32x4 g = *(const f32x4*)(gw + lane * 4 + q * 256), s = *(const f32x4*)(sc + q * 256), t = *(const f32x4*)(sh + q * 256);
                const f32x4 y = (v[q] * rstd * g) * (s + 1.f) + t;
                u32x2 w; w.x = cvt_pk_bf16(y[0], y[1]); w.y = cvt_pk_bf16(y[2], y[3]);
                *(u32x2*)(outb + (size_t)row * DM + lane * 4 + q * 256) = w;
            }
        } else {
#pragma unroll
            for (int q = 0; q < 4; ++q) { const f32x4 g = *(const f32x4*)(gw + lane * 4 + q * 256); *(f32x4*)(outf + (size_t)row * DM + lane * 4 + q * 256) = v[q] * rstd * g; }
        }
    }
}

__device__ void phase_convert(const Params& p, int l, LAS unsigned char* lds) {
    LAS float* tile = (LAS float*)lds;
    const int tid = opaque_tid();
    for (int u = blockIdx.x; u < 5176; u += gridDim.x) {
        const float* src; int Nsrc, K; bf16_t* dst; int kind = KNAT, which = 0; const float* ksc = nullptr; int t = u;
        if (t < 4224) { const int j = t / 704; t %= 704; const int f = j / 3, mm = j % 3;
            if (mm < 2) { src = (f ? (mm ? p.ffn2_w3 : p.ffn2_w1) : (mm ? p.ffn1_w3 : p.ffn1_w1)) + (size_t)l * DM * DFF; Nsrc = DFF; K = DM; dst = f ? p.Bt13b : p.Bt13a; kind = KSWI; which = mm; }
            else { src = (f ? p.ffn2_w2 : p.ffn1_w2) + (size_t)l * DFF * DM; Nsrc = DM; K = DFF; dst = f ? p.Bt2b : p.Bt2a; } }
        else if ((t -= 4224) < 624) { src = p.w_in + (size_t)l * DM * INW; Nsrc = INW; K = DM; dst = p.Btin; kind = KIN; }
        else if ((t -= 624) < 256) { src = p.w_out + (size_t)l * DM * DM; Nsrc = DM; K = DM; dst = p.Btout; }
        else if ((t -= 256) < 36) { src = p.mla_w_uq + (size_t)l * 384 * 384; Nsrc = 384; K = 384; dst = p.Btuq; kind = KUQ; ksc = p.mla_q_norm + l * 384; }
        else if ((t -= 36) < 32) { src = p.mla_w_ukv + (size_t)l * 256 * 512; Nsrc = 512; K = 256; dst = p.Btukv; kind = KUKV; ksc = p.mla_kv_norm + l * 256; }
        else { t -= 32; src = p.pool_w + (size_t)(l * 4 + t) * 4096; Nsrc = 64; K = 64; dst = p.Btpool + t * 4096; t = 0; }
        const int nkt = K / 64; const int c0 = (t / nkt) * 64, k0 = (t % nkt) * 64;
        { const int cl = tid & 63, ks = tid >> 6; const int c = c0 + cl;
#pragma unroll
          for (int kk = 0; kk < 8; ++kk) { const int k = ks + 8 * kk; tile[k * 65 + cl] = c < Nsrc ? src[(size_t)(k0 + k) * Nsrc + c] : 0.f; } }
        __syncthreads();
        { const int cl = tid >> 3, kseg = tid & 7; const int c = c0 + cl;
          if (c < Nsrc) { const int row = dstrow(kind, which, c); float v[8];
#pragma unroll
              for (int i = 0; i < 8; ++i) v[i] = tile[(kseg * 8 + i) * 65 + cl] * (ksc ? ksc[k0 + kseg * 8 + i] : 1.f);
              u32x4 w; w.x = cvt_pk_bf16(v[0], v[1]); w.y = cvt_pk_bf16(v[2], v[3]); w.z = cvt_pk_bf16(v[4], v[5]); w.w = cvt_pk_bf16(v[6], v[7]);
              *(u32x4*)(dst + (size_t)row * K + k0 + kseg * 8) = w; } }
        __syncthreads();
    }
}

template <int K> __device__ __forceinline__ void win_sum(const float* base, size_t stride, int cnt, f32x4& s0, f32x4& s1) {
    f32x4 v0[K], v1[K];
#pragma unroll
    for (int i = 0; i < K; ++i) { const float* q = base + (size_t)min(i, cnt - 1) * stride; v0[i] = *(const f32x4*)q; v1[i] = *(const f32x4*)(q + 4); }
#pragma unroll
    for (int i = 0; i < K; ++i) { const float w = i < cnt ? 1.f : 0.f; s0 += v0[i] * w; s1 += v1[i] * w; }
}
__device__ __forceinline__ void win_sum_g(int g, const float* base, size_t stride, int cnt, f32x4& s0, f32x4& s1) {
    if (g == 0) win_sum<2>(base, stride, cnt, s0, s1); else if (g == 1) win_sum<4>(base, stride, cnt, s0, s1); else if (g == 2) win_sum<8>(base, stride, cnt, s0, s1); else win_sum<16>(base, stride, cnt, s0, s1);
}
__device__ void phase_pool(const Params& p, int l, bool with_ctx, LAS unsigned char* lds) {
    LAS float* V = (LAS float*)lds;
    LAS bf16_t* Dm = (LAS bf16_t*)(lds + 17408);
    const int tid = opaque_tid(), wid = tid >> 6, lane = tid & 63, c16 = lane & 15, gq = lane >> 4;
    const int c = tid >> 3, ch0 = (tid & 7) * 8;
    const int nunits = 4096 + (with_ctx ? 256 : 0);
    const float* ps = p.pool_scale + l * 256;
    for (int uu = blockIdx.x; uu < nunits; uu += gridDim.x) {
        const int u = (uu & ~255) | ((uu & 7) << 5) | ((uu & 255) >> 3);
        const bool lat = u < 4096; int b, g, r, tok0;
        if (lat) { b = u >> 8; g = (u >> 6) & 3; r = u & 63; tok0 = b * 4096 + r * 64; }
        else { const int uu = u - 4096; b = uu >> 4; g = (uu >> 2) & 3; r = uu & 3; tok0 = NLAT + b * 256 + r * 64; }
        const int k = 2 << g, lo = k >> 1, hi = k - 1 - lo;
        const float* Ug = p.U + g * 64 + ch0;
        f32x4 m0 = (f32x4){0.f, 0.f, 0.f, 0.f}, m1 = m0; float inv;
        if (lat) {
            const int r0 = max(r - lo, 0), r1 = min(r + hi, 63);
            f32x4 a0 = m0, a1 = m0;
            win_sum_g(g, Ug + (size_t)(b * 4096 + r0 * 64 + c) * 256, (size_t)64 * 256, r1 - r0 + 1, a0, a1);
            const float ir = 1.f / (float)(r1 - r0 + 1);
            *(LAS f32x4*)(V + c * 68 + ch0) = a0 * ir; *(LAS f32x4*)(V + c * 68 + ch0 + 4) = a1 * ir;
            __syncthreads();
            const int cc0 = max(c - lo, 0), cc1 = min(c + hi, 63);
            for (int cc = cc0; cc <= cc1; ++cc) { m0 += *(const LAS f32x4*)(V + cc * 68 + ch0); m1 += *(const LAS f32x4*)(V + cc * 68 + ch0 + 4); }
            inv = 1.f / (float)(cc1 - cc0 + 1);
        } else {
            const int i = r * 64 + c, i0 = max(i - lo, 0), i1 = min(i + hi, 255);
            win_sum_g(g, Ug + (size_t)(NLAT + b * 256 + i0) * 256, (size_t)256, i1 - i0 + 1, m0, m1);
            inv = 1.f / (float)(i1 - i0 + 1);
        }
        { const float* q = Ug + (size_t)(tok0 + c) * 256; const f32x4 u0 = *(const f32x4*)q, u1 = *(const f32x4*)(q + 4);
          const f32x4 d0 = m0 * inv - u0, d1 = m1 * inv - u1;
          u32x4 w; w.x = cvt_pk_bf16(d0[0], d0[1]); w.y = cvt_pk_bf16(d0[2], d0[3]); w.z = cvt_pk_bf16(d1[0], d1[1]); w.w = cvt_pk_bf16(d1[2], d1[3]);
          *(LAS u32x4*)(Dm + c * 72 + ch0) = w; }
        __syncthreads();
        const int tb = wid >> 1;
#pragma unroll
        for (int o = 0; o < 2; ++o) {
            const int ob = (wid & 1) * 2 + o; f32x4 acc = (f32x4){0.f, 0.f, 0.f, 0.f};
#pragma unroll
            for (int ks = 0; ks < 2; ++ks) {
                const bf16x8 a = *(const bf16x8*)(p.Btpool + g * 4096 + (ob * 16 + c16) * 64 + ks * 32 + gq * 8);
                const bf16x8 bb = *(const LAS bf16x8*)(Dm + (tb * 16 + c16) * 72 + ks * 32 + gq * 8);
                acc = __builtin_amdgcn_mfma_f32_16x16x32_bf16(a, bb, acc, 0, 0, 0);
            }
            const int tok = tok0 + tb * 16 + c16, oc = g * 64 + ob * 16 + 4 * gq;
            const f32x4 sc = *(const f32x4*)(ps + oc);
            u32x2 w; w.x = cvt_pk_bf16(acc[0] * sc[0], acc[1] * sc[1]); w.y = cvt_pk_bf16(acc[2] * sc[2], acc[3] * sc[3]);
            *(u32x2*)(p.XN + (size_t)tok * DM + oc) = w;
        }
        __syncthreads();
    }
}

typedef float f32x16 __attribute__((ext_vector_type(16)));
#define ROWMAX32(out, A, B) do { \
    asm("v_max3_f32 %0, %1, %2, %3\n\tv_max3_f32 %0, %0, %4, %5\n\tv_max3_f32 %0, %0, %6, %7\n\tv_max3_f32 %0, %0, %8, %9\n\tv_max3_f32 %0, %0, %10, %11\n\tv_max3_f32 %0, %0, %12, %13\n\tv_max3_f32 %0, %0, %14, %15\n\tv_max3_f32 %0, %0, %16, %16" \
        : "=&v"(out) : "v"((A)[0]), "v"((A)[1]), "v"((A)[2]), "v"((A)[3]), "v"((A)[4]), "v"((A)[5]), "v"((A)[6]), "v"((A)[7]), "v"((A)[8]), "v"((A)[9]), "v"((A)[10]), "v"((A)[11]), "v"((A)[12]), "v"((A)[13]), "v"((A)[14]), "v"((A)[15])); \
    asm("v_max3_f32 %0, %0, %1, %2\n\tv_max3_f32 %0, %0, %3, %4\n\tv_max3_f32 %0, %0, %5, %6\n\tv_max3_f32 %0, %0, %7, %8\n\tv_max3_f32 %0, %0, %9, %10\n\tv_max3_f32 %0, %0, %11, %12\n\tv_max3_f32 %0, %0, %13, %14\n\tv_max3_f32 %0, %0, %15, %16" \
        : "+v"(out) : "v"((B)[0]), "v"((B)[1]), "v"((B)[2]), "v"((B)[3]), "v"((B)[4]), "v"((B)[5]), "v"((B)[6]), "v"((B)[7]), "v"((B)[8]), "v"((B)[9]), "v"((B)[10]), "v"((B)[11]), "v"((B)[12]), "v"((B)[13]), "v"((B)[14]), "v"((B)[15])); } while (0)

template <int DQK, int DV, bool DIFF>
__device__ __forceinline__ void attn_unit(LAS unsigned char* lds, const bf16_t* Qp, int ldq, const bf16_t* Kp, size_t kmap_stride, const bf16_t* Vtp, int kv_len,
                                          bf16_t* outp  , float lam, float post, const float* subln) {
    constexpr int NMAP = DIFF ? 2 : 1;
    constexpr int KROW = DQK * 2 + 16, VROW = 144, KBYTES = 64 * KROW, VBYTES = DV * VROW, KBUF = NMAP * KBYTES, OFFV = 2 * KBUF;
    constexpr int KC8 = DQK / 8, KCH = NMAP * 64 * KC8, VCH = DV * 8, NLK = (KCH + 511) / 512, NLV = (VCH + 511) / 512, NKS = DQK / 16, NDB = DV / 32;
    const int tid = opaque_tid(), wid = tid >> 6, lane = tid & 63, q32 = lane & 31, h = lane >> 5;
    const int qg = DIFF ? (wid >> 1) : wid, mp = DIFF ? (wid & 1) : 0;
    bf16x8 qf[NKS];
    { const bf16_t* qr = Qp + (size_t)(qg * 32 + q32) * ldq + mp * 64 + h * 8;
#pragma unroll
      for (int ks = 0; ks < NKS; ++ks) qf[ks] = *(const bf16x8*)(qr + ks * 16); }
    f32x16 O[NDB];
#pragma unroll
    for (int db = 0; db < NDB; ++db)
#pragma unroll
        for (int j = 0; j < 16; ++j) O[db][j] = 0.f;
    float lsum = 0.f;
    f32x16 mneg;
#pragma unroll
    for (int j = 0; j < 16; ++j) mneg[j] = 0.f;
    u32x4 stk[NLK], stv[NLV];
    auto kchunk = [&](int i) { const int ch = tid + i * 512; return ch < KCH ? ch : ch - 256; };
    auto gloadK = [&](int t) {
#pragma unroll
        for (int i = 0; i < NLK; ++i) { const int ch = kchunk(i), mpc = ch / (64 * KC8), cc = ch % (64 * KC8); stk[i] = *(const u32x4*)(Kp + (size_t)mpc * kmap_stride + (size_t)t * 64 * DQK + cc * 8); } };
    auto lstoreK = [&](int t) {
#pragma unroll
        for (int i = 0; i < NLK; ++i) { const int ch = kchunk(i), mpc = ch / (64 * KC8), cc = ch % (64 * KC8); *(LAS u32x4*)(lds + (t & 1) * KBUF + mpc * KBYTES + (cc / KC8) * KROW + (cc % KC8) * 16) = stk[i]; } };
    static_assert(VCH % 512 == 0 && KCH >= 512 && KCH - 256 >= 0, "chunk maps");
    auto gloadV = [&](int t) {
#pragma unroll
        for (int i = 0; i < NLV; ++i) { const int cc = tid + i * 512; stv[i] = *(const u32x4*)(Vtp + (size_t)(cc >> 3) * KVL + t * 64 + (cc & 7) * 8); } };
    auto lstoreV = [&](int t) {
#pragma unroll
        for (int i = 0; i < NLV; ++i) { const int cc = tid + i * 512; *(LAS u32x4*)(lds + OFFV + (t & 1) * VBYTES + (cc >> 3) * VROW + (cc & 7) * 16) = stv[i]; } };
    const int nt = kv_len / 64;
    gloadK(0); gloadV(0); lstoreK(0); lstoreV(1);
    gloadK(1); lstoreK(1);
    __syncthreads();
    f32x16 Sc[2], Sn[2];
    {
        const LAS unsigned char* kb_ = lds + mp * KBYTES + q32 * KROW + h * 16;
#pragma unroll
        for (int kb = 0; kb < 2; ++kb) {
#pragma unroll
            for (int j = 0; j < 16; ++j) Sc[kb][j] = 0.f;
#pragma unroll
            for (int ks = 0; ks < NKS; ++ks) { const bf16x8 a = *(const LAS bf16x8*)(kb_ + kb * 32 * KROW + ks * 32); Sc[kb] = __builtin_amdgcn_mfma_f32_32x32x16_bf16(a, qf[ks], Sc[kb], 0, 0, 0); }
        }
    }
    __syncthreads();
    __builtin_amdgcn_sched_barrier(0);
    asm volatile("s_nop 15\n\ts_nop 15\n\ts_nop 15\n\ts_nop 15\n\ts_nop 15\n\ts_nop 15" ::: "memory");
    __builtin_amdgcn_sched_barrier(0);
    float lm_cur;
    ROWMAX32(lm_cur, Sc[0], Sc[1]);
    bf16x8 Pa[2][2], Pb[2][2];
#pragma unroll
    for (int kb = 0; kb < 2; ++kb)
#pragma unroll
        for (int s = 0; s < 2; ++s)
#pragma unroll
            for (int e = 0; e < 8; ++e) Pa[kb][s][e] = 0;
    auto step = [&](f32x16 (&Sa)[2], f32x16 (&Sb)[2], bf16x8 (&Pp)[2][2], bf16x8 (&Pn)[2][2], int t) {
        const float lm = lm_cur;
        if (t == 0 || __builtin_amdgcn_ballot_w64(lm > 8.f) != 0) {
            const float mx = fmaxf(lm, shx(lm, 32, lane));
            const float delta = (t == 0 || mx > 8.f) ? mx : 0.f;
            const float alpha = t == 0 ? 1.f : fast_exp2(-delta);
            lsum *= alpha;
#pragma unroll
            for (int j = 0; j < 16; ++j) { mneg[j] -= delta; Sa[0][j] -= delta; Sa[1][j] -= delta; }
#pragma unroll
            for (int db = 0; db < NDB; ++db) O[db] *= alpha;
#pragma unroll
            for (int kb = 0; kb < 2; ++kb)
#pragma unroll
                for (int s = 0; s < 2; ++s) { u32x4 w = __builtin_bit_cast(u32x4, Pp[kb][s]);
#pragma unroll
                    for (int e = 0; e < 4; ++e) w[e] = cvt_pk_bf16(__uint_as_float(w[e] << 16) * alpha, __uint_as_float(w[e] & 0xffff0000u) * alpha);
                    Pp[kb][s] = __builtin_bit_cast(bf16x8, w); }
        }
        gloadK(min(t + 2, nt - 1)); gloadV(t);
        const LAS unsigned char* kb_ = lds + ((t + 1) & 1) * KBUF + mp * KBYTES + q32 * KROW + h * 16;
        const LAS unsigned char* vb_ = lds + OFFV + ((t + 1) & 1) * VBYTES + q32 * VROW + h * 16;
        constexpr int NQK = 2 * NKS, NM = NQK + 4 * NDB, NG = NM / 4, PPG = (16 + NG - 2) / (NG - 1);
        static_assert(NM % 4 == 0, "MFMA groups of four");
        bf16x8 fr[2][4];
        float ps0 = 0.f;
        unsigned pk[2][8];
#define ATT_LOADGRP(g) _Pragma("unroll") for (int q_ = 0; q_ < 4; ++q_) { const int i_ = 4 * (g) + q_; \
            fr[(g) & 1][q_] = (i_ < NQK) ? *(const LAS bf16x8*)(kb_ + (i_ / NKS) * 32 * KROW + (i_ % NKS) * 32) \
                                         : *(const LAS bf16x8*)(vb_ + ((i_ - NQK) / 4) * 32 * VROW + (((i_ - NQK) / 2) & 1) * 64 + ((i_ - NQK) & 1) * 32); }
        ATT_LOADGRP(0);
#pragma unroll
        for (int g = 0; g < NG; ++g) {
            if (g + 1 < NG) { ATT_LOADGRP(g + 1); }
#pragma unroll
            for (int q_ = 0; q_ < 4; ++q_) { const int i_ = 4 * g + q_;
                if (i_ < NQK) { const int kb = i_ / NKS, ks = i_ % NKS;
                    if (ks == 0) Sb[kb] = __builtin_amdgcn_mfma_f32_32x32x16_bf16(fr[g & 1][q_], qf[ks], mneg, 0, 0, 0);
                    else Sb[kb] = __builtin_amdgcn_mfma_f32_32x32x16_bf16(fr[g & 1][q_], qf[ks], Sb[kb], 0, 0, 0); }
                else { const int j_ = i_ - NQK, db = j_ / 4, kb = (j_ / 2) & 1, sx = j_ & 1; O[db] = __builtin_amdgcn_mfma_f32_32x32x16_bf16(fr[g & 1][q_], Pp[kb][sx], O[db], 0, 0, 0); } }
#pragma unroll
            for (int pp = g * PPG; pp < (g + 1) * PPG && pp < 16; ++pp) { const int kb = pp / 8, j = pp % 8;
                Sa[kb][2 * j] = fast_exp2(Sa[kb][2 * j]); Sa[kb][2 * j + 1] = fast_exp2(Sa[kb][2 * j + 1]); }
            if (g > 0) {
#pragma unroll
                for (int pp = (g - 1) * PPG; pp < g * PPG && pp < 16; ++pp) { const int kb = pp / 8, j = pp % 8;
                    asm("v_add_f32 %0, %1, %2" : "=v"(ps0) : "v"(ps0), "v"(Sa[kb][2 * j])); asm("v_add_f32 %0, %1, %2" : "=v"(ps0) : "v"(ps0), "v"(Sa[kb][2 * j + 1]));
                    pk[kb][j] = cvt_pk_bf16(Sa[kb][2 * j], Sa[kb][2 * j + 1]); }
            }
            if (g == NG - 2) { lstoreK(t + 2); lstoreV(t); }
            if (g == NG - 1) {
                float lmn;
                ROWMAX32(lmn, Sb[0], Sb[1]);
                lm_cur = lmn;
            }
            __builtin_amdgcn_sched_barrier(0);
        }
#pragma unroll
        for (int pp = (NG - 1) * PPG; pp < 16; ++pp) { const int kb = pp / 8, j = pp % 8;
            asm("v_add_f32 %0, %1, %2" : "=v"(ps0) : "v"(ps0), "v"(Sa[kb][2 * j])); asm("v_add_f32 %0, %1, %2" : "=v"(ps0) : "v"(ps0), "v"(Sa[kb][2 * j + 1]));
            pk[kb][j] = cvt_pk_bf16(Sa[kb][2 * j], Sa[kb][2 * j + 1]); }
#undef ATT_LOADGRP
#pragma unroll
        for (int kb = 0; kb < 2; ++kb) { Pn[kb][0] = __builtin_bit_cast(bf16x8, (u32x4){pk[kb][0], pk[kb][1], pk[kb][2], pk[kb][3]}); Pn[kb][1] = __builtin_bit_cast(bf16x8, (u32x4){pk[kb][4], pk[kb][5], pk[kb][6], pk[kb][7]}); }
        lsum += ps0;
        __syncthreads();
    };
    for (int t = 0; t < nt; t += 2) { step(Sc, Sn, Pa, Pb, t); step(Sn, Sc, Pb, Pa, t + 1); }
    bf16x8 (&pfp)[2][2] = Pa;
    { const LAS unsigned char* vb_ = lds + OFFV + ((nt - 1) & 1) * VBYTES + q32 * VROW + h * 16;
#pragma unroll
      for (int db = 0; db < NDB; ++db)
#pragma unroll
          for (int kb = 0; kb < 2; ++kb)
#pragma unroll
              for (int s = 0; s < 2; ++s) { const bf16x8 a = *(const LAS bf16x8*)(vb_ + db * 32 * VROW + kb * 64 + s * 32); O[db] = __builtin_amdgcn_mfma_f32_32x32x16_bf16(a, pfp[kb][s], O[db], 0, 0, 0); } }
    __syncthreads();
    const int te_ = opaque_tid(), lane_e = te_ & 63, q32e = lane_e & 31, he = lane_e >> 5;
    const float ltot = lsum + shx(lsum, 32, lane_e);
    const float inv = 1.f / ltot;
    bf16_t* orow = outp + (size_t)(qg * 32 + q32e) * DM + 4 * he;
    if constexpr (!DIFF) {
#pragma unroll
        for (int db = 0; db < NDB; ++db)
#pragma unroll
            for (int jj = 0; jj < 4; ++jj) { u32x2 w; w.x = cvt_pk_bf16(O[db][4 * jj] * inv, O[db][4 * jj + 1] * inv); w.y = cvt_pk_bf16(O[db][4 * jj + 2] * inv, O[db][4 * jj + 3] * inv);
                *(u32x2*)(orow + db * 32 + jj * 8) = w; }
    } else {
        LAS float* X = (LAS float*)lds + (qg * 32 + q32e) * 132 + 4 * he;
        if (mp == 1) { float lam_ = lam; asm volatile("" : "+v"(lam_)); const float sc = lam_ * inv;
#pragma unroll
            for (int db = 0; db < NDB; ++db)
#pragma unroll
                for (int jj = 0; jj < 4; ++jj) *(LAS f32x4*)(X + db * 32 + jj * 8) = (f32x4){O[db][4 * jj] * sc, O[db][4 * jj + 1] * sc, O[db][4 * jj + 2] * sc, O[db][4 * jj + 3] * sc}; }
        __syncthreads();
        if (mp == 0) {
            float ss = 0.f;
#pragma unroll
            for (int db = 0; db < NDB; ++db)
#pragma unroll
                for (int jj = 0; jj < 4; ++jj) { const f32x4 x = *(const LAS f32x4*)(X + db * 32 + jj * 8);
#pragma unroll
                    for (int e = 0; e < 4; ++e) { const float o = O[db][4 * jj + e] * inv - x[e]; O[db][4 * jj + e] = o; ss += o * o; } }
            ss += shx(ss, 32, lane_e);
            float li_ = post; asm volatile("" : "+v"(li_));
            const float r = rsqrtf(ss * (1.f / DV) + EPS) * (1.f - li_);
#pragma unroll
            for (int db = 0; db < NDB; ++db)
#pragma unroll
                for (int jj = 0; jj < 4; ++jj) { const f32x4 gsub = *(const f32x4*)(subln + db * 32 + jj * 8 + 4 * he);
                    u32x2 w; w.x = cvt_pk_bf16(O[db][4 * jj] * r * gsub[0], O[db][4 * jj + 1] * r * gsub[1]); w.y = cvt_pk_bf16(O[db][4 * jj + 2] * r * gsub[2], O[db][4 * jj + 3] * r * gsub[3]);
                    *(u32x2*)(orow + db * 32 + jj * 8) = w; }
        }
        __syncthreads();
    }
}

__device__ void phase_attn(const Params& p, int l, bool with_ctx, LAS unsigned char* lds) {
    const float lam_init = 0.8f - 0.6f * expf(-0.3f * (float)l);
    const float* dl = p.diff_lambda + l * 256;
    float s1 = 0.f, s2 = 0.f;
    for (int i = 0; i < 64; ++i) { s1 += dl[i] * dl[64 + i]; s2 += dl[128 + i] * dl[192 + i]; }
    const float lam = __builtin_bit_cast(float, __builtin_amdgcn_readfirstlane(__builtin_bit_cast(int, expf(s1) - expf(s2) + lam_init)));
    const float post_scale = __builtin_bit_cast(float, __builtin_amdgcn_readfirstlane(__builtin_bit_cast(int, 1.f - lam_init)));
    const int total = 3072 + (with_ctx ? 192 : 0);
    for (int u = blockIdx.x; u < total; u += gridDim.x) {
        bool diff; int b, h, row0, kvlen;
        if (u < 2048) { diff = true; const int i = u >> 8, blk = u & 255, bh = i * 8 + (blk & 7), qb = blk >> 3; b = bh >> 2; h = bh & 3; row0 = b * 4096 + qb * 128; kvlen = KVL; }
        else if (u < 3072) { diff = false; const int uu = u - 2048, i = uu >> 8, blk = uu & 255, slot = blk >> 3, bh = i * 16 + 2 * (blk & 7) + (slot >> 4), qb = slot & 15; b = bh >> 2; h = bh & 3; row0 = b * 4096 + qb * 256; kvlen = KVL; }
        else if (u < 3200) { diff = true; const int uu = u - 3072, bh = uu >> 1; b = bh >> 2; h = bh & 3; row0 = NLAT + b * 256 + (uu & 1) * 128; kvlen = CTXL; }
        else { diff = false; const int bh = u - 3200; b = bh >> 2; h = bh & 3; row0 = NLAT + b * 256; kvlen = CTXL; }
        if (diff) attn_unit<64, 128, true>(lds, p.QD + (size_t)row0 * 512 + (2 * h) * 64, 512, p.KD + (size_t)(b * 8 + 2 * h) * KVL * 64, (size_t)KVL * 64, p.VTD + (size_t)(b * 4 + h) * 128 * KVL, kvlen,
                                           p.XN + (size_t)row0 * DM + 512 + h * 128, lam, lam_init, p.diff_subln + l * 128);
        else attn_unit<96, 64, false>(lds, p.QM + (size_t)row0 * 384 + h * 96, 384, p.KM + (size_t)(b * 4 + h) * KVL * 96, 0, p.VTM + (size_t)(b * 4 + h) * 64 * KVL, kvlen,
                                      p.XN + (size_t)row0 * DM + 256 + h * 64, 0.f, 1.f, nullptr);
    }
}

constexpr int NPHASE = 2 + DEPTH * 11;
__device__ __forceinline__ void run_phase(const Params& p, int ph, LAS unsigned char* lds) {
    const int G = (int)gridDim.x, cb = (int)blockIdx.x;
    if (ph == 0) { phase_init(p, lds); return; }
    if (ph == NPHASE - 1) { phase_norm(p.H, p.H, NLAT, p.final_norm, nullptr, 0, 0, nullptr, p.out, nullptr, nullptr, 0.f, nullptr); return; }
    const int l = (ph - 1) / 11, k = (ph - 1) % 11; const bool last = l == DEPTH - 1;
    const float* mods_l = p.MODS + (size_t)l * 17 * 9216;
    const int Mlate = last ? NLAT : NT;
    pg8::StaticOrder S;
    if (k == 0 || k == 3 || k == 8) {
        const float* gw = (k == 0 ? p.ffn1_norm : k == 3 ? p.mix_norm : p.ffn2_norm) + l * DM;
        const int si = k == 8 ? 6 : k;
        const bool first = (l == 0 && k == 0);
        const bool pend = !first && !(k == 8 && last);
        const float* pgate = (k == 0 ? mods_l - 17 * 9216 + 8 * 1024 : k == 3 ? mods_l + 2 * 1024 : mods_l + 5 * 1024) + (size_t)16 * 9216;
        const bool ctx_in = (l == 0 && k <= 3);
        phase_norm(first ? p.x : p.H, ctx_in ? p.ctx - (size_t)NLAT * DM : p.H, k == 8 ? Mlate : NT, gw, mods_l, si, si + 1, p.XN, nullptr, pend ? p.P4 : nullptr, pgate, k == 8 ? 1.f : 0.5f, p.H);
        if (k == 0) phase_convert(p, l, lds);
    } else if (k == 1 || k == 9) {
        pg8::Gemm g{p.XN, k == 1 ? p.Bt13a : p.Bt13b, k == 1 ? NT : Mlate, 2 * DFF, DM, DM};
        S.init(g.M, g.N, G, cb); EpiSwiGLU E{p.G};
        pg8::gemm_phase(lds, g, S, E);
    } else if (k == 2 || k == 7 || k == 10) {
        const int Kf = k == 7 ? DM : DFF;
        const bf16_t* Ap = k == 7 ? p.XN : p.G; const bf16_t* Bp = k == 2 ? p.Bt2a : k == 7 ? p.Btout : p.Bt2b;
        const bool first = (l == 0 && k == 2);
        { pg8::Gemm g{Ap, Bp, NLAT, DM, Kf, Kf};
          S.init(g.M, g.N, G, cb); EpiResid E{first ? p.x : p.H, p.H, p.H, mods_l + (k == 2 ? 2 : k == 7 ? 5 : 8) * 1024, k == 7 ? 1.f : 0.5f};
          pg8::gemm_phase(lds, g, S, E); }
        if (k == 2 || !last) {
            const int kt = Kf / 128, q0 = kt / 4, r0 = kt % 4;
            for (int idx = cb; idx < 256; idx += G) {
                const int unit = idx >> 2, sl = idx & 3;
                const int kb0 = sl * q0 + (sl < r0 ? sl : r0), kl = q0 + (sl < r0 ? 1 : 0);
                pg8::Gemm g{Ap + (size_t)NLAT * Kf + kb0 * 128, Bp + kb0 * 128, NCTX, DM, kl * 128, Kf};
                S.init(g.M, g.N, G, cb); S.fixed = unit;
                EpiPartial E{p.P4 + (size_t)sl * NCTX * DM};
                __syncthreads();
                pg8::gemm_phase(lds, g, S, E);
            }
        }
    } else if (k == 4) {
        pg8::Gemm g{p.XN, p.Btin, NT, 2560, DM, DM};
        S.init(g.M, g.N, G, cb); EpiIn E{p.U, p.CQ, p.CKV, p.SSQ, p.QD, p.KD, p.VTD, p.KM, p.ROPED, p.ROPEM, lds + 131072};
        pg8::gemm_phase(lds, g, S, E);
    } else if (k == 5) {
        { pg8::Gemm g{p.CQ, p.Btuq, NT, 512, 384, 384}; S.init(g.M, g.N, G, cb); EpiQup E{p.SSQ, p.QM, p.ROPEM}; pg8::gemm_phase(lds, g, S, E); }
        { pg8::Gemm g{p.CKV, p.Btukv, NT, 512, 256, 256}; S.init(g.M, g.N, G, (cb + 32) % G); EpiKVup E{p.SSQ, p.KM, p.VTM, lds + 131072}; pg8::gemm_phase(lds, g, S, E); }
        __syncthreads();
        phase_pool(p, l, !last, lds);
    } else if (k == 6) {
        phase_attn(p, l, !last, lds);
    }
}

__device__ __forceinline__ void grid_barrier(unsigned* ctr, unsigned target) {
    asm volatile("s_waitcnt vmcnt(0) lgkmcnt(0)" ::: "memory");
    __syncthreads();
    if (threadIdx.x == 0) {
        __builtin_amdgcn_fence(__ATOMIC_RELEASE, "agent");
        asm volatile("s_waitcnt vmcnt(0)" ::: "memory");
        __hip_atomic_fetch_add(ctr, 1u, __ATOMIC_RELAXED, __HIP_MEMORY_SCOPE_AGENT);
        while (__hip_atomic_load(ctr, __ATOMIC_RELAXED, __HIP_MEMORY_SCOPE_AGENT) < target) __builtin_amdgcn_s_sleep(2);
        __builtin_amdgcn_fence(__ATOMIC_ACQUIRE, "agent");
        asm volatile("s_waitcnt vmcnt(0)" ::: "memory");
    }
    __syncthreads();
}

__global__ __launch_bounds__(512, 2) void hymba_mega(Params p) {
    extern __shared__ __attribute__((aligned(16))) unsigned char smem[];
    LAS unsigned char* lds = (LAS unsigned char*)smem;
    cg::grid_group grid = cg::this_grid();
    unsigned nbar = 0;
    for (int ph = p.ph_lo; ph < p.ph_hi; ++ph) {
        run_phase(p, ph, lds);
        if (ph + 1 < p.ph_hi) {
            if (ph == p.ph_lo) grid.sync();
            else grid_barrier(p.BAR, ++nbar * gridDim.x);
        }
    }
}

extern "C" void kernel_launch(void* const* d_in, const int* in_sizes, int n_in, void* d_out, int out_size, void* d_ws, size_t ws_size, hipStream_t stream) {
    static int grid_blocks = 0;
    if (!grid_blocks) {
        int dev = 0, cus = 0, per_cu = 0;
        hipGetDevice(&dev);
        hipDeviceGetAttribute(&cus, hipDeviceAttributeMultiprocessorCount, dev);
        if (hipFuncSetAttribute((const void*)hymba_mega, hipFuncAttributeMaxDynamicSharedMemorySize, LDS_BYTES) != hipSuccess) fprintf(stderr, "hipFuncSetAttribute failed\n");
        if (hipOccupancyMaxActiveBlocksPerMultiprocessor(&per_cu, (const void*)hymba_mega, 512, LDS_BYTES) != hipSuccess || per_cu < 1) { per_cu = 1; (void)hipGetLastError(); }
        grid_blocks = cus * per_cu;
        if (grid_blocks <= 0) grid_blocks = 256;
    }
    Params p{};
    const float** in = (const float**)&p;
    for (int i = 0; i < 26 && i < n_in; ++i) in[i] = (const float*)d_in[i];
    p.out = (float*)d_out;
    unsigned char* w = (unsigned char*)d_ws; size_t off = 0;
    auto take = [&](size_t bytes) { unsigned char* r = w + off; off += (bytes + 255) & ~(size_t)255; return r; };
    p.H = (float*)take((size_t)NT * DM * 4);
    p.XN = (bf16_t*)take((size_t)NT * DM * 2);
    unsigned char* big = w + off; size_t boff = 0;
    auto takeb = [&](size_t bytes) { unsigned char* r = big + boff; boff += (bytes + 255) & ~(size_t)255; return r; };
    p.U = (float*)takeb((size_t)NT * 256 * 4);
    p.CQ = (bf16_t*)takeb((size_t)NT * 384 * 2);
    p.CKV = (bf16_t*)takeb((size_t)NT * 256 * 2);
    p.SSQ = (float*)takeb((size_t)NT * 16 * 4);
    p.QD = (bf16_t*)takeb((size_t)NT * 512 * 2);
    p.KD = (bf16_t*)takeb((size_t)NB * 8 * KVL * 64 * 2);
    p.VTD = (bf16_t*)takeb((size_t)NB * 4 * 128 * KVL * 2);
    p.QM = (bf16_t*)takeb((size_t)NT * 384 * 2);
    p.KM = (bf16_t*)takeb((size_t)NB * 4 * KVL * 96 * 2);
    p.VTM = (bf16_t*)takeb((size_t)NB * 4 * 64 * KVL * 2);
    p.G = (bf16_t*)big;
    p.P4 = (float*)(big + (((size_t)NT * DFF * 2 + 255) & ~(size_t)255));
    const size_t gbytes = (size_t)NT * DFF * 2;
    off += (boff > gbytes ? boff : gbytes); off = (off + 255) & ~(size_t)255;
    p.Bt13a = (bf16_t*)take((size_t)2 * DFF * DM * 2); p.Bt2a = (bf16_t*)take((size_t)DM * DFF * 2);
    p.Bt13b = (bf16_t*)take((size_t)2 * DFF * DM * 2); p.Bt2b = (bf16_t*)take((size_t)DM * DFF * 2);
    p.Btin = (bf16_t*)take((size_t)2560 * DM * 2); p.Btout = (bf16_t*)take((size_t)DM * DM * 2);
    p.Btuq = (bf16_t*)take((size_t)512 * 384 * 2); p.Btukv = (bf16_t*)take((size_t)512 * 256 * 2); p.Btpool = (bf16_t*)take((size_t)4 * 64 * 64 * 2);
    p.MODS = (float*)take((size_t)DEPTH * 17 * 9216 * 4);
    p.BAR = (unsigned*)take(256);
    p.ROPED = (float*)take((size_t)4096 * 32 * 2 * 4); p.ROPEM = (float*)take((size_t)4096 * 16 * 2 * 4);
    if (off > ws_size) { fprintf(stderr, "kernel_launch: workspace too small: need %zu have %zu\n", off, ws_size); return; }
    (void)hipMemsetAsync(p.BAR, 0, 256, stream);
#if MULTI_LAUNCH
    for (int ph = 0; ph < NPHASE; ++ph) { p.ph_lo = ph; p.ph_hi = ph + 1; hipLaunchKernelGGL(hymba_mega, dim3(grid_blocks), dim3(512), LDS_BYTES, stream, p); }
#else
    p.ph_lo = 0; p.ph_hi = NPHASE;
    void* args[] = {&p};
    hipError_t e = hipLaunchCooperativeKernel((const void*)hymba_mega, dim3(grid_blocks), dim3(512), args, LDS_BYTES, stream);
    if (e != hipSuccess) fprintf(stderr, "cooperative launch failed: %s (grid %d)\n", hipGetErrorString(e), grid_blocks);
#endif
}
```

```cpp
#include <hip/hip_runtime.h>
#include <hip/hip_cooperative_groups.h>
#include <cstdio>
namespace cg = cooperative_groups;

#define LAS __attribute__((address_space(3)))
typedef unsigned short bf16_t;
typedef short bf16x8 __attribute__((ext_vector_type(8)));
typedef float f32x4 __attribute__((ext_vector_type(4)));
typedef float f32x2 __attribute__((ext_vector_type(2)));
typedef unsigned u32x4 __attribute__((ext_vector_type(4)));
typedef unsigned u32x2 __attribute__((ext_vector_type(2)));

constexpr int DM = 1024, NB = 16, SEQ = 4096, DEPTH = 4, CTXL = 256, DFF = 2816;
constexpr int NLAT = NB * SEQ, NCTX = NB * CTXL, NT = NLAT + NCTX, KVL = SEQ + CTXL;
constexpr int INW = 2464;
constexpr float EPS = 1e-6f;
constexpr float LOG2E = 1.4426950408889634f;
constexpr int LDS_BYTES = 131072 + 8 * 3072;
#ifndef MULTI_LAUNCH
#define MULTI_LAUNCH 0
#endif

struct Params {
    const float *x, *c, *ctx, *c_ctx, *w_mod, *b_mod, *ffn1_norm, *ffn1_w1, *ffn1_w3, *ffn1_w2, *mix_norm, *w_in, *w_out, *pool_w, *pool_scale,
        *mla_q_norm, *mla_w_uq, *mla_kv_norm, *mla_w_ukv, *diff_lambda, *diff_subln, *ffn2_norm, *ffn2_w1, *ffn2_w3, *ffn2_w2, *final_norm;
    float* out;
    float* H; bf16_t* XN; bf16_t* G; float* U; bf16_t* CQ; bf16_t* CKV; float* SSQ; bf16_t* QD; bf16_t* KD; bf16_t* VTD; bf16_t* QM; bf16_t* KM; bf16_t* VTM;
    bf16_t *Bt13a, *Bt2a, *Bt13b, *Bt2b, *Btin, *Btout, *Btuq, *Btukv, *Btpool;
    float *MODS, *ROPED, *ROPEM;
    float* P4;
    unsigned* BAR;
    int ph_lo, ph_hi;
};

typedef __bf16 bf16x2_t __attribute__((ext_vector_type(2)));
__device__ __forceinline__ unsigned cvt_pk_bf16(float lo, float hi) { const f32x2 v = {lo, hi}; const bf16x2_t b = __builtin_convertvector(v, bf16x2_t); return __builtin_bit_cast(unsigned, b); }
__device__ __forceinline__ bf16_t f2bf(float v) { return (bf16_t)(cvt_pk_bf16(v, 0.f) & 0xffffu); }
__device__ __forceinline__ int opaque_tid() { int t = threadIdx.x; asm volatile("" : "+v"(t)); return t; }
__device__ __forceinline__ float shx(float v, int mask, int lane) { return __int_as_float(__builtin_amdgcn_ds_bpermute((lane ^ mask) << 2, __float_as_int(v))); }
__device__ __forceinline__ float fast_exp2(float x) { return __builtin_amdgcn_exp2f(x); }
__device__ __forceinline__ float fast_rcp(float x) { return __builtin_amdgcn_rcpf(x); }

namespace pg8 {
constexpr int BM = 256, BK = 64, HALF = 128, HTB = HALF * BK * 2, STAGE_BYTES = 8 * HTB, NXCD = 8, WGM = 4;
__host__ __device__ __forceinline__ int lds_byte(int r, int c) { const int st = (r >> 4) * 2 + (c >> 5), rr = r & 15, cc = c & 31, ob = rr * 64 + cc * 2; return st * 1024 + (ob ^ (((ob >> 9) & 1) << 5)); }
__host__ __device__ __forceinline__ void stage_rc(int b, int& R, int& C) { const int st = b / 1024, sb = b % 1024, swz = sb ^ (((sb >> 9) & 1) << 5); R = (st >> 1) * 16 + swz / 64; C = (st & 1) * 32 + (swz % 64) / 2; }
struct Unit { int pm, pn; };
struct Gemm { const bf16_t* A; const bf16_t* Bt; int M, N, K, ld; };
struct StaticOrder {
    int nM, nN, nwg, G, c, fixed;
    __device__ void init(int M, int N, int G_, int c_) { nM = M / BM; nN = N / BM; nwg = nM * nN; G = G_; c = c_; fixed = -1; }
    __device__ bool next(int i, Unit& u) const {
        if (fixed >= 0) { if (i > 0) return false; u.pm = fixed / nN; u.pn = fixed % nN; return true; }
        const long L = (long)i * G + c; if (L >= nwg) return false;
        int wgid = (int)L; { const int q = nwg / NXCD, r = nwg % NXCD, xcd = wgid % NXCD, off = wgid / NXCD; wgid = (xcd < r ? xcd * (q + 1) : r * (q + 1) + (xcd - r) * q) + off; }
        const int nig = WGM * nN, gid = wgid / nig, fm = gid * WGM, gsz = (nM - fm) < WGM ? (nM - fm) : WGM;
        u.pm = fm + ((wgid % nig) % gsz); u.pn = (wgid % nig) / gsz; return true;
    }
};
template <class Epi>
__device__ __forceinline__ void gemm_phase(LAS unsigned char* lds, const Gemm g, const StaticOrder& S, const Epi& E) {
    const int tid = opaque_tid(), wid = __builtin_amdgcn_readfirstlane(tid >> 6), lane = tid & 63, wr = wid >> 2, wc = wid & 3, fr = lane & 15, fq = lane >> 4;
    const int K = g.K, LD = g.ld, nt = K / BK;
    unsigned voffA[2];
#pragma unroll
    for (int i = 0; i < 2; ++i) { int R, C; stage_rc(tid * 16 + i * 8192, R, C); voffA[i] = (unsigned)(R * LD + C) * 2u; }
    const size_t kstep = (size_t)(BK * 2);
    const size_t hstep = (size_t)HALF * LD * 2;
    const size_t tstep = 2 * hstep;
    const unsigned ldsw = (unsigned)wid * 1024u;
    const int aoff = lds_byte(wr * 64 + fr, fq * 8), boff = lds_byte(wc * 32 + fr, fq * 8);
#define PG8_SA(b, h) (((b) * 2 + (h)) * HTB)
#define PG8_SB(b, h) ((4 + (b) * 2 + (h)) * HTB)
#define PG8_STAGE(bufoff, gbase, voff) do { _Pragma("unroll") for (int _i = 0; _i < 2; ++_i) \
        __builtin_amdgcn_global_load_lds((const unsigned*)((const char*)(gbase) + (voff)[_i]), (LAS unsigned*)(lds + (bufoff) + ldsw + _i * 8192), 16, 0, 0); } while (0)
#define PG8_LDA(dst, b, h) do { _Pragma("unroll") for (int m = 0; m < 4; ++m) _Pragma("unroll") for (int k = 0; k < 2; ++k) dst[m][k] = *(const LAS bf16x8*)(lds + PG8_SA(b, h) + aoff + m * 2048 + k * 1024); } while (0)
#define PG8_LDB(dst, b, h) do { _Pragma("unroll") for (int n = 0; n < 2; ++n) _Pragma("unroll") for (int k = 0; k < 2; ++k) dst[n][k] = *(const LAS bf16x8*)(lds + PG8_SB(b, h) + boff + n * 2048 + k * 1024); } while (0)
#define PG8_MMA(ai, bj, At, Bt) do { __builtin_amdgcn_s_setprio(1); _Pragma("unroll") for (int m = 0; m < 4; ++m) _Pragma("unroll") for (int n = 0; n < 2; ++n) _Pragma("unroll") for (int k = 0; k < 2; ++k) \
        acc[ai][bj][m][n] = __builtin_amdgcn_mfma_f32_16x16x32_bf16(Bt[n][k], At[m][k], acc[ai][bj][m][n], 0, 0, 0); __builtin_amdgcn_s_setprio(0); } while (0)
#define PG8_WAIT_V(n) asm volatile("s_waitcnt vmcnt(" #n ")" ::: "memory")
#define PG8_WAIT_L(n) asm volatile("s_waitcnt lgkmcnt(" #n ")" ::: "memory")
#define PG8_BAR __builtin_amdgcn_s_barrier()
#define PG8_SCHED __builtin_amdgcn_sched_barrier(0)
    Unit cur, nxt; int ui = 0;
    if (!S.next(0, cur)) return;
    f32x4 acc[2][2][4][2];
#pragma unroll
    for (int a = 0; a < 2; ++a)
#pragma unroll
        for (int b = 0; b < 2; ++b)
#pragma unroll
            for (int m = 0; m < 4; ++m)
#pragma unroll
                for (int n = 0; n < 2; ++n) acc[a][b][m][n] = (f32x4){0.f, 0.f, 0.f, 0.f};
    bf16x8 At[4][2], B0[2][2], B1[2][2];
    const char* cA = (const char*)g.A + (size_t)cur.pm * tstep; const char* cB = (const char*)g.Bt + (size_t)cur.pn * tstep;
    PG8_STAGE(PG8_SB(0, 0), cB, voffA); PG8_STAGE(PG8_SA(0, 0), cA, voffA); PG8_STAGE(PG8_SB(0, 1), cB + hstep, voffA); PG8_STAGE(PG8_SA(0, 1), cA + hstep, voffA);
    if (wr == 1) PG8_BAR;
    PG8_WAIT_V(4); PG8_BAR;
    PG8_STAGE(PG8_SB(1, 0), cB + kstep, voffA); PG8_STAGE(PG8_SA(1, 0), cA + kstep, voffA); PG8_STAGE(PG8_SB(1, 1), cB + hstep + kstep, voffA);
    PG8_WAIT_V(6); PG8_BAR;
    for (;;) {
        const bool has_next = S.next(ui + 1, nxt);
        const char* nA = has_next ? (const char*)g.A + (size_t)nxt.pm * tstep : cA; const char* nB = has_next ? (const char*)g.Bt + (size_t)nxt.pn * tstep : cB;
        for (int t = 0; t < nt; t += 2) {
            const bool last = (t == nt - 2);
            const char* a1 = cA + (size_t)(t + 1) * kstep;
            const char* a2 = last ? nA : cA + (size_t)(t + 2) * kstep; const char* b2 = last ? nB : cB + (size_t)(t + 2) * kstep;
            const char* a3 = a2 + kstep; const char* b3 = b2 + kstep;
            PG8_LDB(B0, 0, 0); PG8_SCHED; PG8_LDA(At, 0, 0); PG8_STAGE(PG8_SA(1, 1), a1 + hstep, voffA);
            PG8_WAIT_L(8); PG8_BAR; PG8_WAIT_L(0); PG8_MMA(0, 0, At, B0); PG8_BAR; PG8_SCHED;
            PG8_LDB(B1, 0, 1); PG8_STAGE(PG8_SB(0, 0), b2, voffA);
            PG8_BAR; PG8_WAIT_L(0); PG8_MMA(0, 1, At, B1); PG8_BAR;
            PG8_LDA(At, 0, 1); PG8_STAGE(PG8_SA(0, 0), a2, voffA);
            PG8_BAR; PG8_WAIT_L(0); PG8_MMA(1, 0, At, B0); PG8_BAR; PG8_SCHED;
            PG8_STAGE(PG8_SB(0, 1), b2 + hstep, voffA);
            PG8_WAIT_V(6); PG8_BAR; PG8_MMA(1, 1, At, B1); PG8_BAR;
            PG8_LDB(B0, 1, 0); PG8_SCHED; PG8_LDA(At, 1, 0); PG8_STAGE(PG8_SA(0, 1), a2 + hstep, voffA);
            PG8_WAIT_L(8); PG8_BAR; PG8_WAIT_L(0); PG8_MMA(0, 0, At, B0); PG8_BAR; PG8_SCHED;
            PG8_LDB(B1, 1, 1); PG8_STAGE(PG8_SB(1, 0), b3, voffA);
            PG8_BAR; PG8_WAIT_L(0); PG8_MMA(0, 1, At, B1); PG8_BAR;
            PG8_LDA(At, 1, 1); PG8_STAGE(PG8_SA(1, 0), a3, voffA);
            PG8_BAR; PG8_WAIT_L(0); PG8_MMA(1, 0, At, B0); PG8_BAR; PG8_SCHED;
            PG8_STAGE(PG8_SB(1, 1), b3 + hstep, voffA);
            PG8_WAIT_V(6); PG8_BAR; PG8_MMA(1, 1, At, B1); PG8_BAR;
        }
        E(acc, cur, wr, wc, fr, fq);
        if (!has_next) break;
#pragma unroll
        for (int a = 0; a < 2; ++a)
#pragma unroll
            for (int b = 0; b < 2; ++b)
#pragma unroll
                for (int m = 0; m < 4; ++m)
#pragma unroll
                    for (int n = 0; n < 2; ++n) acc[a][b][m][n] = (f32x4){0.f, 0.f, 0.f, 0.f};
        cur = nxt; cA = nA; cB = nB; ++ui;
    }
    PG8_WAIT_V(0);
    if (wr == 0) PG8_BAR;
    PG8_BAR;
#undef PG8_SA
#undef PG8_SB
#undef PG8_STAGE
#undef PG8_LDA
#undef PG8_LDB
#undef PG8_MMA
#undef PG8_WAIT_V
#undef PG8_WAIT_L
#undef PG8_BAR
#undef PG8_SCHED
}
}
using pg8::Unit;

__device__ __forceinline__ int slot_of_L(int L) { return (((L >> 3) & 1) << 7) | (((L >> 6) & 3) << 5) | (((L >> 2) & 1) << 4) | (((L >> 4) & 3) << 2) | (L & 3); }
__device__ __forceinline__ int rope_lambda(int dd, int half) { const int hf = dd / half, i = dd % half; return 16 * (i >> 3) + 8 * hf + (i & 7); }
__device__ __forceinline__ int keypos_of(int key) { return (key & ~12) | ((key & 4) << 1) | ((key & 8) >> 1); }
enum { KNAT = 0, KSWI = 1, KIN = 2, KUQ = 3, KUKV = 4 };
__device__ __forceinline__ int dstrow(int kind, int which, int c) {
    if (kind == KNAT) return c;
    if (kind == KSWI) { const int pn = c >> 7, cg = c & 127; return pn * 256 + ((((cg >> 2) & 1) << 7) | (((cg >> 5) & 3) << 5) | (which << 4) | (((cg >> 3) & 3) << 2) | (cg & 3)); }
    if (kind == KIN) {
        int tile, L;
        if (c < 256) { tile = 0; L = c; }
        else if (c < 640) { const int q = c - 256; tile = 1 + (q >> 8); L = q & 255; }
        else if (c < 896) { tile = 3; L = c - 640; }
        else if (c < 928) { tile = 2; L = 128 + rope_lambda(c - 896, 16); }
        else if (c < 1952) { int qq = c - 928; const int isk = qq >= 512 ? 1 : 0; qq &= 511; const int hd = qq >> 6; tile = 4 + 2 * isk + (hd >> 2); L = 64 * (hd & 3) + rope_lambda(qq & 63, 32); }
        else { const int vv = c - 1952; tile = 8 + (vv >> 8); L = vv & 255; }
        return tile * 256 + slot_of_L(L);
    }
    if (kind == KUQ) { const int head = c / 96, dd = c % 96; const int Lh = dd < 64 ? dd : 64 + rope_lambda(dd - 64, 16); const int L = 128 * (head & 1) + Lh; return (head >> 1) * 256 + slot_of_L(L); }
      { const int head = c >> 7, dd = c & 127; const int tile = dd >> 6; const int L = 64 * head + (dd & 63); return tile * 256 + slot_of_L(L); }
}

struct EpiSwiGLU {
    bf16_t* __restrict__ G;
    __device__ __forceinline__ void operator()(const f32x4 (&acc)[2][2][4][2], const Unit& u, int wr, int wc, int fr_, int fq_) const {
        const int tq_ = opaque_tid(); const int fr = tq_ & 15, fq = (tq_ >> 4) & 3; (void)fr_; (void)fq_;
        const int row0 = u.pm * 256 + wr * 64 + fr, col0 = u.pn * 128 + wc * 32 + fq * 8;
#pragma unroll
        for (int ai = 0; ai < 2; ++ai)
#pragma unroll
            for (int m = 0; m < 4; ++m) {
                float o[8];
#pragma unroll
                for (int bj = 0; bj < 2; ++bj)
#pragma unroll
                    for (int j = 0; j < 4; ++j) { const float a = acc[ai][bj][m][0][j], b = acc[ai][bj][m][1][j]; o[bj * 4 + j] = a * fast_rcp(1.f + fast_exp2(-a * LOG2E)) * b; }
                u32x4 w; w.x = cvt_pk_bf16(o[0], o[1]); w.y = cvt_pk_bf16(o[2], o[3]); w.z = cvt_pk_bf16(o[4], o[5]); w.w = cvt_pk_bf16(o[6], o[7]);
                *(u32x4*)(G + (size_t)(row0 + ai * 128 + m * 16) * DFF + col0) = w;
            }
    }
};
struct EpiResid {
    const float* Hin; const float* Hin_ctx; float* Hout; const float* gate_l; float sc;
    __device__ __forceinline__ void operator()(const f32x4 (&acc)[2][2][4][2], const Unit& u, int wr, int wc, int fr_, int fq_) const {
        const int tq_ = opaque_tid(); const int fr = tq_ & 15, fq = (tq_ >> 4) & 3; (void)fr_; (void)fq_;
        const int bi = u.pm < 256 ? (u.pm >> 4) : 16;
        const int row0 = u.pm * 256 + wr * 64 + fr, col0 = u.pn * 256 + wc * 32 + 4 * fq;
        const float* gate = gate_l + (size_t)bi * 9216 + col0;
        const float* hin = u.pm < 256 ? Hin : Hin_ctx;
        f32x4 gv[2][2];
#pragma unroll
        for (int bj = 0; bj < 2; ++bj)
#pragma unroll
            for (int n = 0; n < 2; ++n) gv[bj][n] = *(const f32x4*)(gate + bj * 128 + n * 16) * sc;
        f32x4 hb[3][2][2];
#define RES_LOAD(g_, st_) { const size_t base_ = (size_t)(row0 + ((g_) >> 2) * 128 + ((g_) & 3) * 16) * DM + col0; \
            _Pragma("unroll") for (int bj = 0; bj < 2; ++bj) _Pragma("unroll") for (int n = 0; n < 2; ++n) hb[st_][bj][n] = *(const f32x4*)(hin + base_ + bj * 128 + n * 16); }
        RES_LOAD(0, 0); RES_LOAD(1, 1);
#pragma unroll
        for (int g = 0; g < 8; ++g) {
            if (g + 2 < 8) { RES_LOAD(g + 2, (g + 2) % 3); }
            const int ai = g >> 2, m = g & 3;
            const size_t base = (size_t)(row0 + ai * 128 + m * 16) * DM + col0;
#pragma unroll
            for (int bj = 0; bj < 2; ++bj)
#pragma unroll
                for (int n = 0; n < 2; ++n) *(f32x4*)(Hout + base + bj * 128 + n * 16) = hb[g % 3][bj][n] + gv[bj][n] * acc[ai][bj][m][n];
        }
#undef RES_LOAD
    }
};
struct EpiPartial {
    float* __restrict__ P;
    __device__ __forceinline__ void operator()(const f32x4 (&acc)[2][2][4][2], const Unit& u, int wr, int wc, int fr_, int fq_) const {
        const int tq_ = opaque_tid(); const int fr = tq_ & 15, fq = (tq_ >> 4) & 3; (void)fr_; (void)fq_;
        const int row0 = u.pm * 256 + wr * 64 + fr, col0 = u.pn * 256 + wc * 32 + 4 * fq;
#pragma unroll
        for (int ai = 0; ai < 2; ++ai)
#pragma unroll
            for (int m = 0; m < 4; ++m) {
                float* hp = P + (size_t)(row0 + ai * 128 + m * 16) * DM + col0;
#pragma unroll
                for (int bj = 0; bj < 2; ++bj)
#pragma unroll
                    for (int n = 0; n < 2; ++n) *(f32x4*)(hp + bj * 128 + n * 16) = acc[ai][bj][m][n];
            }
    }
};
__device__ __forceinline__ void store16bf(bf16_t* dst, const float (&v)[16]) {
    u32x4 w0, w1;
    w0.x = cvt_pk_bf16(v[0], v[1]); w0.y = cvt_pk_bf16(v[2], v[3]); w0.z = cvt_pk_bf16(v[4], v[5]); w0.w = cvt_pk_bf16(v[6], v[7]);
    w1.x = cvt_pk_bf16(v[8], v[9]); w1.y = cvt_pk_bf16(v[10], v[11]); w1.z = cvt_pk_bf16(v[12], v[13]); w1.w = cvt_pk_bf16(v[14], v[15]);
    *(u32x4*)dst = w0; *(u32x4*)(dst + 8) = w1;
}
__device__ __forceinline__ void rope16(float (&v)[16], const float* tab) {
#pragma unroll
    for (int q = 0; q < 4; ++q) {
        const f32x4 cs = *(const f32x4*)(tab + q * 4);
        { const float x1 = v[2 * q], x2 = v[8 + 2 * q]; v[2 * q] = x1 * cs[0] - x2 * cs[1]; v[8 + 2 * q] = x1 * cs[1] + x2 * cs[0]; }
        { const float x1 = v[2 * q + 1], x2 = v[9 + 2 * q]; v[2 * q + 1] = x1 * cs[2] - x2 * cs[3]; v[9 + 2 * q] = x1 * cs[3] + x2 * cs[2]; }
    }
}
__device__ __forceinline__ void store_vt(LAS unsigned char* tw, const float (&v)[16], int fr, int fq, bf16_t* vt) {
    const int pos = ((fr & 4) << 1) | ((fr & 8) >> 1) | (fr & 3);
#pragma unroll
    for (int e = 0; e < 16; ++e) *(LAS bf16_t*)(tw + (16 * fq + e) * 48 + pos * 2) = f2bf(v[e]);
    const int lane = fq * 16 + fr;
#pragma unroll
    for (int i = 0; i < 2; ++i) { const int ch = lane + 64 * i, col = ch >> 1, half = ch & 1;
        const u32x4 w = *(const LAS u32x4*)(tw + col * 48 + half * 16);
        *(u32x4*)(vt + (size_t)col * KVL + half * 8) = w; }
}
struct EpiIn {
    float* __restrict__ U; bf16_t* __restrict__ CQ; bf16_t* __restrict__ CKV; float* __restrict__ SSQ; bf16_t* __restrict__ QD; bf16_t* __restrict__ KD; bf16_t* __restrict__ VTD; bf16_t* __restrict__ KM; const float* __restrict__ ROPED; const float* __restrict__ ROPEM; LAS unsigned char* tl;
    __device__ __forceinline__ void operator()(const f32x4 (&acc)[2][2][4][2], const Unit& u, int wr, int wc, int fr_, int fq_) const {
        const int tq_ = opaque_tid(); const int fr = tq_ & 15, fq = (tq_ >> 4) & 3; (void)fr_; (void)fq_;
        const int pn = u.pn, L0 = 64 * wc + 16 * fq;
#pragma unroll
        for (int ai = 0; ai < 2; ++ai)
#pragma unroll
            for (int m = 0; m < 4; ++m) {
                const int row = u.pm * 256 + ai * 128 + wr * 64 + m * 16 + fr;
                const bool lat = u.pm < 256;
                const int b = lat ? (row >> 12) : ((row - NLAT) >> 8);
                const int key = lat ? (CTXL + (row & 4095)) : ((row - NLAT) & 255);
                const int pos = row & 4095;
                float v[16];
#pragma unroll
                for (int bj = 0; bj < 2; ++bj)
#pragma unroll
                    for (int n = 0; n < 2; ++n)
#pragma unroll
                        for (int j = 0; j < 4; ++j) v[8 * bj + 4 * n + j] = acc[ai][bj][m][n][j];
                if (pn == 0) {
                    float* d = U + (size_t)row * 256 + L0;
#pragma unroll
                    for (int q = 0; q < 4; ++q) *(f32x4*)(d + 4 * q) = (f32x4){v[4 * q], v[4 * q + 1], v[4 * q + 2], v[4 * q + 3]};
                } else if (pn <= 3) {
                    if (pn == 2 && wc >= 2) {
                        if (wc == 2 && fq < 2) {
                            if (lat) rope16(v, ROPEM + ((size_t)pos * 16 + 8 * fq) * 2);
#pragma unroll
                            for (int h = 0; h < 4; ++h) store16bf(KM + ((size_t)(b * 4 + h) * KVL + key) * 96 + 64 + 16 * fq, v);
                        }
                    } else {
                        float s = 0.f;
#pragma unroll
                        for (int e = 0; e < 16; ++e) s += v[e] * v[e];
                        { const int ln = fq * 16 + fr; s += shx(s, 16, ln); s += shx(s, 32, ln); }
                        if (pn < 3) { store16bf(CQ + (size_t)row * 384 + (pn - 1) * 256 + L0, v); if (fq == 0) SSQ[(size_t)row * 16 + (pn - 1) * 4 + wc] = s; }
                        else { store16bf(CKV + (size_t)row * 256 + L0, v); if (fq == 0) SSQ[(size_t)row * 16 + 8 + wc] = s; }
                    }
                } else if (pn <= 7) {
                    const int hd = 4 * ((pn - 4) & 1) + wc;
                    if (lat) rope16(v, ROPED + ((size_t)pos * 32 + 8 * fq) * 2);
                    if (pn <= 5) {
                        const float qs = 0.125f * LOG2E;
#pragma unroll
                        for (int e = 0; e < 16; ++e) v[e] *= qs;
                        store16bf(QD + (size_t)row * 512 + hd * 64 + 16 * fq, v);
                    } else store16bf(KD + ((size_t)(b * 8 + hd) * KVL + key) * 64 + 16 * fq, v);
                } else {
                    const int h = 2 * (pn - 8) + (wc >> 1);
                    store_vt(tl + (wr * 4 + wc) * 3072, v, fr, fq, VTD + ((size_t)(b * 4 + h) * 128 + 64 * (wc & 1)) * KVL + (key - fr));
                }
            }
    }
};
struct EpiQup {
    const float* __restrict__ SSQ; bf16_t* __restrict__ QM; const float* __restrict__ ROPEM;
    __device__ __forceinline__ void operator()(const f32x4 (&acc)[2][2][4][2], const Unit& u, int wr, int wc, int fr_, int fq_) const {
        const int tq_ = opaque_tid(); const int fr = tq_ & 15, fq = (tq_ >> 4) & 3; (void)fr_; (void)fq_;
        const int head = 2 * u.pn + (wc >> 1), part = wc & 1;
        if (part == 1 && fq >= 2) return;
#pragma unroll
        for (int ai = 0; ai < 2; ++ai)
#pragma unroll
            for (int m = 0; m < 4; ++m) {
                const int row = u.pm * 256 + ai * 128 + wr * 64 + m * 16 + fr;
                const f32x4 s4 = *(const f32x4*)(SSQ + (size_t)row * 16); const f32x2 s2 = *(const f32x2*)(SSQ + (size_t)row * 16 + 4);
                const float ss = (s4[0] + s4[1]) + (s4[2] + s4[3]) + (s2[0] + s2[1]);
                const float sc = rsqrtf(ss * (1.f / 384.f) + EPS) * (0.10206207261596577f * LOG2E);
                float v[16];
#pragma unroll
                for (int bj = 0; bj < 2; ++bj)
#pragma unroll
                    for (int n = 0; n < 2; ++n)
#pragma unroll
                        for (int j = 0; j < 4; ++j) v[8 * bj + 4 * n + j] = acc[ai][bj][m][n][j] * sc;
                if (part == 1 && u.pm < 256) rope16(v, ROPEM + ((size_t)(row & 4095) * 16 + 8 * fq) * 2);
                store16bf(QM + (size_t)row * 384 + head * 96 + 64 * part + 16 * fq, v);
            }
    }
};
struct EpiKVup {
    const float* __restrict__ SSQ; bf16_t* __restrict__ KM; bf16_t* __restrict__ VTM; LAS unsigned char* tl;
    __device__ __forceinline__ void operator()(const f32x4 (&acc)[2][2][4][2], const Unit& u, int wr, int wc, int fr_, int fq_) const {
        const int tq_ = opaque_tid(); const int fr = tq_ & 15, fq = (tq_ >> 4) & 3; (void)fr_; (void)fq_;
#pragma unroll
        for (int ai = 0; ai < 2; ++ai)
#pragma unroll
            for (int m = 0; m < 4; ++m) {
                const int row = u.pm * 256 + ai * 128 + wr * 64 + m * 16 + fr;
                const bool lat = u.pm < 256;
                const int b = lat ? (row >> 12) : ((row - NLAT) >> 8);
                const int key = lat ? (CTXL + (row & 4095)) : ((row - NLAT) & 255);
                const f32x4 s4 = *(const f32x4*)(SSQ + (size_t)row * 16 + 8);
                const float sc = rsqrtf(((s4[0] + s4[1]) + (s4[2] + s4[3])) * (1.f / 256.f) + EPS);
                float v[16];
#pragma unroll
                for (int bj = 0; bj < 2; ++bj)
#pragma unroll
                    for (int n = 0; n < 2; ++n)
#pragma unroll
                        for (int j = 0; j < 4; ++j) v[8 * bj + 4 * n + j] = acc[ai][bj][m][n][j] * sc;
                if (u.pn == 0) store16bf(KM + ((size_t)(b * 4 + wc) * KVL + key) * 96 + 16 * fq, v);
                else {
                    store_vt(tl + (wr * 4 + wc) * 3072, v, fr, fq, VTM + ((size_t)(b * 4 + wc) * 64) * KVL + (key - fr));
                }
            }
    }
};

__constant__ float c_invfreq[24] = {1.000000000e+00f, 5.623413324e-01f, 3.162277639e-01f, 1.778279394e-01f, 1.000000015e-01f, 5.623413250e-02f, 3.162277490e-02f, 1.778279431e-02f, 9.999999776e-03f, 5.623413250e-03f, 3.162277630e-03f, 1.778279431e-03f, 1.000000047e-03f, 5.623413017e-04f, 3.162277571e-04f, 1.778279402e-04f, 1.000000000e+00f, 3.162277639e-01f, 1.000000015e-01f, 3.162277490e-02f, 9.999999776e-03f, 3.162277630e-03f, 1.000000047e-03f, 3.162277571e-04f};
__device__ void phase_init(const Params& p, LAS unsigned char* lds) {
    const int tid = opaque_tid();
    const size_t gtid = (size_t)blockIdx.x * 512 + tid, gsz = (size_t)gridDim.x * 512;
    for (size_t i = gtid; i < (size_t)4096 * 48; i += gsz) {
        int pos, a, use_row; float* dst;
        if (i < (size_t)4096 * 32) { pos = (int)(i >> 5); const int ii = (int)(i & 31); a = ii & 15; use_row = ii < 16; dst = p.ROPED + 2 * i; }
        else { const size_t j = i - (size_t)4096 * 32; pos = (int)(j >> 4); const int ii = (int)(j & 15); a = 16 + (ii & 7); use_row = ii < 8; dst = p.ROPEM + 2 * j; }
        const float ang = (float)(use_row ? (pos >> 6) : (pos & 63)) * c_invfreq[a];
        const float kq = rintf(ang * 0.636619772f);
        float r = fmaf(-kq, 1.570770263671875f, ang); r = fmaf(-kq, 2.6063062250614166e-05f, r); r = fmaf(-kq, 6.077094383272197e-11f, r);
        const float r2 = r * r;
        const float sn = r * (1.f + r2 * (-1.6666667e-1f + r2 * (8.3333333e-3f + r2 * (-1.9841270e-4f + r2 * 2.7557319e-6f))));
        const float cs = 1.f + r2 * (-0.5f + r2 * (4.1666667e-2f + r2 * (-1.3888889e-3f + r2 * (2.4801587e-5f + r2 * (-2.7557319e-7f)))));
        const int qd = ((int)kq) & 3;
        dst[0] = qd == 0 ? cs : qd == 1 ? -sn : qd == 2 ? -cs : sn;
        dst[1] = qd == 0 ? sn : qd == 1 ? cs : qd == 2 ? -sn : -cs;
    }
    LAS float* sct = (LAS float*)lds;
    LAS float* red = (LAS float*)(lds + 81920);
    for (int i = tid; i < 17 * 1024; i += 512) { const int bi = i >> 10, k = i & 1023; const float cv = bi < 16 ? p.c[bi * 1024 + k] : p.c_ctx[k]; sct[k * 20 + bi] = cv / (1.f + __expf(-cv)); }
    __syncthreads();
    const int col = tid & 127, kg = tid >> 7;
    for (int u = blockIdx.x; u < DEPTH * 72; u += gridDim.x) {
        const int l = u / 72, n0 = (u % 72) * 128;
        const float* w = p.w_mod + (size_t)l * 1024 * 9216 + n0 + col;
        float a[17];
#pragma unroll
        for (int q = 0; q < 17; ++q) a[q] = 0.f;
#pragma unroll 4
        for (int k = kg * 256; k < kg * 256 + 256; ++k) {
            const float wv = w[(size_t)k * 9216];
            const f32x4 s0 = *(const LAS f32x4*)(sct + k * 20), s1 = *(const LAS f32x4*)(sct + k * 20 + 4), s2 = *(const LAS f32x4*)(sct + k * 20 + 8), s3 = *(const LAS f32x4*)(sct + k * 20 + 12);
            const float s16 = sct[k * 20 + 16];
#pragma unroll
            for (int q = 0; q < 4; ++q) { a[q] += s0[q] * wv; a[4 + q] += s1[q] * wv; a[8 + q] += s2[q] * wv; a[12 + q] += s3[q] * wv; }
            a[16] += s16 * wv;
        }
#pragma unroll
        for (int q = 0; q < 17; ++q) red[(kg * 17 + q) * 128 + col] = a[q];
        __syncthreads();
        for (int i = tid; i < 17 * 128; i += 512) { const int bi = i >> 7, cc = i & 127;
            const float s = (red[(0 * 17 + bi) * 128 + cc] + red[(1 * 17 + bi) * 128 + cc]) + (red[(2 * 17 + bi) * 128 + cc] + red[(3 * 17 + bi) * 128 + cc]);
            p.MODS[((size_t)l * 17 + bi) * 9216 + n0 + cc] = s + p.b_mod[(size_t)l * 9216 + n0 + cc]; }
        __syncthreads();
    }
}

__device__ void phase_norm(const float* H, const float* Hctx, int nrows, const float* gw, const float* mods_l, int shift_idx, int scale_idx, bf16_t* outb, float* outf,
                           const float* P4, const float* pgate, float psc, float* Hw) {
    const int tid = opaque_tid(); const int wid = tid >> 6, lane = tid & 63;
    for (int row = blockIdx.x * 8 + wid; row < nrows; row += gridDim.x * 8) {
        const float* hr = (row < NLAT ? H : Hctx) + (size_t)row * DM + lane * 4;
        f32x4 v[4]; float ss = 0.f;
#pragma unroll
        for (int q = 0; q < 4; ++q) v[q] = *(const f32x4*)(hr + q * 256);
        if (P4 && row >= NLAT) {
            const float* pr = P4 + (size_t)(row - NLAT) * DM + lane * 4;
#pragma unroll
            for (int q = 0; q < 4; ++q) { const f32x4 s4 = (*(const f32x4*)(pr + q * 256) + *(const f32x4*)(pr + (size_t)NCTX * DM + q * 256)) + (*(const f32x4*)(pr + (size_t)2 * NCTX * DM + q * 256) + *(const f32x4*)(pr + (size_t)3 * NCTX * DM + q * 256));
                v[q] += (*(const f32x4*)(pgate + lane * 4 + q * 256) * psc) * s4; *(f32x4*)(Hw + (size_t)row * DM + lane * 4 + q * 256) = v[q]; }
        }
#pragma unroll
        for (int q = 0; q < 4; ++q) ss += (v[q][0] * v[q][0] + v[q][1] * v[q][1]) + (v[q][2] * v[q][2] + v[q][3] * v[q][3]);
        ss += __builtin_bit_cast(float, __builtin_amdgcn_update_dpp(0, __builtin_bit_cast(int, ss), 0xB1, 0xF, 0xF, true));
        ss += __builtin_bit_cast(float, __builtin_amdgcn_update_dpp(0, __builtin_bit_cast(int, ss), 0x4E, 0xF, 0xF, true));
        ss += __builtin_bit_cast(float, __builtin_amdgcn_update_dpp(0, __builtin_bit_cast(int, ss), 0x141, 0xF, 0xF, true));
        ss += __builtin_bit_cast(float, __builtin_amdgcn_update_dpp(0, __builtin_bit_cast(int, ss), 0x140, 0xF, 0xF, true));
        ss += shx(ss, 16, lane); ss += shx(ss, 32, lane);
        const float rstd = rsqrtf(ss * (1.f / DM) + EPS);
        if (outb) {
            const int bi = row < NLAT ? (row >> 12) : 16;
            const float* sh = mods_l + (size_t)bi * 9216 + shift_idx * 1024 + lane * 4; const float* sc = mods_l + (size_t)bi * 9216 + scale_idx * 1024 + lane * 4;
#pragma unroll
            for (int q = 0; q < 4; ++q) {
                const f32x4 g = *(const f32x4*)(gw + lane * 4 + q * 256), s = *(const f32x4*)(sc + q * 256), t = *(const f32x4*)(sh + q * 256);
                const f32x4 y = (v[q] * rstd * g) * (s + 1.f) + t;
                u32x2 w; w.x = cvt_pk_bf16(y[0], y[1]); w.y = cvt_pk_bf16(y[2], y[3]);
                *(u32x2*)(outb + (size_t)row * DM + lane * 4 + q * 256) = w;
            }
        } else {
#pragma unroll
            for (int q = 0; q < 4; ++q) { const f32x4 g = *(const f32x4*)(gw + lane * 4 + q * 256); *(f32x4*)(outf + (size_t)row * DM + lane * 4 + q * 256) = v[q] * rstd * g; }
        }
    }
}

__device__ void phase_convert(const Params& p, int l, LAS unsigned char* lds) {
    LAS float* tile = (LAS float*)lds;
    const int tid = opaque_tid();
    for (int u = blockIdx.x; u < 5176; u += gridDim.x) {
        const float* src; int Nsrc, K; bf16_t* dst; int kind = KNAT, which = 0; const float* ksc = nullptr; int t = u;
        if (t < 4224) { const int j = t / 704; t %= 704; const int f = j / 3, mm = j % 3;
            if (mm < 2) { src = (f ? (mm ? p.ffn2_w3 : p.ffn2_w1) : (mm ? p.ffn1_w3 : p.ffn1_w1)) + (size_t)l * DM * DFF; Nsrc = DFF; K = DM; dst = f ? p.Bt13b : p.Bt13a; kind = KSWI; which = mm; }
            else { src = (f ? p.ffn2_w2 : p.ffn1_w2) + (size_t)l * DFF * DM; Nsrc = DM; K = DFF; dst = f ? p.Bt2b : p.Bt2a; } }
        else if ((t -= 4224) < 624) { src = p.w_in + (size_t)l * DM * INW; Nsrc = INW; K = DM; dst = p.Btin; kind = KIN; }
        else if ((t -= 624) < 256) { src = p.w_out + (size_t)l * DM * DM; Nsrc = DM; K = DM; dst = p.Btout; }
        else if ((t -= 256) < 36) { src = p.mla_w_uq + (size_t)l * 384 * 384; Nsrc = 384; K = 384; dst = p.Btuq; kind = KUQ; ksc = p.mla_q_norm + l * 384; }
        else if ((t -= 36) < 32) { src = p.mla_w_ukv + (size_t)l * 256 * 512; Nsrc = 512; K = 256; dst = p.Btukv; kind = KUKV; ksc = p.mla_kv_norm + l * 256; }
        else { t -= 32; src = p.pool_w + (size_t)(l * 4 + t) * 4096; Nsrc = 64; K = 64; dst = p.Btpool + t * 4096; t = 0; }
        const int nkt = K / 64; const int c0 = (t / nkt) * 64, k0 = (t % nkt) * 64;
        { const int cl = tid & 63, ks = tid >> 6; const int c = c0 + cl;
#pragma unroll
          for (int kk = 0; kk < 8; ++kk) { const int k = ks + 8 * kk; tile[k * 65 + cl] = c < Nsrc ? src[(size_t)(k0 + k) * Nsrc + c] : 0.f; } }
        __syncthreads();
        { const int cl = tid >> 3, kseg = tid & 7; const int c = c0 + cl;
          if (c < Nsrc) { const int row = dstrow(kind, which, c); float v[8];
#pragma unroll
              for (int i = 0; i < 8; ++i) v[i] = tile[(kseg * 8 + i) * 65 + cl] * (ksc ? ksc[k0 + kseg * 8 + i] : 1.f);
              u32x4 w; w.x = cvt_pk_bf16(v[0], v[1]); w.y = cvt_pk_bf16(v[2], v[3]); w.z = cvt_pk_bf16(v[4], v[5]); w.w = cvt_pk_bf16(v[6], v[7]);
              *(u32x4*)(dst + (size_t)row * K + k0 + kseg * 8) = w; } }
        __syncthreads();
    }
}

template <int K> __device__ __forceinline__ void win_sum(const float* base, size_t stride, int cnt, f32x4& s0, f32x4& s1) {
    f32x4 v0[K], v1[K];
#pragma unroll
    for (int i = 0; i < K; ++i) { const float* q = base + (size_t)min(i, cnt - 1) * stride; v0[i] = *(const f32x4*)q; v1[i] = *(const f32x4*)(q + 4); }
#pragma unroll
    for (int i = 0; i < K; ++i) { const float w = i < cnt ? 1.f : 0.f; s0 += v0[i] * w; s1 += v1[i] * w; }
}
__device__ __forceinline__ void win_sum_g(int g, const float* base, size_t stride, int cnt, f32x4& s0, f32x4& s1) {
    if (g == 0) win_sum<2>(base, stride, cnt, s0, s1); else if (g == 1) win_sum<4>(base, stride, cnt, s0, s1); else if (g == 2) win_sum<8>(base, stride, cnt, s0, s1); else win_sum<16>(base, stride, cnt, s0, s1);
}
__device__ void phase_pool(const Params& p, int l, bool with_ctx, LAS unsigned char* lds) {
    LAS float* V = (LAS float*)lds;
    LAS bf16_t* Dm = (LAS bf16_t*)(lds + 17408);
    const int tid = opaque_tid(), wid = tid >> 6, lane = tid & 63, c16 = lane & 15, gq = lane >> 4;
    const int c = tid >> 3, ch0 = (tid & 7) * 8;
    const int nunits = 4096 + (with_ctx ? 256 : 0);
    const float* ps = p.pool_scale + l * 256;
    for (int uu = blockIdx.x; uu < nunits; uu += gridDim.x) {
        const int u = (uu & ~255) | ((uu & 7) << 5) | ((uu & 255) >> 3);
        const bool lat = u < 4096; int b, g, r, tok0;
        if (lat) { b = u >> 8; g = (u >> 6) & 3; r = u & 63; tok0 = b * 4096 + r * 64; }
        else { const int uu = u - 4096; b = uu >> 4; g = (uu >> 2) & 3; r = uu & 3; tok0 = NLAT + b * 256 + r * 64; }
        const int k = 2 << g, lo = k >> 1, hi = k - 1 - lo;
        const float* Ug = p.U + g * 64 + ch0;
        f32x4 m0 = (f32x4){0.f, 0.f, 0.f, 0.f}, m1 = m0; float inv;
        if (lat) {
            const int r0 = max(r - lo, 0), r1 = min(r + hi, 63);
            f32x4 a0 = m0, a1 = m0;
            win_sum_g(g, Ug + (size_t)(b * 4096 + r0 * 64 + c) * 256, (size_t)64 * 256, r1 - r0 + 1, a0, a1);
            const float ir = 1.f / (float)(r1 - r0 + 1);
            *(LAS f32x4*)(V + c * 68 + ch0) = a0 * ir; *(LAS f32x4*)(V + c * 68 + ch0 + 4) = a1 * ir;
            __syncthreads();
            const int cc0 = max(c - lo, 0), cc1 = min(c + hi, 63);
            for (int cc = cc0; cc <= cc1; ++cc) { m0 += *(const LAS f32x4*)(V + cc * 68 + ch0); m1 += *(const LAS f32x4*)(V + cc * 68 + ch0 + 4); }
            inv = 1.f / (float)(cc1 - cc0 + 1);
        } else {
            const int i = r * 64 + c, i0 = max(i - lo, 0), i1 = min(i + hi, 255);
            win_sum_g(g, Ug + (size_t)(NLAT + b * 256 + i0) * 256, (size_t)256, i1 - i0 + 1, m0, m1);
            inv = 1.f / (float)(i1 - i0 + 1);
        }
        { const float* q = Ug + (size_t)(tok0 + c) * 256; const f32x4 u0 = *(const f32x4*)q, u1 = *(const f32x4*)(q + 4);
          const f32x4 d0 = m0 * inv - u0, d1 = m1 * inv - u1;
          u32x4 w; w.x = cvt_pk_bf16(d0[0], d0[1]); w.y = cvt_pk_bf16(d0[2], d0[3]); w.z = cvt_pk_bf16(d1[0], d1[1]); w.w = cvt_pk_bf16(d1[2], d1[3]);
          *(LAS u32x4*)(Dm + c * 72 + ch0) = w; }
        __syncthreads();
        const int tb = wid >> 1;
#pragma unroll
        for (int o = 0; o < 2; ++o) {
            const int ob = (wid & 1) * 2 + o; f32x4 acc = (f32x4){0.f, 0.f, 0.f, 0.f};
#pragma unroll
            for (int ks = 0; ks < 2; ++ks) {
                const bf16x8 a = *(const bf16x8*)(p.Btpool + g * 4096 + (ob * 16 + c16) * 64 + ks * 32 + gq * 8);
                const bf16x8 bb = *(const LAS bf16x8*)(Dm + (tb * 16 + c16) * 72 + ks * 32 + gq * 8);
                acc = __builtin_amdgcn_mfma_f32_16x16x32_bf16(a, bb, acc, 0, 0, 0);
            }
            const int tok = tok0 + tb * 16 + c16, oc = g * 64 + ob * 16 + 4 * gq;
            const f32x4 sc = *(const f32x4*)(ps + oc);
            u32x2 w; w.x = cvt_pk_bf16(acc[0] * sc[0], acc[1] * sc[1]); w.y = cvt_pk_bf16(acc[2] * sc[2], acc[3] * sc[3]);
            *(u32x2*)(p.XN + (size_t)tok * DM + oc) = w;
        }
        __syncthreads();
    }
}

typedef float f32x16 __attribute__((ext_vector_type(16)));
#define ROWMAX32(out, A, B) do { \
    asm("v_max3_f32 %0, %1, %2, %3\n\tv_max3_f32 %0, %0, %4, %5\n\tv_max3_f32 %0, %0, %6, %7\n\tv_max3_f32 %0, %0, %8, %9\n\tv_max3_f32 %0, %0, %10, %11\n\tv_max3_f32 %0, %0, %12, %13\n\tv_max3_f32 %0, %0, %14, %15\n\tv_max3_f32 %0, %0, %16, %16" \
        : "=&v"(out) : "v"((A)[0]), "v"((A)[1]), "v"((A)[2]), "v"((A)[3]), "v"((A)[4]), "v"((A)[5]), "v"((A)[6]), "v"((A)[7]), "v"((A)[8]), "v"((A)[9]), "v"((A)[10]), "v"((A)[11]), "v"((A)[12]), "v"((A)[13]), "v"((A)[14]), "v"((A)[15])); \
    asm("v_max3_f32 %0, %0, %1, %2\n\tv_max3_f32 %0, %0, %3, %4\n\tv_max3_f32 %0, %0, %5, %6\n\tv_max3_f32 %0, %0, %7, %8\n\tv_max3_f32 %0, %0, %9, %10\n\tv_max3_f32 %0, %0, %11, %12\n\tv_max3_f32 %0, %0, %13, %14\n\tv_max3_f32 %0, %0, %15, %16" \
        : "+v"(out) : "v"((B)[0]), "v"((B)[1]), "v"((B)[2]), "v"((B)[3]), "v"((B)[4]), "v"((B)[5]), "v"((B)[6]), "v"((B)[7]), "v"((B)[8]), "v"((B)[9]), "v"((B)[10]), "v"((B)[11]), "v"((B)[12]), "v"((B)[13]), "v"((B)[14]), "v"((B)[15])); } while (0)

template <int DQK, int DV, bool DIFF>
__device__ __forceinline__ void attn_unit(LAS unsigned char* lds, const bf16_t* Qp, int ldq, const bf16_t* Kp, size_t kmap_stride, const bf16_t* Vtp, int kv_len,
                                          bf16_t* outp  , float lam, float post, const float* subln) {
    constexpr int NMAP = DIFF ? 2 : 1;
    constexpr int KROW = DQK * 2 + 16, VROW = 144, KBYTES = 64 * KROW, VBYTES = DV * VROW, KBUF = NMAP * KBYTES, OFFV = 2 * KBUF;
    constexpr int KC8 = DQK / 8, KCH = NMAP * 64 * KC8, VCH = DV * 8, NLK = (KCH + 511) / 512, NLV = (VCH + 511) / 512, NKS = DQK / 16, NDB = DV / 32;
    const int tid = opaque_tid(), wid = tid >> 6, lane = tid & 63, q32 = lane & 31, h = lane >> 5;
    const int qg = DIFF ? (wid >> 1) : wid, mp = DIFF ? (wid & 1) : 0;
    bf16x8 qf[NKS];
    { const bf16_t* qr = Qp + (size_t)(qg * 32 + q32) * ldq + mp * 64 + h * 8;
#pragma unroll
      for (int ks = 0; ks < NKS; ++ks) qf[ks] = *(const bf16x8*)(qr + ks * 16); }
    f32x16 O[NDB];
#pragma unroll
    for (int db = 0; db < NDB; ++db)
#pragma unroll
        for (int j = 0; j < 16; ++j) O[db][j] = 0.f;
    float lsum = 0.f;
    f32x16 mneg;
#pragma unroll
    for (int j = 0; j < 16; ++j) mneg[j] = 0.f;
    u32x4 stk[NLK], stv[NLV];
    auto kchunk = [&](int i) { const int ch = tid + i * 512; return ch < KCH ? ch : ch - 256; };
    auto gloadK = [&](int t) {
#pragma unroll
        for (int i = 0; i < NLK; ++i) { const int ch = kchunk(i), mpc = ch / (64 * KC8), cc = ch % (64 * KC8); stk[i] = *(const u32x4*)(Kp + (size_t)mpc * kmap_stride + (size_t)t * 64 * DQK + cc * 8); } };
    auto lstoreK = [&](int t) {
#pragma unroll
        for (int i = 0; i < NLK; ++i) { const int ch = kchunk(i), mpc = ch / (64 * KC8), cc = ch % (64 * KC8); *(LAS u32x4*)(lds + (t & 1) * KBUF + mpc * KBYTES + (cc / KC8) * KROW + (cc % KC8) * 16) = stk[i]; } };
    static_assert(VCH % 512 == 0 && KCH >= 512 && KCH - 256 >= 0, "chunk maps");
    auto gloadV = [&](int t) {
#pragma unroll
        for (int i = 0; i < NLV; ++i) { const int cc = tid + i * 512; stv[i] = *(const u32x4*)(Vtp + (size_t)(cc >> 3) * KVL + t * 64 + (cc & 7) * 8); } };
    auto lstoreV = [&](int t) {
#pragma unroll
        for (int i = 0; i < NLV; ++i) { const int cc = tid + i * 512; *(LAS u32x4*)(lds + OFFV + (t & 1) * VBYTES + (cc >> 3) * VROW + (cc & 7) * 16) = stv[i]; } };
    const int nt = kv_len / 64;
    gloadK(0); gloadV(0); lstoreK(0); lstoreV(1);
    gloadK(1); lstoreK(1);
    __syncthreads();
    f32x16 Sc[2], Sn[2];
    {
        const LAS unsigned char* kb_ = lds + mp * KBYTES + q32 * KROW + h * 16;
#pragma unroll
        for (int kb = 0; kb < 2; ++kb) {
#pragma unroll
            for (int j = 0; j < 16; ++j) Sc[kb][j] = 0.f;
#pragma unroll
            for (int ks = 0; ks < NKS; ++ks) { const bf16x8 a = *(const LAS bf16x8*)(kb_ + kb * 32 * KROW + ks * 32); Sc[kb] = __builtin_amdgcn_mfma_f32_32x32x16_bf16(a, qf[ks], Sc[kb], 0, 0, 0); }
        }
    }
    __syncthreads();
    __builtin_amdgcn_sched_barrier(0);
    asm volatile("s_nop 15\n\ts_nop 15\n\ts_nop 15\n\ts_nop 15\n\ts_nop 15\n\ts_nop 15" ::: "memory");
    __builtin_amdgcn_sched_barrier(0);
    float lm_cur;
    ROWMAX32(lm_cur, Sc[0], Sc[1]);
    bf16x8 Pa[2][2], Pb[2][2];
#pragma unroll
    for (int kb = 0; kb < 2; ++kb)
#pragma unroll
        for (int s = 0; s < 2; ++s)
#pragma unroll
            for (int e = 0; e < 8; ++e) Pa[kb][s][e] = 0;
    auto step = [&](f32x16 (&Sa)[2], f32x16 (&Sb)[2], bf16x8 (&Pp)[2][2], bf16x8 (&Pn)[2][2], int t) {
        const float lm = lm_cur;
        if (t == 0 || __builtin_amdgcn_ballot_w64(lm > 8.f) != 0) {
            const float mx = fmaxf(lm, shx(lm, 32, lane));
            const float delta = (t == 0 || mx > 8.f) ? mx : 0.f;
            const float alpha = t == 0 ? 1.f : fast_exp2(-delta);
            lsum *= alpha;
#pragma unroll
            for (int j = 0; j < 16; ++j) { mneg[j] -= delta; Sa[0][j] -= delta; Sa[1][j] -= delta; }
#pragma unroll
            for (int db = 0; db < NDB; ++db) O[db] *= alpha;
#pragma unroll
            for (int kb = 0; kb < 2; ++kb)
#pragma unroll
                for (int s = 0; s < 2; ++s) { u32x4 w = __builtin_bit_cast(u32x4, Pp[kb][s]);
#pragma unroll
                    for (int e = 0; e < 4; ++e) w[e] = cvt_pk_bf16(__uint_as_float(w[e] << 16) * alpha, __uint_as_float(w[e] & 0xffff0000u) * alpha);
                    Pp[kb][s] = __builtin_bit_cast(bf16x8, w); }
        }
        gloadK(min(t + 2, nt - 1)); gloadV(t);
        const LAS unsigned char* kb_ = lds + ((t + 1) & 1) * KBUF + mp * KBYTES + q32 * KROW + h * 16;
        const LAS unsigned char* vb_ = lds + OFFV + ((t + 1) & 1) * VBYTES + q32 * VROW + h * 16;
        constexpr int NQK = 2 * NKS, NM = NQK + 4 * NDB, NG = NM / 4, PPG = (16 + NG - 2) / (NG - 1);
        static_assert(NM % 4 == 0, "MFMA groups of four");
        bf16x8 fr[2][4];
        float ps0 = 0.f;
        unsigned pk[2][8];
#define ATT_LOADGRP(g) _Pragma("unroll") for (int q_ = 0; q_ < 4; ++q_) { const int i_ = 4 * (g) + q_; \
            fr[(g) & 1][q_] = (i_ < NQK) ? *(const LAS bf16x8*)(kb_ + (i_ / NKS) * 32 * KROW + (i_ % NKS) * 32) \
                                         : *(const LAS bf16x8*)(vb_ + ((i_ - NQK) / 4) * 32 * VROW + (((i_ - NQK) / 2) & 1) * 64 + ((i_ - NQK) & 1) * 32); }
        ATT_LOADGRP(0);
#pragma unroll
        for (int g = 0; g < NG; ++g) {
            if (g + 1 < NG) { ATT_LOADGRP(g + 1); }
#pragma unroll
            for (int q_ = 0; q_ < 4; ++q_) { const int i_ = 4 * g + q_;
                if (i_ < NQK) { const int kb = i_ / NKS, ks = i_ % NKS;
                    if (ks == 0) Sb[kb] = __builtin_amdgcn_mfma_f32_32x32x16_bf16(fr[g & 1][q_], qf[ks], mneg, 0, 0, 0);
                    else Sb[kb] = __builtin_amdgcn_mfma_f32_32x32x16_bf16(fr[g & 1][q_], qf[ks], Sb[kb], 0, 0, 0); }
                else { const int j_ = i_ - NQK, db = j_ / 4, kb = (j_ / 2) & 1, sx = j_ & 1; O[db] = __builtin_amdgcn_mfma_f32_32x32x16_bf16(fr[g & 1][q_], Pp[kb][sx], O[db], 0, 0, 0); } }
#pragma unroll
            for (int pp = g * PPG; pp < (g + 1) * PPG && pp < 16; ++pp) { const int kb = pp / 8, j = pp % 8;
                Sa[kb][2 * j] = fast_exp2(Sa[kb][2 * j]); Sa[kb][2 * j + 1] = fast_exp2(Sa[kb][2 * j + 1]); }
            if (g > 0) {
#pragma unroll
                for (int pp = (g - 1) * PPG; pp < g * PPG && pp < 16; ++pp) { const int kb = pp / 8, j = pp % 8;
                    asm("v_add_f32 %0, %1, %2" : "=v"(ps0) : "v"(ps0), "v"(Sa[kb][2 * j])); asm("v_add_f32 %0, %1, %2" : "=v"(ps0) : "v"(ps0), "v"(Sa[kb][2 * j + 1]));
                    pk[kb][j] = cvt_pk_bf16(Sa[kb][2 * j], Sa[kb][2 * j + 1]); }
            }
            if (g == NG - 2) { lstoreK(t + 2); lstoreV(t); }
            if (g == NG - 1) {
                float lmn;
                ROWMAX32(lmn, Sb[0], Sb[1]);
                lm_cur = lmn;
            }
            __builtin_amdgcn_sched_barrier(0);
        }
#pragma unroll
        for (int pp = (NG - 1) * PPG; pp < 16; ++pp) { const int kb = pp / 8, j = pp % 8;
            asm("v_add_f32 %0, %1, %2" : "=v"(ps0) : "v"(ps0), "v"(Sa[kb][2 * j])); asm("v_add_f32 %0, %1, %2" : "=v"(ps0) : "v"(ps0), "v"(Sa[kb][2 * j + 1]));
            pk[kb][j] = cvt_pk_bf16(Sa[kb][2 * j], Sa[kb][2 * j + 1]); }
#undef ATT_LOADGRP
#pragma unroll
        for (int kb = 0; kb < 2; ++kb) { Pn[kb][0] = __builtin_bit_cast(bf16x8, (u32x4){pk[kb][0], pk[kb][1], pk[kb][2], pk[kb][3]}); Pn[kb][1] = __builtin_bit_cast(bf16x8, (u32x4){pk[kb][4], pk[kb][5], pk[kb][6], pk[kb][7]}); }
        lsum += ps0;
        __syncthreads();
    };
    for (int t = 0; t < nt; t += 2) { step(Sc, Sn, Pa, Pb, t); step(Sn, Sc, Pb, Pa, t + 1); }
    bf16x8 (&pfp)[2][2] = Pa;
    { const LAS unsigned char* vb_ = lds + OFFV + ((nt - 1) & 1) * VBYTES + q32 * VROW + h * 16;
#pragma unroll
      for (int db = 0; db < NDB; ++db)
#pragma unroll
          for (int kb = 0; kb < 2; ++kb)
#pragma unroll
              for (int s = 0; s < 2; ++s) { const bf16x8 a = *(const LAS bf16x8*)(vb_ + db * 32 * VROW + kb * 64 + s * 32); O[db] = __builtin_amdgcn_mfma_f32_32x32x16_bf16(a, pfp[kb][s], O[db], 0, 0, 0); } }
    __syncthreads();
    const int te_ = opaque_tid(), lane_e = te_ & 63, q32e = lane_e & 31, he = lane_e >> 5;
    const float ltot = lsum + shx(lsum, 32, lane_e);
    const float inv = 1.f / ltot;
    bf16_t* orow = outp + (size_t)(qg * 32 + q32e) * DM + 4 * he;
    if constexpr (!DIFF) {
#pragma unroll
        for (int db = 0; db < NDB; ++db)
#pragma unroll
            for (int jj = 0; jj < 4; ++jj) { u32x2 w; w.x = cvt_pk_bf16(O[db][4 * jj] * inv, O[db][4 * jj + 1] * inv); w.y = cvt_pk_bf16(O[db][4 * jj + 2] * inv, O[db][4 * jj + 3] * inv);
                *(u32x2*)(orow + db * 32 + jj * 8) = w; }
    } else {
        LAS float* X = (LAS float*)lds + (qg * 32 + q32e) * 132 + 4 * he;
        if (mp == 1) { float lam_ = lam; asm volatile("" : "+v"(lam_)); const float sc = lam_ * inv;
#pragma unroll
            for (int db = 0; db < NDB; ++db)
#pragma unroll
                for (int jj = 0; jj < 4; ++jj) *(LAS f32x4*)(X + db * 32 + jj * 8) = (f32x4){O[db][4 * jj] * sc, O[db][4 * jj + 1] * sc, O[db][4 * jj + 2] * sc, O[db][4 * jj + 3] * sc}; }
        __syncthreads();
        if (mp == 0) {
            float ss = 0.f;
#pragma unroll
            for (int db = 0; db < NDB; ++db)
#pragma unroll
                for (int jj = 0; jj < 4; ++jj) { const f32x4 x = *(const LAS f32x4*)(X + db * 32 + jj * 8);
#pragma unroll
                    for (int e = 0; e < 4; ++e) { const float o = O[db][4 * jj + e] * inv - x[e]; O[db][4 * jj + e] = o; ss += o * o; } }
            ss += shx(ss, 32, lane_e);
            float li_ = post; asm volatile("" : "+v"(li_));
            const float r = rsqrtf(ss * (1.f / DV) + EPS) * (1.f - li_);
#pragma unroll
            for (int db = 0; db < NDB; ++db)
#pragma unroll
                for (int jj = 0; jj < 4; ++jj) { const f32x4 gsub = *(const f32x4*)(subln + db * 32 + jj * 8 + 4 * he);
                    u32x2 w; w.x = cvt_pk_bf16(O[db][4 * jj] * r * gsub[0], O[db][4 * jj + 1] * r * gsub[1]); w.y = cvt_pk_bf16(O[db][4 * jj + 2] * r * gsub[2], O[db][4 * jj + 3] * r * gsub[3]);
                    *(u32x2*)(orow + db * 32 + jj * 8) = w; }
        }
        __syncthreads();
    }
}

__device__ void phase_attn(const Params& p, int l, bool with_ctx, LAS unsigned char* lds) {
    const float lam_init = 0.8f - 0.6f * expf(-0.3f * (float)l);
    const float* dl = p.diff_lambda + l * 256;
    float s1 = 0.f, s2 = 0.f;
    for (int i = 0; i < 64; ++i) { s1 += dl[i] * dl[64 + i]; s2 += dl[128 + i] * dl[192 + i]; }
    const float lam = __builtin_bit_cast(float, __builtin_amdgcn_readfirstlane(__builtin_bit_cast(int, expf(s1) - expf(s2) + lam_init)));
    const float post_scale = __builtin_bit_cast(float, __builtin_amdgcn_readfirstlane(__builtin_bit_cast(int, 1.f - lam_init)));
    const int total = 3072 + (with_ctx ? 192 : 0);
    for (int u = blockIdx.x; u < total; u += gridDim.x) {
        bool diff; int b, h, row0, kvlen;
        if (u < 2048) { diff = true; const int i = u >> 8, blk = u & 255, bh = i * 8 + (blk & 7), qb = blk >> 3; b = bh >> 2; h = bh & 3; row0 = b * 4096 + qb * 128; kvlen = KVL; }
        else if (u < 3072) { diff = false; const int uu = u - 2048, i = uu >> 8, blk = uu & 255, slot = blk >> 3, bh = i * 16 + 2 * (blk & 7) + (slot >> 4), qb = slot & 15; b = bh >> 2; h = bh & 3; row0 = b * 4096 + qb * 256; kvlen = KVL; }
        else if (u < 3200) { diff = true; const int uu = u - 3072, bh = uu >> 1; b = bh >> 2; h = bh & 3; row0 = NLAT + b * 256 + (uu & 1) * 128; kvlen = CTXL; }
        else { diff = false; const int bh = u - 3200; b = bh >> 2; h = bh & 3; row0 = NLAT + b * 256; kvlen = CTXL; }
        if (diff) attn_unit<64, 128, true>(lds, p.QD + (size_t)row0 * 512 + (2 * h) * 64, 512, p.KD + (size_t)(b * 8 + 2 * h) * KVL * 64, (size_t)KVL * 64, p.VTD + (size_t)(b * 4 + h) * 128 * KVL, kvlen,
                                           p.XN + (size_t)row0 * DM + 512 + h * 128, lam, lam_init, p.diff_subln + l * 128);
        else attn_unit<96, 64, false>(lds, p.QM + (size_t)row0 * 384 + h * 96, 384, p.KM + (size_t)(b * 4 + h) * KVL * 96, 0, p.VTM + (size_t)(b * 4 + h) * 64 * KVL, kvlen,
                                      p.XN + (size_t)row0 * DM + 256 + h * 64, 0.f, 1.f, nullptr);
    }
}

constexpr int NPHASE = 2 + DEPTH * 11;
__device__ __forceinline__ void run_phase(const Params& p, int ph, LAS unsigned char* lds) {
    const int G = (int)gridDim.x, cb = (int)blockIdx.x;
    if (ph == 0) { phase_init(p, lds); return; }
    if (ph == NPHASE - 1) { phase_norm(p.H, p.H, NLAT, p.final_norm, nullptr, 0, 0, nullptr, p.out, nullptr, nullptr, 0.f, nullptr); return; }
    const int l = (ph - 1) / 11, k = (ph - 1) % 11; const bool last = l == DEPTH - 1;
    const float* mods_l = p.MODS + (size_t)l * 17 * 9216;
    const int Mlate = last ? NLAT : NT;
    pg8::StaticOrder S;
    if (k == 0 || k == 3 || k == 8) {
        const float* gw = (k == 0 ? p.ffn1_norm : k == 3 ? p.mix_norm : p.ffn2_norm) + l * DM;
        const int si = k == 8 ? 6 : k;
        const bool first = (l == 0 && k == 0);
        const bool pend = !first && !(k == 8 && last);
        const float* pgate = (k == 0 ? mods_l - 17 * 9216 + 8 * 1024 : k == 3 ? mods_l + 2 * 1024 : mods_l + 5 * 1024) + (size_t)16 * 9216;
        const bool ctx_in = (l == 0 && k <= 3);
        phase_norm(first ? p.x : p.H, ctx_in ? p.ctx - (size_t)NLAT * DM : p.H, k == 8 ? Mlate : NT, gw, mods_l, si, si + 1, p.XN, nullptr, pend ? p.P4 : nullptr, pgate, k == 8 ? 1.f : 0.5f, p.H);
        if (k == 0) phase_convert(p, l, lds);
    } else if (k == 1 || k == 9) {
        pg8::Gemm g{p.XN, k == 1 ? p.Bt13a : p.Bt13b, k == 1 ? NT : Mlate, 2 * DFF, DM, DM};
        S.init(g.M, g.N, G, cb); EpiSwiGLU E{p.G};
        pg8::gemm_phase(lds, g, S, E);
    } else if (k == 2 || k == 7 || k == 10) {
        const int Kf = k == 7 ? DM : DFF;
        const bf16_t* Ap = k == 7 ? p.XN : p.G; const bf16_t* Bp = k == 2 ? p.Bt2a : k == 7 ? p.Btout : p.Bt2b;
        const bool first = (l == 0 && k == 2);
        { pg8::Gemm g{Ap, Bp, NLAT, DM, Kf, Kf};
          S.init(g.M, g.N, G, cb); EpiResid E{first ? p.x : p.H, p.H, p.H, mods_l + (k == 2 ? 2 : k == 7 ? 5 : 8) * 1024, k == 7 ? 1.f : 0.5f};
          pg8::gemm_phase(lds, g, S, E); }
        if (k == 2 || !last) {
            const int kt = Kf / 128, q0 = kt / 4, r0 = kt % 4;
            for (int idx = cb; idx < 256; idx += G) {
                const int unit = idx >> 2, sl = idx & 3;
                const int kb0 = sl * q0 + (sl < r0 ? sl : r0), kl = q0 + (sl < r0 ? 1 : 0);
                pg8::Gemm g{Ap + (size_t)NLAT * Kf + kb0 * 128, Bp + kb0 * 128, NCTX, DM, kl * 128, Kf};
                S.init(g.M, g.N, G, cb); S.fixed = unit;
                EpiPartial E{p.P4 + (size_t)sl * NCTX * DM};
                __syncthreads();
                pg8::gemm_phase(lds, g, S, E);
            }
        }
    } else if (k == 4) {
        pg8::Gemm g{p.XN, p.Btin, NT, 2560, DM, DM};
        S.init(g.M, g.N, G, cb); EpiIn E{p.U, p.CQ, p.CKV, p.SSQ, p.QD, p.KD, p.VTD, p.KM, p.ROPED, p.ROPEM, lds + 131072};
        pg8::gemm_phase(lds, g, S, E);
    } else if (k == 5) {
        { pg8::Gemm g{p.CQ, p.Btuq, NT, 512, 384, 384}; S.init(g.M, g.N, G, cb); EpiQup E{p.SSQ, p.QM, p.ROPEM}; pg8::gemm_phase(lds, g, S, E); }
        { pg8::Gemm g{p.CKV, p.Btukv, NT, 512, 256, 256}; S.init(g.M, g.N, G, (cb + 32) % G); EpiKVup E{p.SSQ, p.KM, p.VTM, lds + 131072}; pg8::gemm_phase(lds, g, S, E); }
        __syncthreads();
        phase_pool(p, l, !last, lds);
    } else if (k == 6) {
        phase_attn(p, l, !last, lds);
    }
}

__device__ __forceinline__ void grid_barrier(unsigned* ctr, unsigned target) {
    asm volatile("s_waitcnt vmcnt(0) lgkmcnt(0)" ::: "memory");
    __syncthreads();
    if (threadIdx.x == 0) {
        __builtin_amdgcn_fence(__ATOMIC_RELEASE, "agent");
        asm volatile("s_waitcnt vmcnt(0)" ::: "memory");
        __hip_atomic_fetch_add(ctr, 1u, __ATOMIC_RELAXED, __HIP_MEMORY_SCOPE_AGENT);
        while (__hip_atomic_load(ctr, __ATOMIC_RELAXED, __HIP_MEMORY_SCOPE_AGENT) < target) __builtin_amdgcn_s_sleep(1);
        __builtin_amdgcn_fence(__ATOMIC_ACQUIRE, "agent");
        asm volatile("s_waitcnt vmcnt(0)" ::: "memory");
    }
    __syncthreads();
}

__global__ __launch_bounds__(512, 2) void hymba_mega(Params p) {
    extern __shared__ __attribute__((aligned(16))) unsigned char smem[];
    LAS unsigned char* lds = (LAS unsigned char*)smem;
    cg::grid_group grid = cg::this_grid();
    unsigned nbar = 0;
    for (int ph = p.ph_lo; ph < p.ph_hi; ++ph) {
        run_phase(p, ph, lds);
        if (ph + 1 < p.ph_hi) {
            if (ph == p.ph_lo) grid.sync();
            else grid_barrier(p.BAR, ++nbar * gridDim.x);
        }
    }
}

extern "C" void kernel_launch(void* const* d_in, const int* in_sizes, int n_in, void* d_out, int out_size, void* d_ws, size_t ws_size, hipStream_t stream) {
    static int grid_blocks = 0;
    if (!grid_blocks) {
        int dev = 0, cus = 0, per_cu = 0;
        hipGetDevice(&dev);
        hipDeviceGetAttribute(&cus, hipDeviceAttributeMultiprocessorCount, dev);
        if (hipFuncSetAttribute((const void*)hymba_mega, hipFuncAttributeMaxDynamicSharedMemorySize, LDS_BYTES) != hipSuccess) fprintf(stderr, "hipFuncSetAttribute failed\n");
        if (hipOccupancyMaxActiveBlocksPerMultiprocessor(&per_cu, (const void*)hymba_mega, 512, LDS_BYTES) != hipSuccess || per_cu < 1) { per_cu = 1; (void)hipGetLastError(); }
        grid_blocks = cus * per_cu;
        if (grid_blocks <= 0) grid_blocks = 256;
    }
    Params p{};
    const float** in = (const float**)&p;
    for (int i = 0; i < 26 && i < n_in; ++i) in[i] = (const float*)d_in[i];
    p.out = (float*)d_out;
    unsigned char* w = (unsigned char*)d_ws; size_t off = 0;
    auto take = [&](size_t bytes) { unsigned char* r = w + off; off += (bytes + 255) & ~(size_t)255; return r; };
    p.H = (float*)take((size_t)NT * DM * 4);
    p.XN = (bf16_t*)take((size_t)NT * DM * 2);
    unsigned char* big = w + off; size_t boff = 0;
    auto takeb = [&](size_t bytes) { unsigned char* r = big + boff; boff += (bytes + 255) & ~(size_t)255; return r; };
    p.U = (float*)takeb((size_t)NT * 256 * 4);
    p.CQ = (bf16_t*)takeb((size_t)NT * 384 * 2);
    p.CKV = (bf16_t*)takeb((size_t)NT * 256 * 2);
    p.SSQ = (float*)takeb((size_t)NT * 16 * 4);
    p.QD = (bf16_t*)takeb((size_t)NT * 512 * 2);
    p.KD = (bf16_t*)takeb((size_t)NB * 8 * KVL * 64 * 2);
    p.VTD = (bf16_t*)takeb((size_t)NB * 4 * 128 * KVL * 2);
    p.QM = (bf16_t*)takeb((size_t)NT * 384 * 2);
    p.KM = (bf16_t*)takeb((size_t)NB * 4 * KVL * 96 * 2);
    p.VTM = (bf16_t*)takeb((size_t)NB * 4 * 64 * KVL * 2);
    p.G = (bf16_t*)big;
    p.P4 = (float*)(big + (((size_t)NT * DFF * 2 + 255) & ~(size_t)255));
    const size_t gbytes = (size_t)NT * DFF * 2;
    off += (boff > gbytes ? boff : gbytes); off = (off + 255) & ~(size_t)255;
    p.Bt13a = (bf16_t*)take((size_t)2 * DFF * DM * 2); p.Bt2a = (bf16_t*)take((size_t)DM * DFF * 2);
    p.Bt13b = (bf16_t*)take((size_t)2 * DFF * DM * 2); p.Bt2b = (bf16_t*)take((size_t)DM * DFF * 2);
    p.Btin = (bf16_t*)take((size_t)2560 * DM * 2); p.Btout = (bf16_t*)take((size_t)DM * DM * 2);
    p.Btuq = (bf16_t*)take((size_t)512 * 384 * 2); p.Btukv = (bf16_t*)take((size_t)512 * 256 * 2); p.Btpool = (bf16_t*)take((size_t)4 * 64 * 64 * 2);
    p.MODS = (float*)take((size_t)DEPTH * 17 * 9216 * 4);
    p.BAR = (unsigned*)take(256);
    p.ROPED = (float*)take((size_t)4096 * 32 * 2 * 4); p.ROPEM = (float*)take((size_t)4096 * 16 * 2 * 4);
    if (off > ws_size) { fprintf(stderr, "kernel_launch: workspace too small: need %zu have %zu\n", off, ws_size); return; }
    (void)hipMemsetAsync(p.BAR, 0, 256, stream);
#if MULTI_LAUNCH
    for (int ph = 0; ph < NPHASE; ++ph) { p.ph_lo = ph; p.ph_hi = ph + 1; hipLaunchKernelGGL(hymba_mega, dim3(grid_blocks), dim3(512), LDS_BYTES, stream, p); }
#else
    p.ph_lo = 0; p.ph_hi = NPHASE;
    void* args[] = {&p};
    hipError_t e = hipLaunchCooperativeKernel((const void*)hymba_mega, dim3(grid_blocks), dim3(512), args, LDS_BYTES, stream);
    if (e != hipSuccess) fprintf(stderr, "cooperative launch failed: %s (grid %d)\n", hipGetErrorString(e), grid_blocks);
#endif
}
```

```cpp
#include <hip/hip_runtime.h>
#include <hip/hip_cooperative_groups.h>
#include <cstdio>
namespace cg = cooperative_groups;

#define LAS __attribute__((address_space(3)))
typedef unsigned short bf16_t;
typedef short bf16x8 __attribute__((ext_vector_type(8)));
typedef float f32x4 __attribute__((ext_vector_type(4)));
typedef float f32x2 __attribute__((ext_vector_type(2)));
typedef unsigned u32x4 __attribute__((ext_vector_type(4)));
typedef unsigned u32x2 __attribute__((ext_vector_type(2)));

constexpr int DM = 1024, NB = 16, SEQ = 4096, DEPTH = 4, CTXL = 256, DFF = 2816;
constexpr int NLAT = NB * SEQ, NCTX = NB * CTXL, NT = NLAT + NCTX, KVL = SEQ + CTXL;
constexpr int INW = 2464;
constexpr float EPS = 1e-6f;
constexpr float LOG2E = 1.4426950408889634f;
constexpr int LDS_BYTES = 131072 + 8 * 3072;
#ifndef MULTI_LAUNCH
#define MULTI_LAUNCH 0
#endif

struct Params {
    const float *x, *c, *ctx, *c_ctx, *w_mod, *b_mod, *ffn1_norm, *ffn1_w1, *ffn1_w3, *ffn1_w2, *mix_norm, *w_in, *w_out, *pool_w, *pool_scale,
        *mla_q_norm, *mla_w_uq, *mla_kv_norm, *mla_w_ukv, *diff_lambda, *diff_subln, *ffn2_norm, *ffn2_w1, *ffn2_w3, *ffn2_w2, *final_norm;
    float* out;
    float* H; bf16_t* XN; bf16_t* G; float* U; bf16_t* CQ; bf16_t* CKV; float* SSQ; bf16_t* QD; bf16_t* KD; bf16_t* VTD; bf16_t* QM; bf16_t* KM; bf16_t* VTM;
    bf16_t *Bt13a, *Bt2a, *Bt13b, *Bt2b, *Btin, *Btout, *Btuq, *Btukv, *Btpool;
    float *MODS, *ROPED, *ROPEM;
    float* P4;
    unsigned* BAR;
    int ph_lo, ph_hi;
};

typedef __bf16 bf16x2_t __attribute__((ext_vector_type(2)));
__device__ __forceinline__ unsigned cvt_pk_bf16(float lo, float hi) { const f32x2 v = {lo, hi}; const bf16x2_t b = __builtin_convertvector(v, bf16x2_t); return __builtin_bit_cast(unsigned, b); }
__device__ __forceinline__ bf16_t f2bf(float v) { return (bf16_t)(cvt_pk_bf16(v, 0.f) & 0xffffu); }
__device__ __forceinline__ int opaque_tid() { int t = threadIdx.x; asm volatile("" : "+v"(t)); return t; }
__device__ __forceinline__ float shx(float v, int mask, int lane) { return __int_as_float(__builtin_amdgcn_ds_bpermute((lane ^ mask) << 2, __float_as_int(v))); }
__device__ __forceinline__ float fast_exp2(float x) { return __builtin_amdgcn_exp2f(x); }
__device__ __forceinline__ float fast_rcp(float x) { return __builtin_amdgcn_rcpf(x); }

namespace pg8 {
constexpr int BM = 256, BK = 64, HALF = 128, HTB = HALF * BK * 2, STAGE_BYTES = 8 * HTB, NXCD = 8, WGM = 4;
__host__ __device__ __forceinline__ int lds_byte(int r, int c) { const int st = (r >> 4) * 2 + (c >> 5), rr = r & 15, cc = c & 31, ob = rr * 64 + cc * 2; return st * 1024 + (ob ^ (((ob >> 9) & 1) << 5)); }
__host__ __device__ __forceinline__ void stage_rc(int b, int& R, int& C) { const int st = b / 1024, sb = b % 1024, swz = sb ^ (((sb >> 9) & 1) << 5); R = (st >> 1) * 16 + swz / 64; C = (st & 1) * 32 + (swz % 64) / 2; }
struct Unit { int pm, pn; };
struct Gemm { const bf16_t* A; const bf16_t* Bt; int M, N, K, ld; };
struct StaticOrder {
    int nM, nN, nwg, G, c, fixed;
    __device__ void init(int M, int N, int G_, int c_) { nM = M / BM; nN = N / BM; nwg = nM * nN; G = G_; c = c_; fixed = -1; }
    __device__ bool next(int i, Unit& u) const {
        if (fixed >= 0) { if (i > 0) return false; u.pm = fixed / nN; u.pn = fixed % nN; return true; }
        const long L = (long)i * G + c; if (L >= nwg) return false;
        int wgid = (int)L; { const int q = nwg / NXCD, r = nwg % NXCD, xcd = wgid % NXCD, off = wgid / NXCD; wgid = (xcd < r ? xcd * (q + 1) : r * (q + 1) + (xcd - r) * q) + off; }
        const int nig = WGM * nN, gid = wgid / nig, fm = gid * WGM, gsz = (nM - fm) < WGM ? (nM - fm) : WGM;
        u.pm = fm + ((wgid % nig) % gsz); u.pn = (wgid % nig) / gsz; return true;
    }
};
template <class Epi>
__device__ __forceinline__ void gemm_phase(LAS unsigned char* lds, const Gemm g, const StaticOrder& S, const Epi& E) {
    const int tid = opaque_tid(), wid = __builtin_amdgcn_readfirstlane(tid >> 6), lane = tid & 63, wr = wid >> 2, wc = wid & 3, fr = lane & 15, fq = lane >> 4;
    const int K = g.K, LD = g.ld, nt = K / BK;
    unsigned voffA[2];
#pragma unroll
    for (int i = 0; i < 2; ++i) { int R, C; stage_rc(tid * 16 + i * 8192, R, C); voffA[i] = (unsigned)(R * LD + C) * 2u; }
    const size_t kstep = (size_t)(BK * 2);
    const size_t hstep = (size_t)HALF * LD * 2;
    const size_t tstep = 2 * hstep;
    const unsigned ldsw = (unsigned)wid * 1024u;
    const int aoff = lds_byte(wr * 64 + fr, fq * 8), boff = lds_byte(wc * 32 + fr, fq * 8);
#define PG8_SA(b, h) (((b) * 2 + (h)) * HTB)
#define PG8_SB(b, h) ((4 + (b) * 2 + (h)) * HTB)
#define PG8_STAGE(bufoff, gbase, voff) do { _Pragma("unroll") for (int _i = 0; _i < 2; ++_i) \
        __builtin_amdgcn_global_load_lds((const unsigned*)((const char*)(gbase) + (voff)[_i]), (LAS unsigned*)(lds + (bufoff) + ldsw + _i * 8192), 16, 0, 0); } while (0)
#define PG8_LDA(dst, b, h) do { _Pragma("unroll") for (int m = 0; m < 4; ++m) _Pragma("unroll") for (int k = 0; k < 2; ++k) dst[m][k] = *(const LAS bf16x8*)(lds + PG8_SA(b, h) + aoff + m * 2048 + k * 1024); } while (0)
#define PG8_LDB(dst, b, h) do { _Pragma("unroll") for (int n = 0; n < 2; ++n) _Pragma("unroll") for (int k = 0; k < 2; ++k) dst[n][k] = *(const LAS bf16x8*)(lds + PG8_SB(b, h) + boff + n * 2048 + k * 1024); } while (0)
#define PG8_MMA(ai, bj, At, Bt) do { __builtin_amdgcn_s_setprio(1); _Pragma("unroll") for (int m = 0; m < 4; ++m) _Pragma("unroll") for (int n = 0; n < 2; ++n) _Pragma("unroll") for (int k = 0; k < 2; ++k) \
        acc[ai][bj][m][n] = __builtin_amdgcn_mfma_f32_16x16x32_bf16(Bt[n][k], At[m][k], acc[ai][bj][m][n], 0, 0, 0); __builtin_amdgcn_s_setprio(0); } while (0)
#define PG8_WAIT_V(n) asm volatile("s_waitcnt vmcnt(" #n ")" ::: "memory")
#define PG8_WAIT_L(n) asm volatile("s_waitcnt lgkmcnt(" #n ")" ::: "memory")
#define PG8_BAR __builtin_amdgcn_s_barrier()
#define PG8_SCHED __builtin_amdgcn_sched_barrier(0)
    Unit cur, nxt; int ui = 0;
    if (!S.next(0, cur)) return;
    f32x4 acc[2][2][4][2];
#pragma unroll
    for (int a = 0; a < 2; ++a)
#pragma unroll
        for (int b = 0; b < 2; ++b)
#pragma unroll
            for (int m = 0; m < 4; ++m)
#pragma unroll
                for (int n = 0; n < 2; ++n) acc[a][b][m][n] = (f32x4){0.f, 0.f, 0.f, 0.f};
    bf16x8 At[4][2], B0[2][2], B1[2][2];
    const char* cA = (const char*)g.A + (size_t)cur.pm * tstep; const char* cB = (const char*)g.Bt + (size_t)cur.pn * tstep;
    PG8_STAGE(PG8_SB(0, 0), cB, voffA); PG8_STAGE(PG8_SA(0, 0), cA, voffA); PG8_STAGE(PG8_SB(0, 1), cB + hstep, voffA); PG8_STAGE(PG8_SA(0, 1), cA + hstep, voffA);
    if (wr == 1) PG8_BAR;
    PG8_WAIT_V(4); PG8_BAR;
    PG8_STAGE(PG8_SB(1, 0), cB + kstep, voffA); PG8_STAGE(PG8_SA(1, 0), cA + kstep, voffA); PG8_STAGE(PG8_SB(1, 1), cB + hstep + kstep, voffA);
    PG8_WAIT_V(6); PG8_BAR;
    for (;;) {
        const bool has_next = S.next(ui + 1, nxt);
        const char* nA = has_next ? (const char*)g.A + (size_t)nxt.pm * tstep : cA; const char* nB = has_next ? (const char*)g.Bt + (size_t)nxt.pn * tstep : cB;
        for (int t = 0; t < nt; t += 2) {
            const bool last = (t == nt - 2);
            const char* a1 = cA + (size_t)(t + 1) * kstep;
            const char* a2 = last ? nA : cA + (size_t)(t + 2) * kstep; const char* b2 = last ? nB : cB + (size_t)(t + 2) * kstep;
            const char* a3 = a2 + kstep; const char* b3 = b2 + kstep;
            PG8_LDB(B0, 0, 0); PG8_SCHED; PG8_LDA(At, 0, 0); PG8_STAGE(PG8_SA(1, 1), a1 + hstep, voffA);
            PG8_WAIT_L(8); PG8_BAR; PG8_WAIT_L(0); PG8_MMA(0, 0, At, B0); PG8_BAR; PG8_SCHED;
            PG8_LDB(B1, 0, 1); PG8_STAGE(PG8_SB(0, 0), b2, voffA);
            PG8_BAR; PG8_WAIT_L(0); PG8_MMA(0, 1, At, B1); PG8_BAR;
            PG8_LDA(At, 0, 1); PG8_STAGE(PG8_SA(0, 0), a2, voffA);
            PG8_BAR; PG8_WAIT_L(0); PG8_MMA(1, 0, At, B0); PG8_BAR; PG8_SCHED;
            PG8_STAGE(PG8_SB(0, 1), b2 + hstep, voffA);
            PG8_WAIT_V(6); PG8_BAR; PG8_MMA(1, 1, At, B1); PG8_BAR;
            PG8_LDB(B0, 1, 0); PG8_SCHED; PG8_LDA(At, 1, 0); PG8_STAGE(PG8_SA(0, 1), a2 + hstep, voffA);
            PG8_WAIT_L(8); PG8_BAR; PG8_WAIT_L(0); PG8_MMA(0, 0, At, B0); PG8_BAR; PG8_SCHED;
            PG8_LDB(B1, 1, 1); PG8_STAGE(PG8_SB(1, 0), b3, voffA);
            PG8_BAR; PG8_WAIT_L(0); PG8_MMA(0, 1, At, B1); PG8_BAR;
            PG8_LDA(At, 1, 1); PG8_STAGE(PG8_SA(1, 0), a3, voffA);
            PG8_BAR; PG8_WAIT_L(0); PG8_MMA(1, 0, At, B0); PG8_BAR; PG8_SCHED;
            PG8_STAGE(PG8_SB(1, 1), b3 + hstep, voffA);
            PG8_WAIT_V(6); PG8_BAR; PG8_MMA(1, 1, At, B1); PG8_BAR;
        }
        E(acc, cur, wr, wc, fr, fq);
        if (!has_next) break;
#pragma unroll
        for (int a = 0; a < 2; ++a)
#pragma unroll
            for (int b = 0; b < 2; ++b)
#pragma unroll
                for (int m = 0; m < 4; ++m)
#pragma unroll
                    for (int n = 0; n < 2; ++n) acc[a][b][m][n] = (f32x4){0.f, 0.f, 0.f, 0.f};
        cur = nxt; cA = nA; cB = nB; ++ui;
    }
    PG8_WAIT_V(0);
    if (wr == 0) PG8_BAR;
    PG8_BAR;
#undef PG8_SA
#undef PG8_SB
#undef PG8_STAGE
#undef PG8_LDA
#undef PG8_LDB
#undef PG8_MMA
#undef PG8_WAIT_V
#undef PG8_WAIT_L
#undef PG8_BAR
#undef PG8_SCHED
}
}
using pg8::Unit;

__device__ __forceinline__ int slot_of_L(int L) { return (((L >> 3) & 1) << 7) | (((L >> 6) & 3) << 5) | (((L >> 2) & 1) << 4) | (((L >> 4) & 3) << 2) | (L & 3); }
__device__ __forceinline__ int rope_lambda(int dd, int half) { const int hf = dd / half, i = dd % half; return 16 * (i >> 3) + 8 * hf + (i & 7); }
__device__ __forceinline__ int keypos_of(int key) { return (key & ~12) | ((key & 4) << 1) | ((key & 8) >> 1); }
enum { KNAT = 0, KSWI = 1, KIN = 2, KUQ = 3, KUKV = 4 };
__device__ __forceinline__ int dstrow(int kind, int which, int c) {
    if (kind == KNAT) return c;
    if (kind == KSWI) { const int pn = c >> 7, cg = c & 127; return pn * 256 + ((((cg >> 2) & 1) << 7) | (((cg >> 5) & 3) << 5) | (which << 4) | (((cg >> 3) & 3) << 2) | (cg & 3)); }
    if (kind == KIN) {
        int tile, L;
        if (c < 256) { tile = 0; L = c; }
        else if (c < 640) { const int q = c - 256; tile = 1 + (q >> 8); L = q & 255; }
        else if (c < 896) { tile = 3; L = c - 640; }
        else if (c < 928) { tile = 2; L = 128 + rope_lambda(c - 896, 16); }
        else if (c < 1952) { int qq = c - 928; const int isk = qq >= 512 ? 1 : 0; qq &= 511; const int hd = qq >> 6; tile = 4 + 2 * isk + (hd >> 2); L = 64 * (hd & 3) + rope_lambda(qq & 63, 32); }
        else { const int vv = c - 1952; tile = 8 + (vv >> 8); L = vv & 255; }
        return tile * 256 + slot_of_L(L);
    }
    if (kind == KUQ) { const int head = c / 96, dd = c % 96; const int Lh = dd < 64 ? dd : 64 + rope_lambda(dd - 64, 16); const int L = 128 * (head & 1) + Lh; return (head >> 1) * 256 + slot_of_L(L); }
      { const int head = c >> 7, dd = c & 127; const int tile = dd >> 6; const int L = 64 * head + (dd & 63); return tile * 256 + slot_of_L(L); }
}

struct EpiSwiGLU {
    bf16_t* __restrict__ G;
    __device__ __forceinline__ void operator()(const f32x4 (&acc)[2][2][4][2], const Unit& u, int wr, int wc, int fr_, int fq_) const {
        const int tq_ = opaque_tid(); const int fr = tq_ & 15, fq = (tq_ >> 4) & 3; (void)fr_; (void)fq_;
        const int row0 = u.pm * 256 + wr * 64 + fr, col0 = u.pn * 128 + wc * 32 + fq * 8;
#pragma unroll
        for (int ai = 0; ai < 2; ++ai)
#pragma unroll
            for (int m = 0; m < 4; ++m) {
                float o[8];
#pragma unroll
                for (int bj = 0; bj < 2; ++bj)
#pragma unroll
                    for (int j = 0; j < 4; ++j) { const float a = acc[ai][bj][m][0][j], b = acc[ai][bj][m][1][j]; o[bj * 4 + j] = a * fast_rcp(1.f + fast_exp2(-a * LOG2E)) * b; }
                u32x4 w; w.x = cvt_pk_bf16(o[0], o[1]); w.y = cvt_pk_bf16(o[2], o[3]); w.z = cvt_pk_bf16(o[4], o[5]); w.w = cvt_pk_bf16(o[6], o[7]);
                *(u32x4*)(G + (size_t)(row0 + ai * 128 + m * 16) * DFF + col0) = w;
            }
    }
};
struct EpiResid {
    const float* Hin; const float* Hin_ctx; float* Hout; const float* gate_l; float sc;
    __device__ __forceinline__ void operator()(const f32x4 (&acc)[2][2][4][2], const Unit& u, int wr, int wc, int fr_, int fq_) const {
        const int tq_ = opaque_tid(); const int fr = tq_ & 15, fq = (tq_ >> 4) & 3; (void)fr_; (void)fq_;
        const int bi = u.pm < 256 ? (u.pm >> 4) : 16;
        const int row0 = u.pm * 256 + wr * 64 + fr, col0 = u.pn * 256 + wc * 32 + 4 * fq;
        const float* gate = gate_l + (size_t)bi * 9216 + col0;
        const float* hin = u.pm < 256 ? Hin : Hin_ctx;
        f32x4 gv[2][2];
#pragma unroll
        for (int bj = 0; bj < 2; ++bj)
#pragma unroll
            for (int n = 0; n < 2; ++n) gv[bj][n] = *(const f32x4*)(gate + bj * 128 + n * 16) * sc;
        f32x4 hb[3][2][2];
#define RES_LOAD(g_, st_) { const size_t base_ = (size_t)(row0 + ((g_) >> 2) * 128 + ((g_) & 3) * 16) * DM + col0; \
            _Pragma("unroll") for (int bj = 0; bj < 2; ++bj) _Pragma("unroll") for (int n = 0; n < 2; ++n) hb[st_][bj][n] = *(const f32x4*)(hin + base_ + bj * 128 + n * 16); }
        RES_LOAD(0, 0); RES_LOAD(1, 1);
#pragma unroll
        for (int g = 0; g < 8; ++g) {
            if (g + 2 < 8) { RES_LOAD(g + 2, (g + 2) % 3); }
            const int ai = g >> 2, m = g & 3;
            const size_t base = (size_t)(row0 + ai * 128 + m * 16) * DM + col0;
#pragma unroll
            for (int bj = 0; bj < 2; ++bj)
#pragma unroll
                for (int n = 0; n < 2; ++n) *(f32x4*)(Hout + base + bj * 128 + n * 16) = hb[g % 3][bj][n] + gv[bj][n] * acc[ai][bj][m][n];
        }
#undef RES_LOAD
    }
};
struct EpiPartial {
    float* __restrict__ P;
    __device__ __forceinline__ void operator()(const f32x4 (&acc)[2][2][4][2], const Unit& u, int wr, int wc, int fr_, int fq_) const {
        const int tq_ = opaque_tid(); const int fr = tq_ & 15, fq = (tq_ >> 4) & 3; (void)fr_; (void)fq_;
        const int row0 = u.pm * 256 + wr * 64 + fr, col0 = u.pn * 256 + wc * 32 + 4 * fq;
#pragma unroll
        for (int ai = 0; ai < 2; ++ai)
#pragma unroll
            for (int m = 0; m < 4; ++m) {
                float* hp = P + (size_t)(row0 + ai * 128 + m * 16) * DM + col0;
#pragma unroll
                for (int bj = 0; bj < 2; ++bj)
#pragma unroll
                    for (int n = 0; n < 2; ++n) *(f32x4*)(hp + bj * 128 + n * 16) = acc[ai][bj][m][n];
            }
    }
};
__device__ __forceinline__ void store16bf(bf16_t* dst, const float (&v)[16]) {
    u32x4 w0, w1;
    w0.x = cvt_pk_bf16(v[0], v[1]); w0.y = cvt_pk_bf16(v[2], v[3]); w0.z = cvt_pk_bf16(v[4], v[5]); w0.w = cvt_pk_bf16(v[6], v[7]);
    w1.x = cvt_pk_bf16(v[8], v[9]); w1.y = cvt_pk_bf16(v[10], v[11]); w1.z = cvt_pk_bf16(v[12], v[13]); w1.w = cvt_pk_bf16(v[14], v[15]);
    *(u32x4*)dst = w0; *(u32x4*)(dst + 8) = w1;
}
__device__ __forceinline__ void rope16(float (&v)[16], const float* tab) {
#pragma unroll
    for (int q = 0; q < 4; ++q) {
        const f32x4 cs = *(const f32x4*)(tab + q * 4);
        { const float x1 = v[2 * q], x2 = v[8 + 2 * q]; v[2 * q] = x1 * cs[0] - x2 * cs[1]; v[8 + 2 * q] = x1 * cs[1] + x2 * cs[0]; }
        { const float x1 = v[2 * q + 1], x2 = v[9 + 2 * q]; v[2 * q + 1] = x1 * cs[2] - x2 * cs[3]; v[9 + 2 * q] = x1 * cs[3] + x2 * cs[2]; }
    }
}
__device__ __forceinline__ void store_vt(LAS unsigned char* tw, const float (&v)[16], int fr, int fq, bf16_t* vt) {
    const int pos = ((fr & 4) << 1) | ((fr & 8) >> 1) | (fr & 3);
#pragma unroll
    for (int e = 0; e < 16; ++e) *(LAS bf16_t*)(tw + (16 * fq + e) * 48 + pos * 2) = f2bf(v[e]);
    const int lane = fq * 16 + fr;
#pragma unroll
    for (int i = 0; i < 2; ++i) { const int ch = lane + 64 * i, col = ch >> 1, half = ch & 1;
        const u32x4 w = *(const LAS u32x4*)(tw + col * 48 + half * 16);
        *(u32x4*)(vt + (size_t)col * KVL + half * 8) = w; }
}
struct EpiIn {
    float* __restrict__ U; bf16_t* __restrict__ CQ; bf16_t* __restrict__ CKV; float* __restrict__ SSQ; bf16_t* __restrict__ QD; bf16_t* __restrict__ KD; bf16_t* __restrict__ VTD; bf16_t* __restrict__ KM; const float* __restrict__ ROPED; const float* __restrict__ ROPEM; LAS unsigned char* tl;
    __device__ __forceinline__ void operator()(const f32x4 (&acc)[2][2][4][2], const Unit& u, int wr, int wc, int fr_, int fq_) const {
        const int tq_ = opaque_tid(); const int fr = tq_ & 15, fq = (tq_ >> 4) & 3; (void)fr_; (void)fq_;
        const int pn = u.pn, L0 = 64 * wc + 16 * fq;
#pragma unroll
        for (int ai = 0; ai < 2; ++ai)
#pragma unroll
            for (int m = 0; m < 4; ++m) {
                const int row = u.pm * 256 + ai * 128 + wr * 64 + m * 16 + fr;
                const bool lat = u.pm < 256;
                const int b = lat ? (row >> 12) : ((row - NLAT) >> 8);
                const int key = lat ? (CTXL + (row & 4095)) : ((row - NLAT) & 255);
                const int pos = row & 4095;
                float v[16];
#pragma unroll
                for (int bj = 0; bj < 2; ++bj)
#pragma unroll
                    for (int n = 0; n < 2; ++n)
#pragma unroll
                        for (int j = 0; j < 4; ++j) v[8 * bj + 4 * n + j] = acc[ai][bj][m][n][j];
                if (pn == 0) {
                    float* d = U + (size_t)row * 256 + L0;
#pragma unroll
                    for (int q = 0; q < 4; ++q) *(f32x4*)(d + 4 * q) = (f32x4){v[4 * q], v[4 * q + 1], v[4 * q + 2], v[4 * q + 3]};
                } else if (pn <= 3) {
                    if (pn == 2 && wc >= 2) {
                        if (wc == 2 && fq < 2) {
                            if (lat) rope16(v, ROPEM + ((size_t)pos * 16 + 8 * fq) * 2);
#pragma unroll
                            for (int h = 0; h < 4; ++h) store16bf(KM + ((size_t)(b * 4 + h) * KVL + key) * 96 + 64 + 16 * fq, v);
                        }
                    } else {
                        float s = 0.f;
#pragma unroll
                        for (int e = 0; e < 16; ++e) s += v[e] * v[e];
                        { const int ln = fq * 16 + fr; s += shx(s, 16, ln); s += shx(s, 32, ln); }
                        if (pn < 3) { store16bf(CQ + (size_t)row * 384 + (pn - 1) * 256 + L0, v); if (fq == 0) SSQ[(size_t)row * 16 + (pn - 1) * 4 + wc] = s; }
                        else { store16bf(CKV + (size_t)row * 256 + L0, v); if (fq == 0) SSQ[(size_t)row * 16 + 8 + wc] = s; }
                    }
                } else if (pn <= 7) {
                    const int hd = 4 * ((pn - 4) & 1) + wc;
                    if (lat) rope16(v, ROPED + ((size_t)pos * 32 + 8 * fq) * 2);
                    if (pn <= 5) {
                        const float qs = 0.125f * LOG2E;
#pragma unroll
                        for (int e = 0; e < 16; ++e) v[e] *= qs;
                        store16bf(QD + (size_t)row * 512 + hd * 64 + 16 * fq, v);
                    } else store16bf(KD + ((size_t)(b * 8 + hd) * KVL + key) * 64 + 16 * fq, v);
                } else {
                    const int h = 2 * (pn - 8) + (wc >> 1);
                    store_vt(tl + (wr * 4 + wc) * 3072, v, fr, fq, VTD + ((size_t)(b * 4 + h) * 128 + 64 * (wc & 1)) * KVL + (key - fr));
                }
            }
    }
};
struct EpiQup {
    const float* __restrict__ SSQ; bf16_t* __restrict__ QM; const float* __restrict__ ROPEM;
    __device__ __forceinline__ void operator()(const f32x4 (&acc)[2][2][4][2], const Unit& u, int wr, int wc, int fr_, int fq_) const {
        const int tq_ = opaque_tid(); const int fr = tq_ & 15, fq = (tq_ >> 4) & 3; (void)fr_; (void)fq_;
        const int head = 2 * u.pn + (wc >> 1), part = wc & 1;
        if (part == 1 && fq >= 2) return;
#pragma unroll
        for (int ai = 0; ai < 2; ++ai)
#pragma unroll
            for (int m = 0; m < 4; ++m) {
                const int row = u.pm * 256 + ai * 128 + wr * 64 + m * 16 + fr;
                const f32x4 s4 = *(const f32x4*)(SSQ + (size_t)row * 16); const f32x2 s2 = *(const f32x2*)(SSQ + (size_t)row * 16 + 4);
                const float ss = (s4[0] + s4[1]) + (s4[2] + s4[3]) + (s2[0] + s2[1]);
                const float sc = rsqrtf(ss * (1.f / 384.f) + EPS) * (0.10206207261596577f * LOG2E);
                float v[16];
#pragma unroll
                for (int bj = 0; bj < 2; ++bj)
#pragma unroll
                    for (int n = 0; n < 2; ++n)
#pragma unroll
                        for (int j = 0; j < 4; ++j) v[8 * bj + 4 * n + j] = acc[ai][bj][m][n][j] * sc;
                if (part == 1 && u.pm < 256) rope16(v, ROPEM + ((size_t)(row & 4095) * 16 + 8 * fq) * 2);
                store16bf(QM + (size_t)row * 384 + head * 96 + 64 * part + 16 * fq, v);
            }
    }
};
struct EpiKVup {
    const float* __restrict__ SSQ; bf16_t* __restrict__ KM; bf16_t* __restrict__ VTM; LAS unsigned char* tl;
    __device__ __forceinline__ void operator()(const f32x4 (&acc)[2][2][4][2], const Unit& u, int wr, int wc, int fr_, int fq_) const {
        const int tq_ = opaque_tid(); const int fr = tq_ & 15, fq = (tq_ >> 4) & 3; (void)fr_; (void)fq_;
#pragma unroll
        for (int ai = 0; ai < 2; ++ai)
#pragma unroll
            for (int m = 0; m < 4; ++m) {
                const int row = u.pm * 256 + ai * 128 + wr * 64 + m * 16 + fr;
                const bool lat = u.pm < 256;
                const int b = lat ? (row >> 12) : ((row - NLAT) >> 8);
                const int key = lat ? (CTXL + (row & 4095)) : ((row - NLAT) & 255);
                const f32x4 s4 = *(const f32x4*)(SSQ + (size_t)row * 16 + 8);
                const float sc = rsqrtf(((s4[0] + s4[1]) + (s4[2] + s4[3])) * (1.f / 256.f) + EPS);
                float v[16];
#pragma unroll
                for (int bj = 0; bj < 2; ++bj)
#pragma unroll
                    for (int n = 0; n < 2; ++n)
#pragma unroll
                        for (int j = 0; j < 4; ++j) v[8 * bj + 4 * n + j] = acc[ai][bj][m][n][j] * sc;
                if (u.pn == 0) store16bf(KM + ((size_t)(b * 4 + wc) * KVL + key) * 96 + 16 * fq, v);
                else {
                    store_vt(tl + (wr * 4 + wc) * 3072, v, fr, fq, VTM + ((size_t)(b * 4 + wc) * 64) * KVL + (key - fr));
                }
            }
    }
};

__constant__ float c_invfreq[24] = {1.000000000e+00f, 5.623413324e-01f, 3.162277639e-01f, 1.778279394e-01f, 1.000000015e-01f, 5.623413250e-02f, 3.162277490e-02f, 1.778279431e-02f, 9.999999776e-03f, 5.623413250e-03f, 3.162277630e-03f, 1.778279431e-03f, 1.000000047e-03f, 5.623413017e-04f, 3.162277571e-04f, 1.778279402e-04f, 1.000000000e+00f, 3.162277639e-01f, 1.000000015e-01f, 3.162277490e-02f, 9.999999776e-03f, 3.162277630e-03f, 1.000000047e-03f, 3.162277571e-04f};
__device__ void phase_init(const Params& p, LAS unsigned char* lds) {
    const int tid = opaque_tid();
    const size_t gtid = (size_t)blockIdx.x * 512 + tid, gsz = (size_t)gridDim.x * 512;
    for (size_t i = gtid; i < (size_t)4096 * 48; i += gsz) {
        int pos, a, use_row; float* dst;
        if (i < (size_t)4096 * 32) { pos = (int)(i >> 5); const int ii = (int)(i & 31); a = ii & 15; use_row = ii < 16; dst = p.ROPED + 2 * i; }
        else { const size_t j = i - (size_t)4096 * 32; pos = (int)(j >> 4); const int ii = (int)(j & 15); a = 16 + (ii & 7); use_row = ii < 8; dst = p.ROPEM + 2 * j; }
        const float ang = (float)(use_row ? (pos >> 6) : (pos & 63)) * c_invfreq[a];
        const float kq = rintf(ang * 0.636619772f);
        float r = fmaf(-kq, 1.570770263671875f, ang); r = fmaf(-kq, 2.6063062250614166e-05f, r); r = fmaf(-kq, 6.077094383272197e-11f, r);
        const float r2 = r * r;
        const float sn = r * (1.f + r2 * (-1.6666667e-1f + r2 * (8.3333333e-3f + r2 * (-1.9841270e-4f + r2 * 2.7557319e-6f))));
        const float cs = 1.f + r2 * (-0.5f + r2 * (4.1666667e-2f + r2 * (-1.3888889e-3f + r2 * (2.4801587e-5f + r2 * (-2.7557319e-7f)))));
        const int qd = ((int)kq) & 3;
        dst[0] = qd == 0 ? cs : qd == 1 ? -sn : qd == 2 ? -cs : sn;
        dst[1] = qd == 0 ? sn : qd == 1 ? cs : qd == 2 ? -sn : -cs;
    }
    LAS float* sct = (LAS float*)lds;
    LAS float* red = (LAS float*)(lds + 81920);
    for (int i = tid; i < 17 * 1024; i += 512) { const int bi = i >> 10, k = i & 1023; const float cv = bi < 16 ? p.c[bi * 1024 + k] : p.c_ctx[k]; sct[k * 20 + bi] = cv / (1.f + __expf(-cv)); }
    __syncthreads();
    const int col = tid & 127, kg = tid >> 7;
    for (int u = blockIdx.x; u < DEPTH * 72; u += gridDim.x) {
        const int l = u / 72, n0 = (u % 72) * 128;
        const float* w = p.w_mod + (size_t)l * 1024 * 9216 + n0 + col;
        float a[17];
#pragma unroll
        for (int q = 0; q < 17; ++q) a[q] = 0.f;
#pragma unroll 4
        for (int k = kg * 256; k < kg * 256 + 256; ++k) {
            const float wv = w[(size_t)k * 9216];
            const f32x4 s0 = *(const LAS f32x4*)(sct + k * 20), s1 = *(const LAS f32x4*)(sct + k * 20 + 4), s2 = *(const LAS f32x4*)(sct + k * 20 + 8), s3 = *(const LAS f32x4*)(sct + k * 20 + 12);
            const float s16 = sct[k * 20 + 16];
#pragma unroll
            for (int q = 0; q < 4; ++q) { a[q] += s0[q] * wv; a[4 + q] += s1[q] * wv; a[8 + q] += s2[q] * wv; a[12 + q] += s3[q] * wv; }
            a[16] += s16 * wv;
        }
#pragma unroll
        for (int q = 0; q < 17; ++q) red[(kg * 17 + q) * 128 + col] = a[q];
        __syncthreads();
        for (int i = tid; i < 17 * 128; i += 512) { const int bi = i >> 7, cc = i & 127;
            const float s = (red[(0 * 17 + bi) * 128 + cc] + red[(1 * 17 + bi) * 128 + cc]) + (red[(2 * 17 + bi) * 128 + cc] + red[(3 * 17 + bi) * 128 + cc]);
            p.MODS[((size_t)l * 17 + bi) * 9216 + n0 + cc] = s + p.b_mod[(size_t)l * 9216 + n0 + cc]; }
        __syncthreads();
    }
}

__device__ void phase_norm(const float* H, const float* Hctx, int nrows, const float* gw, const float* mods_l, int shift_idx, int scale_idx, bf16_t* outb, float* outf,
                           const float* P4, const float* pgate, float psc, float* Hw) {
    const int tid = opaque_tid(); const int wid = tid >> 6, lane = tid & 63;
    for (int row = blockIdx.x * 8 + wid; row < nrows; row += gridDim.x * 8) {
        const float* hr = (row < NLAT ? H : Hctx) + (size_t)row * DM + lane * 4;
        f32x4 v[4]; float ss = 0.f;
#pragma unroll
        for (int q = 0; q < 4; ++q) v[q] = *(const f32x4*)(hr + q * 256);
        if (P4 && row >= NLAT) {
            const float* pr = P4 + (size_t)(row - NLAT) * DM + lane * 4;
#pragma unroll
            for (int q = 0; q < 4; ++q) { const f32x4 s4 = (*(const f32x4*)(pr + q * 256) + *(const f32x4*)(pr + (size_t)NCTX * DM + q * 256)) + (*(const f32x4*)(pr + (size_t)2 * NCTX * DM + q * 256) + *(const f32x4*)(pr + (size_t)3 * NCTX * DM + q * 256));
                v[q] += (*(const f32x4*)(pgate + lane * 4 + q * 256) * psc) * s4; *(f32x4*)(Hw + (size_t)row * DM + lane * 4 + q * 256) = v[q]; }
        }
#pragma unroll
        for (int q = 0; q < 4; ++q) ss += (v[q][0] * v[q][0] + v[q][1] * v[q][1]) + (v[q][2] * v[q][2] + v[q][3] * v[q][3]);
        ss += __builtin_bit_cast(float, __builtin_amdgcn_update_dpp(0, __builtin_bit_cast(int, ss), 0xB1, 0xF, 0xF, true));
        ss += __builtin_bit_cast(float, __builtin_amdgcn_update_dpp(0, __builtin_bit_cast(int, ss), 0x4E, 0xF, 0xF, true));
        ss += __builtin_bit_cast(float, __builtin_amdgcn_update_dpp(0, __builtin_bit_cast(int, ss), 0x141, 0xF, 0xF, true));
        ss += __builtin_bit_cast(float, __builtin_amdgcn_update_dpp(0, __builtin_bit_cast(int, ss), 0x140, 0xF, 0xF, true));
        ss += shx(ss, 16, lane); ss += shx(ss, 32, lane);
        const float rstd = rsqrtf(ss * (1.f / DM) + EPS);
        if (outb) {
            const int bi = row < NLAT ? (row >> 12) : 16;
            const float* sh = mods_l + (size_t)bi * 9216 + shift_idx * 1024 + lane * 4; const float* sc = mods_l + (size_t)bi * 9216 + scale_idx * 1024 + lane * 4;
#pragma unroll
            for (int q = 0; q < 4; ++q) {
                const f32x4 g = *(const f32x4*)(gw + lane * 4 + q * 256), s = *(const f32x4*)(sc + q * 256), t = *(const f32x4*)(sh + q * 256);
                const f32x4 y = (v[q] * rstd * g) * (s + 1.f) + t;
                u32x2 w; w.x = cvt_pk_bf16(y[0], y[1]); w.y = cvt_pk_bf16(y[2], y[3]);
                *(u32x2*)(outb + (size_t)row * DM + lane * 4 + q * 256) = w;
            }
        } else {
#pragma unroll
            for (int q = 0; q < 4; ++q) { const f32x4 g = *(const f32x4*)(gw + lane * 4 + q * 256); *(f32x4*)(outf + (size_t)row * DM + lane * 4 + q * 256) = v[q] * rstd * g; }
        }
    }
}

__device__ void phase_convert(const Params& p, int l, LAS unsigned char* lds) {
    LAS float* tile = (LAS float*)lds;
    const int tid = opaque_tid();
    for (int u = blockIdx.x; u < 5176; u += gridDim.x) {
        const float* src; int Nsrc, K; bf16_t* dst; int kind = KNAT, which = 0; const float* ksc = nullptr; int t = u;
        if (t < 4224) { const int j = t / 704; t %= 704; const int f = j / 3, mm = j % 3;
            if (mm < 2) { src = (f ? (mm ? p.ffn2_w3 : p.ffn2_w1) : (mm ? p.ffn1_w3 : p.ffn1_w1)) + (size_t)l * DM * DFF; Nsrc = DFF; K = DM; dst = f ? p.Bt13b : p.Bt13a; kind = KSWI; which = mm; }
            else { src = (f ? p.ffn2_w2 : p.ffn1_w2) + (size_t)l * DFF * DM; Nsrc = DM; K = DFF; dst = f ? p.Bt2b : p.Bt2a; } }
        else if ((t -= 4224) < 624) { src = p.w_in + (size_t)l * DM * INW; Nsrc = INW; K = DM; dst = p.Btin; kind = KIN; }
        else if ((t -= 624) < 256) { src = p.w_out + (size_t)l * DM * DM; Nsrc = DM; K = DM; dst = p.Btout; }
        else if ((t -= 256) < 36) { src = p.mla_w_uq + (size_t)l * 384 * 384; Nsrc = 384; K = 384; dst = p.Btuq; kind = KUQ; ksc = p.mla_q_norm + l * 384; }
        else if ((t -= 36) < 32) { src = p.mla_w_ukv + (size_t)l * 256 * 512; Nsrc = 512; K = 256; dst = p.Btukv; kind = KUKV; ksc = p.mla_kv_norm + l * 256; }
        else { t -= 32; src = p.pool_w + (size_t)(l * 4 + t) * 4096; Nsrc = 64; K = 64; dst = p.Btpool + t * 4096; t = 0; }
        const int nkt = K / 64; const int c0 = (t / nkt) * 64, k0 = (t % nkt) * 64;
        { const int cl = tid & 63, ks = tid >> 6; const int c = c0 + cl;
#pragma unroll
          for (int kk = 0; kk < 8; ++kk) { const int k = ks + 8 * kk; tile[k * 65 + cl] = c < Nsrc ? src[(size_t)(k0 + k) * Nsrc + c] : 0.f; } }
        __syncthreads();
        { const int cl = tid >> 3, kseg = tid & 7; const int c = c0 + cl;
          if (c < Nsrc) { const int row = dstrow(kind, which, c); float v[8];
#pragma unroll
              for (int i = 0; i < 8; ++i) v[i] = tile[(kseg * 8 + i) * 65 + cl] * (ksc ? ksc[k0 + kseg * 8 + i] : 1.f);
              u32x4 w; w.x = cvt_pk_bf16(v[0], v[1]); w.y = cvt_pk_bf16(v[2], v[3]); w.z = cvt_pk_bf16(v[4], v[5]); w.w = cvt_pk_bf16(v[6], v[7]);
              *(u32x4*)(dst + (size_t)row * K + k0 + kseg * 8) = w; } }
        __syncthreads();
    }
}

template <int K> __device__ __forceinline__ void win_sum(const float* base, size_t stride, int cnt, f32x4& s0, f32x4& s1) {
    f32x4 v0[K], v1[K];
#pragma unroll
    for (int i = 0; i < K; ++i) { const float* q = base + (size_t)min(i, cnt - 1) * stride; v0[i] = *(const f32x4*)q; v1[i] = *(const f32x4*)(q + 4); }
#pragma unroll
    for (int i = 0; i < K; ++i) { const float w = i < cnt ? 1.f : 0.f; s0 += v0[i] * w; s1 += v1[i] * w; }
}
__device__ __forceinline__ void win_sum_g(int g, const float* base, size_t stride, int cnt, f32x4& s0, f32x4& s1) {
    if (g == 0) win_sum<2>(base, stride, cnt, s0, s1); else if (g == 1) win_sum<4>(base, stride, cnt, s0, s1); else if (g == 2) win_sum<8>(base, stride, cnt, s0, s1); else win_sum<16>(base, stride, cnt, s0, s1);
}
__device__ void phase_pool(const Params& p, int l, bool with_ctx, LAS unsigned char* lds) {
    LAS float* V = (LAS float*)lds;
    LAS bf16_t* Dm = (LAS bf16_t*)(lds + 17408);
    const int tid = opaque_tid(), wid = tid >> 6, lane = tid & 63, c16 = lane & 15, gq = lane >> 4;
    const int c = tid >> 3, ch0 = (tid & 7) * 8;
    const int nunits = 4096 + (with_ctx ? 256 : 0);
    const float* ps = p.pool_scale + l * 256;
    for (int uu = blockIdx.x; uu < nunits; uu += gridDim.x) {
        const int u = (uu & ~255) | ((uu & 7) << 5) | ((uu & 255) >> 3);
        const bool lat = u < 4096; int b, g, r, tok0;
        if (lat) { b = u >> 8; g = (u >> 6) & 3; r = u & 63; tok0 = b * 4096 + r * 64; }
        else { const int uu = u - 4096; b = uu >> 4; g = (uu >> 2) & 3; r = uu & 3; tok0 = NLAT + b * 256 + r * 64; }
        const int k = 2 << g, lo = k >> 1, hi = k - 1 - lo;
        const float* Ug = p.U + g * 64 + ch0;
        f32x4 m0 = (f32x4){0.f, 0.f, 0.f, 0.f}, m1 = m0; float inv;
        if (lat) {
            const int r0 = max(r - lo, 0), r1 = min(r + hi, 63);
            f32x4 a0 = m0, a1 = m0;
            win_sum_g(g, Ug + (size_t)(b * 4096 + r0 * 64 + c) * 256, (size_t)64 * 256, r1 - r0 + 1, a0, a1);
            const float ir = 1.f / (float)(r1 - r0 + 1);
            *(LAS f32x4*)(V + c * 68 + ch0) = a0 * ir; *(LAS f32x4*)(V + c * 68 + ch0 + 4) = a1 * ir;
            __syncthreads();
            const int cc0 = max(c - lo, 0), cc1 = min(c + hi, 63);
            for (int cc = cc0; cc <= cc1; ++cc) { m0 += *(const LAS f32x4*)(V + cc * 68 + ch0); m1 += *(const LAS f32x4*)(V + cc * 68 + ch0 + 4); }
            inv = 1.f / (float)(cc1 - cc0 + 1);
        } else {
            const int i = r * 64 + c, i0 = max(i - lo, 0), i1 = min(i + hi, 255);
            win_sum_g(g, Ug + (size_t)(NLAT + b * 256 + i0) * 256, (size_t)256, i1 - i0 + 1, m0, m1);
            inv = 1.f / (float)(i1 - i0 + 1);
        }
        { const float* q = Ug + (size_t)(tok0 + c) * 256; const f32x4 u0 = *(const f32x4*)q, u1 = *(const f32x4*)(q + 4);
          const f32x4 d0 = m0 * inv - u0, d1 = m1 * inv - u1;
          u32x4 w; w.x = cvt_pk_bf16(d0[0], d0[1]); w.y = cvt_pk_bf16(d0[2], d0[3]); w.z = cvt_pk_bf16(d1[0], d1[1]); w.w = cvt_pk_bf16(d1[2], d1[3]);
          *(LAS u32x4*)(Dm + c * 72 + ch0) = w; }
        __syncthreads();
        const int tb = wid >> 1;
#pragma unroll
        for (int o = 0; o < 2; ++o) {
            const int ob = (wid & 1) * 2 + o; f32x4 acc = (f32x4){0.f, 0.f, 0.f, 0.f};
#pragma unroll
            for (int ks = 0; ks < 2; ++ks) {
                const bf16x8 a = *(const bf16x8*)(p.Btpool + g * 4096 + (ob * 16 + c16) * 64 + ks * 32 + gq * 8);
                const bf16x8 bb = *(const LAS bf16x8*)(Dm + (tb * 16 + c16) * 72 + ks * 32 + gq * 8);
                acc = __builtin_amdgcn_mfma_f32_16x16x32_bf16(a, bb, acc, 0, 0, 0);
            }
            const int tok = tok0 + tb * 16 + c16, oc = g * 64 + ob * 16 + 4 * gq;
            const f32x4 sc = *(const f32x4*)(ps + oc);
            u32x2 w; w.x = cvt_pk_bf16(acc[0] * sc[0], acc[1] * sc[1]); w.y = cvt_pk_bf16(acc[2] * sc[2], acc[3] * sc[3]);
            *(u32x2*)(p.XN + (size_t)tok * DM + oc) = w;
        }
        __syncthreads();
    }
}

typedef float f32x16 __attribute__((ext_vector_type(16)));
#define ROWMAX32(out, A, B) do { \
    asm("v_max3_f32 %0, %1, %2, %3\n\tv_max3_f32 %0, %0, %4, %5\n\tv_max3_f32 %0, %0, %6, %7\n\tv_max3_f32 %0, %0, %8, %9\n\tv_max3_f32 %0, %0, %10, %11\n\tv_max3_f32 %0, %0, %12, %13\n\tv_max3_f32 %0, %0, %14, %15\n\tv_max3_f32 %0, %0, %16, %16" \
        : "=&v"(out) : "v"((A)[0]), "v"((A)[1]), "v"((A)[2]), "v"((A)[3]), "v"((A)[4]), "v"((A)[5]), "v"((A)[6]), "v"((A)[7]), "v"((A)[8]), "v"((A)[9]), "v"((A)[10]), "v"((A)[11]), "v"((A)[12]), "v"((A)[13]), "v"((A)[14]), "v"((A)[15])); \
    asm("v_max3_f32 %0, %0, %1, %2\n\tv_max3_f32 %0, %0, %3, %4\n\tv_max3_f32 %0, %0, %5, %6\n\tv_max3_f32 %0, %0, %7, %8\n\tv_max3_f32 %0, %0, %9, %10\n\tv_max3_f32 %0, %0, %11, %12\n\tv_max3_f32 %0, %0, %13, %14\n\tv_max3_f32 %0, %0, %15, %16" \
        : "+v"(out) : "v"((B)[0]), "v"((B)[1]), "v"((B)[2]), "v"((B)[3]), "v"((B)[4]), "v"((B)[5]), "v"((B)[6]), "v"((B)[7]), "v"((B)[8]), "v"((B)[9]), "v"((B)[10]), "v"((B)[11]), "v"((B)[12]), "v"((B)[13]), "v"((B)[14]), "v"((B)[15])); } while (0)

template <int DQK, int DV, bool DIFF>
__device__ __forceinline__ void attn_unit(LAS unsigned char* lds, const bf16_t* Qp, int ldq, const bf16_t* Kp, size_t kmap_stride, const bf16_t* Vtp, int kv_len,
                                          bf16_t* outp  , float lam, float post, const float* subln) {
    constexpr int NMAP = DIFF ? 2 : 1;
    constexpr int KROW = DQK * 2 + 16, VROW = 144, KBYTES = 64 * KROW, VBYTES = DV * VROW, KBUF = NMAP * KBYTES, OFFV = 2 * KBUF;
    constexpr int KC8 = DQK / 8, KCH = NMAP * 64 * KC8, VCH = DV * 8, NLK = (KCH + 511) / 512, NLV = (VCH + 511) / 512, NKS = DQK / 16, NDB = DV / 32;
    const int tid = opaque_tid(), wid = tid >> 6, lane = tid & 63, q32 = lane & 31, h = lane >> 5;
    const int qg = DIFF ? (wid >> 1) : wid, mp = DIFF ? (wid & 1) : 0;
    bf16x8 qf[NKS];
    { const bf16_t* qr = Qp + (size_t)(qg * 32 + q32) * ldq + mp * 64 + h * 8;
#pragma unroll
      for (int ks = 0; ks < NKS; ++ks) qf[ks] = *(const bf16x8*)(qr + ks * 16); }
    f32x16 O[NDB];
#pragma unroll
    for (int db = 0; db < NDB; ++db)
#pragma unroll
        for (int j = 0; j < 16; ++j) O[db][j] = 0.f;
    float lsum = 0.f;
    f32x16 mneg;
#pragma unroll
    for (int j = 0; j < 16; ++j) mneg[j] = 0.f;
    u32x4 stk[NLK], stv[NLV];
    auto kchunk = [&](int i) { const int ch = tid + i * 512; return ch < KCH ? ch : ch - 256; };
    const __amdgpu_buffer_rsrc_t srdK = __builtin_amdgcn_make_buffer_rsrc((void*)Kp, (short)0, 0x7fffffff, 0x00020000);
    int kvo[NLK];
#pragma unroll
    for (int i = 0; i < NLK; ++i) { const int ch = kchunk(i), mpc = ch / (64 * KC8), cc = ch % (64 * KC8); kvo[i] = (int)(mpc * kmap_stride * 2) + cc * 16; }
    auto gloadK = [&](int t) {
#pragma unroll
        for (int i = 0; i < NLK; ++i) stk[i] = __builtin_amdgcn_raw_buffer_load_b128(srdK, kvo[i], t * (64 * DQK * 2), 0); };
    auto lstoreK = [&](int t) {
#pragma unroll
        for (int i = 0; i < NLK; ++i) { const int ch = kchunk(i), mpc = ch / (64 * KC8), cc = ch % (64 * KC8); *(LAS u32x4*)(lds + (t & 1) * KBUF + mpc * KBYTES + (cc / KC8) * KROW + (cc % KC8) * 16) = stk[i]; } };
    static_assert(VCH % 512 == 0 && KCH >= 512 && KCH - 256 >= 0, "chunk maps");
    const __amdgpu_buffer_rsrc_t srdV = __builtin_amdgcn_make_buffer_rsrc((void*)Vtp, (short)0, 0x7fffffff, 0x00020000);
    int vvo[NLV];
#pragma unroll
    for (int i = 0; i < NLV; ++i) { const int cc = tid + i * 512; vvo[i] = (cc >> 3) * (KVL * 2) + (cc & 7) * 16; }
    auto gloadV = [&](int t) {
#pragma unroll
        for (int i = 0; i < NLV; ++i) stv[i] = __builtin_amdgcn_raw_buffer_load_b128(srdV, vvo[i], t * 128, 0); };
    auto lstoreV = [&](int t) {
#pragma unroll
        for (int i = 0; i < NLV; ++i) { const int cc = tid + i * 512; *(LAS u32x4*)(lds + OFFV + (t & 1) * VBYTES + (cc >> 3) * VROW + (cc & 7) * 16) = stv[i]; } };
    const int nt = kv_len / 64;
    gloadK(0); gloadV(0); lstoreK(0); lstoreV(1);
    gloadK(1); lstoreK(1);
    __syncthreads();
    f32x16 Sc[2], Sn[2];
    {
        const LAS unsigned char* kb_ = lds + mp * KBYTES + q32 * KROW + h * 16;
#pragma unroll
        for (int kb = 0; kb < 2; ++kb) {
#pragma unroll
            for (int j = 0; j < 16; ++j) Sc[kb][j] = 0.f;
#pragma unroll
            for (int ks = 0; ks < NKS; ++ks) { const bf16x8 a = *(const LAS bf16x8*)(kb_ + kb * 32 * KROW + ks * 32); Sc[kb] = __builtin_amdgcn_mfma_f32_32x32x16_bf16(a, qf[ks], Sc[kb], 0, 0, 0); }
        }
    }
    __syncthreads();
    __builtin_amdgcn_sched_barrier(0);
    asm volatile("s_nop 15\n\ts_nop 15\n\ts_nop 15\n\ts_nop 15\n\ts_nop 15\n\ts_nop 15" ::: "memory");
    __builtin_amdgcn_sched_barrier(0);
    float lm_cur;
    ROWMAX32(lm_cur, Sc[0], Sc[1]);
    bf16x8 Pa[2][2], Pb[2][2];
#pragma unroll
    for (int kb = 0; kb < 2; ++kb)
#pragma unroll
        for (int s = 0; s < 2; ++s)
#pragma unroll
            for (int e = 0; e < 8; ++e) Pa[kb][s][e] = 0;
    auto step = [&](f32x16 (&Sa)[2], f32x16 (&Sb)[2], bf16x8 (&Pp)[2][2], bf16x8 (&Pn)[2][2], int t) {
        const float lm = lm_cur;
        if (t == 0 || __builtin_amdgcn_ballot_w64(lm > 8.f) != 0) {
            const float mx = fmaxf(lm, shx(lm, 32, lane));
            const float delta = (t == 0 || mx > 8.f) ? mx : 0.f;
            const float alpha = t == 0 ? 1.f : fast_exp2(-delta);
            lsum *= alpha;
#pragma unroll
            for (int j = 0; j < 16; ++j) { mneg[j] -= delta; Sa[0][j] -= delta; Sa[1][j] -= delta; }
#pragma unroll
            for (int db = 0; db < NDB; ++db) O[db] *= alpha;
#pragma unroll
            for (int kb = 0; kb < 2; ++kb)
#pragma unroll
                for (int s = 0; s < 2; ++s) { u32x4 w = __builtin_bit_cast(u32x4, Pp[kb][s]);
#pragma unroll
                    for (int e = 0; e < 4; ++e) w[e] = cvt_pk_bf16(__uint_as_float(w[e] << 16) * alpha, __uint_as_float(w[e] & 0xffff0000u) * alpha);
                    Pp[kb][s] = __builtin_bit_cast(bf16x8, w); }
        }
        gloadK(min(t + 2, nt - 1)); gloadV(t);
        const LAS unsigned char* kb_ = lds + ((t + 1) & 1) * KBUF + mp * KBYTES + q32 * KROW + h * 16;
        const LAS unsigned char* vb_ = lds + OFFV + ((t + 1) & 1) * VBYTES + q32 * VROW + h * 16;
        constexpr int NQK = 2 * NKS, NM = NQK + 4 * NDB, NG = NM / 4, PPG = (16 + NG - 2) / (NG - 1);
        static_assert(NM % 4 == 0, "MFMA groups of four");
        bf16x8 fr[2][4];
        float ps0 = 0.f;
        unsigned pk[2][8];
#define ATT_LOADGRP(g) _Pragma("unroll") for (int q_ = 0; q_ < 4; ++q_) { const int i_ = 4 * (g) + q_; \
            fr[(g) & 1][q_] = (i_ < NQK) ? *(const LAS bf16x8*)(kb_ + (i_ / NKS) * 32 * KROW + (i_ % NKS) * 32) \
                                         : *(const LAS bf16x8*)(vb_ + ((i_ - NQK) / 4) * 32 * VROW + (((i_ - NQK) / 2) & 1) * 64 + ((i_ - NQK) & 1) * 32); }
        ATT_LOADGRP(0);
#pragma unroll
        for (int g = 0; g < NG; ++g) {
            if (g + 1 < NG) { ATT_LOADGRP(g + 1); }
#pragma unroll
            for (int q_ = 0; q_ < 4; ++q_) { const int i_ = 4 * g + q_;
                if (i_ < NQK) { const int kb = i_ / NKS, ks = i_ % NKS;
                    if (ks == 0) Sb[kb] = __builtin_amdgcn_mfma_f32_32x32x16_bf16(fr[g & 1][q_], qf[ks], mneg, 0, 0, 0);
                    else Sb[kb] = __builtin_amdgcn_mfma_f32_32x32x16_bf16(fr[g & 1][q_], qf[ks], Sb[kb], 0, 0, 0); }
                else { const int j_ = i_ - NQK, db = j_ / 4, kb = (j_ / 2) & 1, sx = j_ & 1; O[db] = __builtin_amdgcn_mfma_f32_32x32x16_bf16(fr[g & 1][q_], Pp[kb][sx], O[db], 0, 0, 0); } }
#pragma unroll
            for (int pp = g * PPG; pp < (g + 1) * PPG && pp < 16; ++pp) { const int kb = pp / 8, j = pp % 8;
                Sa[kb][2 * j] = fast_exp2(Sa[kb][2 * j]); Sa[kb][2 * j + 1] = fast_exp2(Sa[kb][2 * j + 1]); }
            if (g > 0) {
#pragma unroll
                for (int pp = (g - 1) * PPG; pp < g * PPG && pp < 16; ++pp) { const int kb = pp / 8, j = pp % 8;
                    asm("v_add_f32 %0, %1, %2" : "=v"(ps0) : "v"(ps0), "v"(Sa[kb][2 * j])); asm("v_add_f32 %0, %1, %2" : "=v"(ps0) : "v"(ps0), "v"(Sa[kb][2 * j + 1]));
                    pk[kb][j] = cvt_pk_bf16(Sa[kb][2 * j], Sa[kb][2 * j + 1]); }
            }
            if (g == NG - 2) { lstoreK(t + 2); lstoreV(t); }
            if (g == NG - 1) {
                float lmn;
                ROWMAX32(lmn, Sb[0], Sb[1]);
                lm_cur = lmn;
            }
            __builtin_amdgcn_sched_barrier(0);
        }
#pragma unroll
        for (int pp = (NG - 1) * PPG; pp < 16; ++pp) { const int kb = pp / 8, j = pp % 8;
            asm("v_add_f32 %0, %1, %2" : "=v"(ps0) : "v"(ps0), "v"(Sa[kb][2 * j])); asm("v_add_f32 %0, %1, %2" : "=v"(ps0) : "v"(ps0), "v"(Sa[kb][2 * j + 1]));
            pk[kb][j] = cvt_pk_bf16(Sa[kb][2 * j], Sa[kb][2 * j + 1]); }
#undef ATT_LOADGRP
#pragma unroll
        for (int kb = 0; kb < 2; ++kb) { Pn[kb][0] = __builtin_bit_cast(bf16x8, (u32x4){pk[kb][0], pk[kb][1], pk[kb][2], pk[kb][3]}); Pn[kb][1] = __builtin_bit_cast(bf16x8, (u32x4){pk[kb][4], pk[kb][5], pk[kb][6], pk[kb][7]}); }
        lsum += ps0;
        __syncthreads();
    };
    for (int t = 0; t < nt; t += 2) { step(Sc, Sn, Pa, Pb, t); step(Sn, Sc, Pb, Pa, t + 1); }
    bf16x8 (&pfp)[2][2] = Pa;
    { const LAS unsigned char* vb_ = lds + OFFV + ((nt - 1) & 1) * VBYTES + q32 * VROW + h * 16;
#pragma unroll
      for (int db = 0; db < NDB; ++db)
#pragma unroll
          for (int kb = 0; kb < 2; ++kb)
#pragma unroll
              for (int s = 0; s < 2; ++s) { const bf16x8 a = *(const LAS bf16x8*)(vb_ + db * 32 * VROW + kb * 64 + s * 32); O[db] = __builtin_amdgcn_mfma_f32_32x32x16_bf16(a, pfp[kb][s], O[db], 0, 0, 0); } }
    __syncthreads();
    const int te_ = opaque_tid(), lane_e = te_ & 63, q32e = lane_e & 31, he = lane_e >> 5;
    const float ltot = lsum + shx(lsum, 32, lane_e);
    const float inv = 1.f / ltot;
    bf16_t* orow = outp + (size_t)(qg * 32 + q32e) * DM + 4 * he;
    if constexpr (!DIFF) {
#pragma unroll
        for (int db = 0; db < NDB; ++db)
#pragma unroll
            for (int jj = 0; jj < 4; ++jj) { u32x2 w; w.x = cvt_pk_bf16(O[db][4 * jj] * inv, O[db][4 * jj + 1] * inv); w.y = cvt_pk_bf16(O[db][4 * jj + 2] * inv, O[db][4 * jj + 3] * inv);
                *(u32x2*)(orow + db * 32 + jj * 8) = w; }
    } else {
        LAS float* X = (LAS float*)lds + (qg * 32 + q32e) * 132 + 4 * he;
        if (mp == 1) { float lam_ = lam; asm volatile("" : "+v"(lam_)); const float sc = lam_ * inv;
#pragma unroll
            for (int db = 0; db < NDB; ++db)
#pragma unroll
                for (int jj = 0; jj < 4; ++jj) *(LAS f32x4*)(X + db * 32 + jj * 8) = (f32x4){O[db][4 * jj] * sc, O[db][4 * jj + 1] * sc, O[db][4 * jj + 2] * sc, O[db][4 * jj + 3] * sc}; }
        __syncthreads();
        if (mp == 0) {
            float ss = 0.f;
#pragma unroll
            for (int db = 0; db < NDB; ++db)
#pragma unroll
                for (int jj = 0; jj < 4; ++jj) { const f32x4 x = *(const LAS f32x4*)(X + db * 32 + jj * 8);
#pragma unroll
                    for (int e = 0; e < 4; ++e) { const float o = O[db][4 * jj + e] * inv - x[e]; O[db][4 * jj + e] = o; ss += o * o; } }
            ss += shx(ss, 32, lane_e);
            float li_ = post; asm volatile("" : "+v"(li_));
            const float r = rsqrtf(ss * (1.f / DV) + EPS) * (1.f - li_);
#pragma unroll
            for (int db = 0; db < NDB; ++db)
#pragma unroll
                for (int jj = 0; jj < 4; ++jj) { const f32x4 gsub = *(const f32x4*)(subln + db * 32 + jj * 8 + 4 * he);
                    u32x2 w; w.x = cvt_pk_bf16(O[db][4 * jj] * r * gsub[0], O[db][4 * jj + 1] * r * gsub[1]); w.y = cvt_pk_bf16(O[db][4 * jj + 2] * r * gsub[2], O[db][4 * jj + 3] * r * gsub[3]);
                    *(u32x2*)(orow + db * 32 + jj * 8) = w; }
        }
        __syncthreads();
    }
}

__device__ void phase_attn(const Params& p, int l, bool with_ctx, LAS unsigned char* lds) {
    const float lam_init = 0.8f - 0.6f * expf(-0.3f * (float)l);
    const float* dl = p.diff_lambda + l * 256;
    float s1 = 0.f, s2 = 0.f;
    for (int i = 0; i < 64; ++i) { s1 += dl[i] * dl[64 + i]; s2 += dl[128 + i] * dl[192 + i]; }
    const float lam = __builtin_bit_cast(float, __builtin_amdgcn_readfirstlane(__builtin_bit_cast(int, expf(s1) - expf(s2) + lam_init)));
    const float post_scale = __builtin_bit_cast(float, __builtin_amdgcn_readfirstlane(__builtin_bit_cast(int, 1.f - lam_init)));
    const int total = 3072 + (with_ctx ? 192 : 0);
    for (int u = blockIdx.x; u < total; u += gridDim.x) {
        bool diff; int b, h, row0, kvlen;
        if (u < 2048) { diff = true; const int i = u >> 8, blk = u & 255, bh = i * 8 + (blk & 7), qb = blk >> 3; b = bh >> 2; h = bh & 3; row0 = b * 4096 + qb * 128; kvlen = KVL; }
        else if (u < 3072) { diff = false; const int uu = u - 2048, i = uu >> 8, blk = uu & 255, slot = blk >> 3, bh = i * 16 + 2 * (blk & 7) + (slot >> 4), qb = slot & 15; b = bh >> 2; h = bh & 3; row0 = b * 4096 + qb * 256; kvlen = KVL; }
        else if (u < 3200) { diff = true; const int uu = u - 3072, bh = uu >> 1; b = bh >> 2; h = bh & 3; row0 = NLAT + b * 256 + (uu & 1) * 128; kvlen = CTXL; }
        else { diff = false; const int bh = u - 3200; b = bh >> 2; h = bh & 3; row0 = NLAT + b * 256; kvlen = CTXL; }
        if (diff) attn_unit<64, 128, true>(lds, p.QD + (size_t)row0 * 512 + (2 * h) * 64, 512, p.KD + (size_t)(b * 8 + 2 * h) * KVL * 64, (size_t)KVL * 64, p.VTD + (size_t)(b * 4 + h) * 128 * KVL, kvlen,
                                           p.XN + (size_t)row0 * DM + 512 + h * 128, lam, lam_init, p.diff_subln + l * 128);
        else attn_unit<96, 64, false>(lds, p.QM + (size_t)row0 * 384 + h * 96, 384, p.KM + (size_t)(b * 4 + h) * KVL * 96, 0, p.VTM + (size_t)(b * 4 + h) * 64 * KVL, kvlen,
                                      p.XN + (size_t)row0 * DM + 256 + h * 64, 0.f, 1.f, nullptr);
    }
}

constexpr int NPHASE = 2 + DEPTH * 11;
__device__ __forceinline__ void run_phase(const Params& p, int ph, LAS unsigned char* lds) {
    const int G = (int)gridDim.x, cb = (int)blockIdx.x;
    if (ph == 0) { phase_init(p, lds); return; }
    if (ph == NPHASE - 1) { phase_norm(p.H, p.H, NLAT, p.final_norm, nullptr, 0, 0, nullptr, p.out, nullptr, nullptr, 0.f, nullptr); return; }
    const int l = (ph - 1) / 11, k = (ph - 1) % 11; const bool last = l == DEPTH - 1;
    const float* mods_l = p.MODS + (size_t)l * 17 * 9216;
    const int Mlate = last ? NLAT : NT;
    pg8::StaticOrder S;
    if (k == 0 || k == 3 || k == 8) {
        const float* gw = (k == 0 ? p.ffn1_norm : k == 3 ? p.mix_norm : p.ffn2_norm) + l * DM;
        const int si = k == 8 ? 6 : k;
        const bool first = (l == 0 && k == 0);
        const bool pend = !first && !(k == 8 && last);
        const float* pgate = (k == 0 ? mods_l - 17 * 9216 + 8 * 1024 : k == 3 ? mods_l + 2 * 1024 : mods_l + 5 * 1024) + (size_t)16 * 9216;
        const bool ctx_in = (l == 0 && k <= 3);
        phase_norm(first ? p.x : p.H, ctx_in ? p.ctx - (size_t)NLAT * DM : p.H, k == 8 ? Mlate : NT, gw, mods_l, si, si + 1, p.XN, nullptr, pend ? p.P4 : nullptr, pgate, k == 8 ? 1.f : 0.5f, p.H);
        if (k == 0) phase_convert(p, l, lds);
    } else if (k == 1 || k == 9) {
        pg8::Gemm g{p.XN, k == 1 ? p.Bt13a : p.Bt13b, k == 1 ? NT : Mlate, 2 * DFF, DM, DM};
        S.init(g.M, g.N, G, cb); EpiSwiGLU E{p.G};
        pg8::gemm_phase(lds, g, S, E);
    } else if (k == 2 || k == 7 || k == 10) {
        const int Kf = k == 7 ? DM : DFF;
        const bf16_t* Ap = k == 7 ? p.XN : p.G; const bf16_t* Bp = k == 2 ? p.Bt2a : k == 7 ? p.Btout : p.Bt2b;
        const bool first = (l == 0 && k == 2);
        { pg8::Gemm g{Ap, Bp, NLAT, DM, Kf, Kf};
          S.init(g.M, g.N, G, cb); EpiResid E{first ? p.x : p.H, p.H, p.H, mods_l + (k == 2 ? 2 : k == 7 ? 5 : 8) * 1024, k == 7 ? 1.f : 0.5f};
          pg8::gemm_phase(lds, g, S, E); }
        if (k == 2 || !last) {
            const int kt = Kf / 128, q0 = kt / 4, r0 = kt % 4;
            for (int idx = cb; idx < 256; idx += G) {
                const int unit = idx >> 2, sl = idx & 3;
                const int kb0 = sl * q0 + (sl < r0 ? sl : r0), kl = q0 + (sl < r0 ? 1 : 0);
                pg8::Gemm g{Ap + (size_t)NLAT * Kf + kb0 * 128, Bp + kb0 * 128, NCTX, DM, kl * 128, Kf};
                S.init(g.M, g.N, G, cb); S.fixed = unit;
                EpiPartial E{p.P4 + (size_t)sl * NCTX * DM};
                __syncthreads();
                pg8::gemm_phase(lds, g, S, E);
            }
        }
    } else if (k == 4) {
        pg8::Gemm g{p.XN, p.Btin, NT, 2560, DM, DM};
        S.init(g.M, g.N, G, cb); EpiIn E{p.U, p.CQ, p.CKV, p.SSQ, p.QD, p.KD, p.VTD, p.KM, p.ROPED, p.ROPEM, lds + 131072};
        pg8::gemm_phase(lds, g, S, E);
    } else if (k == 5) {
        { pg8::Gemm g{p.CQ, p.Btuq, NT, 512, 384, 384}; S.init(g.M, g.N, G, cb); EpiQup E{p.SSQ, p.QM, p.ROPEM}; pg8::gemm_phase(lds, g, S, E); }
        { pg8::Gemm g{p.CKV, p.Btukv, NT, 512, 256, 256}; S.init(g.M, g.N, G, (cb + 32) % G); EpiKVup E{p.SSQ, p.KM, p.VTM, lds + 131072}; pg8::gemm_phase(lds, g, S, E); }
        __syncthreads();
        phase_pool(p, l, !last, lds);
    } else if (k == 6) {
        phase_attn(p, l, !last, lds);
    }
}

__device__ __forceinline__ void grid_barrier(unsigned* ctr, unsigned target) {
    asm volatile("s_waitcnt vmcnt(0) lgkmcnt(0)" ::: "memory");
    __syncthreads();
    if (threadIdx.x == 0) {
        __builtin_amdgcn_fence(__ATOMIC_RELEASE, "agent");
        asm volatile("s_waitcnt vmcnt(0)" ::: "memory");
        __hip_atomic_fetch_add(ctr, 1u, __ATOMIC_RELAXED, __HIP_MEMORY_SCOPE_AGENT);
        while (__hip_atomic_load(ctr, __ATOMIC_RELAXED, __HIP_MEMORY_SCOPE_AGENT) < target) __builtin_amdgcn_s_sleep(1);
        __builtin_amdgcn_fence(__ATOMIC_ACQUIRE, "agent");
        asm volatile("s_waitcnt vmcnt(0)" ::: "memory");
    }
    __syncthreads();
}

__global__ __launch_bounds__(512, 2) void hymba_mega(Params p) {
    extern __shared__ __attribute__((aligned(16))) unsigned char smem[];
    LAS unsigned char* lds = (LAS unsigned char*)smem;
    cg::grid_group grid = cg::this_grid();
    unsigned nbar = 0;
    for (int ph = p.ph_lo; ph < p.ph_hi; ++ph) {
        run_phase(p, ph, lds);
        if (ph + 1 < p.ph_hi) {
            if (ph == p.ph_lo) grid.sync();
            else grid_barrier(p.BAR, ++nbar * gridDim.x);
        }
    }
}

extern "C" void kernel_launch(void* const* d_in, const int* in_sizes, int n_in, void* d_out, int out_size, void* d_ws, size_t ws_size, hipStream_t stream) {
    static int grid_blocks = 0;
    if (!grid_blocks) {
        int dev = 0, cus = 0, per_cu = 0;
        hipGetDevice(&dev);
        hipDeviceGetAttribute(&cus, hipDeviceAttributeMultiprocessorCount, dev);
        if (hipFuncSetAttribute((const void*)hymba_mega, hipFuncAttributeMaxDynamicSharedMemorySize, LDS_BYTES) != hipSuccess) fprintf(stderr, "hipFuncSetAttribute failed\n");
        if (hipOccupancyMaxActiveBlocksPerMultiprocessor(&per_cu, (const void*)hymba_mega, 512, LDS_BYTES) != hipSuccess || per_cu < 1) { per_cu = 1; (void)hipGetLastError(); }
        grid_blocks = cus * per_cu;
        if (grid_blocks <= 0) grid_blocks = 256;
    }
    Params p{};
    const float** in = (const float**)&p;
    for (int i = 0; i < 26 && i < n_in; ++i) in[i] = (const float*)d_in[i];
    p.out = (float*)d_out;
    unsigned char* w = (unsigned char*)d_ws; size_t off = 0;
    auto take = [&](size_t bytes) { unsigned char* r = w + off; off += (bytes + 255) & ~(size_t)255; return r; };
    p.H = (float*)take((size_t)NT * DM * 4);
    p.XN = (bf16_t*)take((size_t)NT * DM * 2);
    unsigned char* big = w + off; size_t boff = 0;
    auto takeb = [&](size_t bytes) { unsigned char* r = big + boff; boff += (bytes + 255) & ~(size_t)255; return r; };
    p.U = (float*)takeb((size_t)NT * 256 * 4);
    p.CQ = (bf16_t*)takeb((size_t)NT * 384 * 2);
    p.CKV = (bf16_t*)takeb((size_t)NT * 256 * 2);
    p.SSQ = (float*)takeb((size_t)NT * 16 * 4);
    p.QD = (bf16_t*)takeb((size_t)NT * 512 * 2);
    p.KD = (bf16_t*)takeb((size_t)NB * 8 * KVL * 64 * 2);
    p.VTD = (bf16_t*)takeb((size_t)NB * 4 * 128 * KVL * 2);
    p.QM = (bf16_t*)takeb((size_t)NT * 384 * 2);
    p.KM = (bf16_t*)takeb((size_t)NB * 4 * KVL * 96 * 2);
    p.VTM = (bf16_t*)takeb((size_t)NB * 4 * 64 * KVL * 2);
    p.G = (bf16_t*)big;
    p.P4 = (float*)(big + (((size_t)NT * DFF * 2 + 255) & ~(size_t)255));
    const size_t gbytes = (size_t)NT * DFF * 2;
    off += (boff > gbytes ? boff : gbytes); off = (off + 255) & ~(size_t)255;
    p.Bt13a = (bf16_t*)take((size_t)2 * DFF * DM * 2); p.Bt2a = (bf16_t*)take((size_t)DM * DFF * 2);
    p.Bt13b = (bf16_t*)take((size_t)2 * DFF * DM * 2); p.Bt2b = (bf16_t*)take((size_t)DM * DFF * 2);
    p.Btin = (bf16_t*)take((size_t)2560 * DM * 2); p.Btout = (bf16_t*)take((size_t)DM * DM * 2);
    p.Btuq = (bf16_t*)take((size_t)512 * 384 * 2); p.Btukv = (bf16_t*)take((size_t)512 * 256 * 2); p.Btpool = (bf16_t*)take((size_t)4 * 64 * 64 * 2);
    p.MODS = (float*)take((size_t)DEPTH * 17 * 9216 * 4);
    p.BAR = (unsigned*)take(256);
    p.ROPED = (float*)take((size_t)4096 * 32 * 2 * 4); p.ROPEM = (float*)take((size_t)4096 * 16 * 2 * 4);
    if (off > ws_size) { fprintf(stderr, "kernel_launch: workspace too small: need %zu have %zu\n", off, ws_size); return; }
    (void)hipMemsetAsync(p.BAR, 0, 256, stream);
#if MULTI_LAUNCH
    for (int ph = 0; ph < NPHASE; ++ph) { p.ph_lo = ph; p.ph_hi = ph + 1; hipLaunchKernelGGL(hymba_mega, dim3(grid_blocks), dim3(512), LDS_BYTES, stream, p); }
#else
    p.ph_lo = 0; p.ph_hi = NPHASE;
    void* args[] = {&p};
    hipError_t e = hipLaunchCooperativeKernel((const void*)hymba_mega, dim3(grid_blocks), dim3(512), args, LDS_BYTES, stream);
    if (e != hipSuccess) fprintf(stderr, "cooperative launch failed: %s (grid %d)\n", hipGetErrorString(e), grid_blocks);
#endif
}
```

```cpp
#include <hip/hip_runtime.h>
#include <hip/hip_cooperative_groups.h>
#include <cstdio>
namespace cg = cooperative_groups;

#define LAS __attribute__((address_space(3)))
typedef unsigned short bf16_t;
typedef short bf16x8 __attribute__((ext_vector_type(8)));
typedef float f32x4 __attribute__((ext_vector_type(4)));
typedef float f32x2 __attribute__((ext_vector_type(2)));
typedef unsigned u32x4 __attribute__((ext_vector_type(4)));
typedef unsigned u32x2 __attribute__((ext_vector_type(2)));

constexpr int DM = 1024, NB = 16, SEQ = 4096, DEPTH = 4, CTXL = 256, DFF = 2816;
constexpr int NLAT = NB * SEQ, NCTX = NB * CTXL, NT = NLAT + NCTX, KVL = SEQ + CTXL;
constexpr int INW = 2464;
constexpr float EPS = 1e-6f;
constexpr float LOG2E = 1.4426950408889634f;
constexpr int LDS_BYTES = 131072 + 8 * 3072;
#ifndef MULTI_LAUNCH
#define MULTI_LAUNCH 0
#endif

struct Params {
    const float *x, *c, *ctx, *c_ctx, *w_mod, *b_mod, *ffn1_norm, *ffn1_w1, *ffn1_w3, *ffn1_w2, *mix_norm, *w_in, *w_out, *pool_w, *pool_scale,
        *mla_q_norm, *mla_w_uq, *mla_kv_norm, *mla_w_ukv, *diff_lambda, *diff_subln, *ffn2_norm, *ffn2_w1, *ffn2_w3, *ffn2_w2, *final_norm;
    float* out;
    float* H; bf16_t* XN; bf16_t* G; float* U; bf16_t* CQ; bf16_t* CKV; float* SSQ; bf16_t* QD; bf16_t* KD; bf16_t* VTD; bf16_t* QM; bf16_t* KM; bf16_t* VTM;
    bf16_t *Bt13a, *Bt2a, *Bt13b, *Bt2b, *Btin, *Btout, *Btuq, *Btukv, *Btpool;
    float *MODS, *ROPED, *ROPEM;
    float* P4;
    unsigned* BAR;
    int ph_lo, ph_hi;
};

typedef __bf16 bf16x2_t __attribute__((ext_vector_type(2)));
__device__ __forceinline__ unsigned cvt_pk_bf16(float lo, float hi) { const f32x2 v = {lo, hi}; const bf16x2_t b = __builtin_convertvector(v, bf16x2_t); return __builtin_bit_cast(unsigned, b); }
__device__ __forceinline__ bf16_t f2bf(float v) { return (bf16_t)(cvt_pk_bf16(v, 0.f) & 0xffffu); }
__device__ __forceinline__ int opaque_tid() { int t = threadIdx.x; asm volatile("" : "+v"(t)); return t; }
__device__ __forceinline__ float shx(float v, int mask, int lane) { return __int_as_float(__builtin_amdgcn_ds_bpermute((lane ^ mask) << 2, __float_as_int(v))); }
__device__ __forceinline__ float fast_exp2(float x) { return __builtin_amdgcn_exp2f(x); }
__device__ __forceinline__ float fast_rcp(float x) { return __builtin_amdgcn_rcpf(x); }

namespace pg8 {
constexpr int BM = 256, BK = 64, HALF = 128, HTB = HALF * BK * 2, STAGE_BYTES = 8 * HTB, NXCD = 8, WGM = 4;
__host__ __device__ __forceinline__ int lds_byte(int r, int c) { const int st = (r >> 4) * 2 + (c >> 5), rr = r & 15, cc = c & 31, ob = rr * 64 + cc * 2; return st * 1024 + (ob ^ (((ob >> 9) & 1) << 5)); }
__host__ __device__ __forceinline__ void stage_rc(int b, int& R, int& C) { const int st = b / 1024, sb = b % 1024, swz = sb ^ (((sb >> 9) & 1) << 5); R = (st >> 1) * 16 + swz / 64; C = (st & 1) * 32 + (swz % 64) / 2; }
struct Unit { int pm, pn; };
struct Gemm { const bf16_t* A; const bf16_t* Bt; int M, N, K, ld; };
struct StaticOrder {
    int nM, nN, nwg, G, c, fixed;
    __device__ void init(int M, int N, int G_, int c_) { nM = M / BM; nN = N / BM; nwg = nM * nN; G = G_; c = c_; fixed = -1; }
    __device__ bool next(int i, Unit& u) const {
        if (fixed >= 0) { if (i > 0) return false; u.pm = fixed / nN; u.pn = fixed % nN; return true; }
        const long L = (long)i * G + c; if (L >= nwg) return false;
        int wgid = (int)L; { const int q = nwg / NXCD, r = nwg % NXCD, xcd = wgid % NXCD, off = wgid / NXCD; wgid = (xcd < r ? xcd * (q + 1) : r * (q + 1) + (xcd - r) * q) + off; }
        const int nig = WGM * nN, gid = wgid / nig, fm = gid * WGM, gsz = (nM - fm) < WGM ? (nM - fm) : WGM;
        u.pm = fm + ((wgid % nig) % gsz); u.pn = (wgid % nig) / gsz; return true;
    }
};
template <class Epi>
__device__ __forceinline__ void gemm_phase(LAS unsigned char* lds, const Gemm g, const StaticOrder& S, const Epi& E) {
    const int tid = opaque_tid(), wid = __builtin_amdgcn_readfirstlane(tid >> 6), lane = tid & 63, wr = wid >> 2, wc = wid & 3, fr = lane & 15, fq = lane >> 4;
    const int K = g.K, LD = g.ld, nt = K / BK;
    unsigned voffA[2];
#pragma unroll
    for (int i = 0; i < 2; ++i) { int R, C; stage_rc(tid * 16 + i * 8192, R, C); voffA[i] = (unsigned)(R * LD + C) * 2u; }
    const size_t kstep = (size_t)(BK * 2);
    const size_t hstep = (size_t)HALF * LD * 2;
    const size_t tstep = 2 * hstep;
    const unsigned ldsw = (unsigned)wid * 1024u;
    const int aoff = lds_byte(wr * 64 + fr, fq * 8), boff = lds_byte(wc * 32 + fr, fq * 8);
#define PG8_SA(b, h) (((b) * 2 + (h)) * HTB)
#define PG8_SB(b, h) ((4 + (b) * 2 + (h)) * HTB)
#define PG8_STAGE(bufoff, gbase, voff) do { _Pragma("unroll") for (int _i = 0; _i < 2; ++_i) \
        __builtin_amdgcn_global_load_lds((const unsigned*)((const char*)(gbase) + (voff)[_i]), (LAS unsigned*)(lds + (bufoff) + ldsw + _i * 8192), 16, 0, 0); } while (0)
#define PG8_LDA(dst, b, h) do { _Pragma("unroll") for (int m = 0; m < 4; ++m) _Pragma("unroll") for (int k = 0; k < 2; ++k) dst[m][k] = *(const LAS bf16x8*)(lds + PG8_SA(b, h) + aoff + m * 2048 + k * 1024); } while (0)
#define PG8_LDB(dst, b, h) do { _Pragma("unroll") for (int n = 0; n < 2; ++n) _Pragma("unroll") for (int k = 0; k < 2; ++k) dst[n][k] = *(const LAS bf16x8*)(lds + PG8_SB(b, h) + boff + n * 2048 + k * 1024); } while (0)
#define PG8_MMA(ai, bj, At, Bt) do { __builtin_amdgcn_s_setprio(1); _Pragma("unroll") for (int m = 0; m < 4; ++m) _Pragma("unroll") for (int n = 0; n < 2; ++n) _Pragma("unroll") for (int k = 0; k < 2; ++k) \
        acc[ai][bj][m][n] = __builtin_amdgcn_mfma_f32_16x16x32_bf16(Bt[n][k], At[m][k], acc[ai][bj][m][n], 0, 0, 0); __builtin_amdgcn_s_setprio(0); } while (0)
#define PG8_WAIT_V(n) asm volatile("s_waitcnt vmcnt(" #n ")" ::: "memory")
#define PG8_WAIT_L(n) asm volatile("s_waitcnt lgkmcnt(" #n ")" ::: "memory")
#define PG8_BAR __builtin_amdgcn_s_barrier()
#define PG8_SCHED __builtin_amdgcn_sched_barrier(0)
    Unit cur, nxt; int ui = 0;
    if (!S.next(0, cur)) return;
    f32x4 acc[2][2][4][2];
#pragma unroll
    for (int a = 0; a < 2; ++a)
#pragma unroll
        for (int b = 0; b < 2; ++b)
#pragma unroll
            for (int m = 0; m < 4; ++m)
#pragma unroll
                for (int n = 0; n < 2; ++n) acc[a][b][m][n] = (f32x4){0.f, 0.f, 0.f, 0.f};
    bf16x8 At[4][2], B0[2][2], B1[2][2];
    const char* cA = (const char*)g.A + (size_t)cur.pm * tstep; const char* cB = (const char*)g.Bt + (size_t)cur.pn * tstep;
    PG8_STAGE(PG8_SB(0, 0), cB, voffA); PG8_STAGE(PG8_SA(0, 0), cA, voffA); PG8_STAGE(PG8_SB(0, 1), cB + hstep, voffA); PG8_STAGE(PG8_SA(0, 1), cA + hstep, voffA);
    if (wr == 1) PG8_BAR;
    PG8_WAIT_V(4); PG8_BAR;
    PG8_STAGE(PG8_SB(1, 0), cB + kstep, voffA); PG8_STAGE(PG8_SA(1, 0), cA + kstep, voffA); PG8_STAGE(PG8_SB(1, 1), cB + hstep + kstep, voffA);
    PG8_WAIT_V(6); PG8_BAR;
    for (;;) {
        const bool has_next = S.next(ui + 1, nxt);
        const char* nA = has_next ? (const char*)g.A + (size_t)nxt.pm * tstep : cA; const char* nB = has_next ? (const char*)g.Bt + (size_t)nxt.pn * tstep : cB;
        for (int t = 0; t < nt; t += 2) {
            const bool last = (t == nt - 2);
            const char* a1 = cA + (size_t)(t + 1) * kstep;
            const char* a2 = last ? nA : cA + (size_t)(t + 2) * kstep; const char* b2 = last ? nB : cB + (size_t)(t + 2) * kstep;
            const char* a3 = a2 + kstep; const char* b3 = b2 + kstep;
            PG8_LDB(B0, 0, 0); PG8_SCHED; PG8_LDA(At, 0, 0); PG8_STAGE(PG8_SA(1, 1), a1 + hstep, voffA);
            PG8_WAIT_L(8); PG8_BAR; PG8_WAIT_L(0); PG8_MMA(0, 0, At, B0); PG8_BAR; PG8_SCHED;
            PG8_LDB(B1, 0, 1); PG8_STAGE(PG8_SB(0, 0), b2, voffA);
            PG8_BAR; PG8_WAIT_L(0); PG8_MMA(0, 1, At, B1); PG8_BAR;
            PG8_LDA(At, 0, 1); PG8_STAGE(PG8_SA(0, 0), a2, voffA);
            PG8_BAR; PG8_WAIT_L(0); PG8_MMA(1, 0, At, B0); PG8_BAR; PG8_SCHED;
            PG8_STAGE(PG8_SB(0, 1), b2 + hstep, voffA);
            PG8_WAIT_V(6); PG8_BAR; PG8_MMA(1, 1, At, B1); PG8_BAR;
            PG8_LDB(B0, 1, 0); PG8_SCHED; PG8_LDA(At, 1, 0); PG8_STAGE(PG8_SA(0, 1), a2 + hstep, voffA);
            PG8_WAIT_L(8); PG8_BAR; PG8_WAIT_L(0); PG8_MMA(0, 0, At, B0); PG8_BAR; PG8_SCHED;
            PG8_LDB(B1, 1, 1); PG8_STAGE(PG8_SB(1, 0), b3, voffA);
            PG8_BAR; PG8_WAIT_L(0); PG8_MMA(0, 1, At, B1); PG8_BAR;
            PG8_LDA(At, 1, 1); PG8_STAGE(PG8_SA(1, 0), a3, voffA);
            PG8_BAR; PG8_WAIT_L(0); PG8_MMA(1, 0, At, B0); PG8_BAR; PG8_SCHED;
            PG8_STAGE(PG8_SB(1, 1), b3 + hstep, voffA);
            PG8_WAIT_V(6); PG8_BAR; PG8_MMA(1, 1, At, B1); PG8_BAR;
        }
        E(acc, cur, wr, wc, fr, fq);
        if (!has_next) break;
#pragma unroll
        for (int a = 0; a < 2; ++a)
#pragma unroll
            for (int b = 0; b < 2; ++b)
#pragma unroll
                for (int m = 0; m < 4; ++m)
#pragma unroll
                    for (int n = 0; n < 2; ++n) acc[a][b][m][n] = (f32x4){0.f, 0.f, 0.f, 0.f};
        cur = nxt; cA = nA; cB = nB; ++ui;
    }
    PG8_WAIT_V(0);
    if (wr == 0) PG8_BAR;
    PG8_BAR;
#undef PG8_SA
#undef PG8_SB
#undef PG8_STAGE
#undef PG8_LDA
#undef PG8_LDB
#undef PG8_MMA
#undef PG8_WAIT_V
#undef PG8_WAIT_L
#undef PG8_BAR
#undef PG8_SCHED
}
}
using pg8::Unit;

__device__ __forceinline__ int slot_of_L(int L) { return (((L >> 3) & 1) << 7) | (((L >> 6) & 3) << 5) | (((L >> 2) & 1) << 4) | (((L >> 4) & 3) << 2) | (L & 3); }
__device__ __forceinline__ int rope_lambda(int dd, int half) { const int hf = dd / half, i = dd % half; return 16 * (i >> 3) + 8 * hf + (i & 7); }
__device__ __forceinline__ int keypos_of(int key) { return (key & ~12) | ((key & 4) << 1) | ((key & 8) >> 1); }
enum { KNAT = 0, KSWI = 1, KIN = 2, KUQ = 3, KUKV = 4 };
__device__ __forceinline__ int dstrow(int kind, int which, int c) {
    if (kind == KNAT) return c;
    if (kind == KSWI) { const int pn = c >> 7, cg = c & 127; return pn * 256 + ((((cg >> 2) & 1) << 7) | (((cg >> 5) & 3) << 5) | (which << 4) | (((cg >> 3) & 3) << 2) | (cg & 3)); }
    if (kind == KIN) {
        int tile, L;
        if (c < 256) { tile = 0; L = c; }
        else if (c < 640) { const int q = c - 256; tile = 1 + (q >> 8); L = q & 255; }
        else if (c < 896) { tile = 3; L = c - 640; }
        else if (c < 928) { tile = 2; L = 128 + rope_lambda(c - 896, 16); }
        else if (c < 1952) { int qq = c - 928; const int isk = qq >= 512 ? 1 : 0; qq &= 511; const int hd = qq >> 6; tile = 4 + 2 * isk + (hd >> 2); L = 64 * (hd & 3) + rope_lambda(qq & 63, 32); }
        else { const int vv = c - 1952; tile = 8 + (vv >> 8); L = vv & 255; }
        return tile * 256 + slot_of_L(L);
    }
    if (kind == KUQ) { const int head = c / 96, dd = c % 96; const int Lh = dd < 64 ? dd : 64 + rope_lambda(dd - 64, 16); const int L = 128 * (head & 1) + Lh; return (head >> 1) * 256 + slot_of_L(L); }
      { const int head = c >> 7, dd = c & 127; const int tile = dd >> 6; const int L = 64 * head + (dd & 63); return tile * 256 + slot_of_L(L); }
}

struct EpiSwiGLU {
    bf16_t* __restrict__ G;
    __device__ __forceinline__ void operator()(const f32x4 (&acc)[2][2][4][2], const Unit& u, int wr, int wc, int fr_, int fq_) const {
        const int tq_ = opaque_tid(); const int fr = tq_ & 15, fq = (tq_ >> 4) & 3; (void)fr_; (void)fq_;
        const int row0 = u.pm * 256 + wr * 64 + fr, col0 = u.pn * 128 + wc * 32 + fq * 8;
#pragma unroll
        for (int ai = 0; ai < 2; ++ai)
#pragma unroll
            for (int m = 0; m < 4; ++m) {
                float o[8];
#pragma unroll
                for (int bj = 0; bj < 2; ++bj)
#pragma unroll
                    for (int j = 0; j < 4; ++j) { const float a = acc[ai][bj][m][0][j], b = acc[ai][bj][m][1][j]; o[bj * 4 + j] = a * fast_rcp(1.f + fast_exp2(-a * LOG2E)) * b; }
                u32x4 w; w.x = cvt_pk_bf16(o[0], o[1]); w.y = cvt_pk_bf16(o[2], o[3]); w.z = cvt_pk_bf16(o[4], o[5]); w.w = cvt_pk_bf16(o[6], o[7]);
                *(u32x4*)(G + (size_t)(row0 + ai * 128 + m * 16) * DFF + col0) = w;
            }
    }
};
struct EpiResid {
    const float* Hin; const float* Hin_ctx; float* Hout; const float* gate_l; float sc;
    __device__ __forceinline__ void operator()(const f32x4 (&acc)[2][2][4][2], const Unit& u, int wr, int wc, int fr_, int fq_) const {
        const int tq_ = opaque_tid(); const int fr = tq_ & 15, fq = (tq_ >> 4) & 3; (void)fr_; (void)fq_;
        const int bi = u.pm < 256 ? (u.pm >> 4) : 16;
        const int row0 = u.pm * 256 + wr * 64 + fr, col0 = u.pn * 256 + wc * 32 + 4 * fq;
        const float* gate = gate_l + (size_t)bi * 9216 + col0;
        const float* hin = u.pm < 256 ? Hin : Hin_ctx;
        f32x4 gv[2][2];
#pragma unroll
        for (int bj = 0; bj < 2; ++bj)
#pragma unroll
            for (int n = 0; n < 2; ++n) gv[bj][n] = *(const f32x4*)(gate + bj * 128 + n * 16) * sc;
        f32x4 hb[4][2][2];
#define RES_LOAD(g_, st_) { const size_t base_ = (size_t)(row0 + ((g_) >> 2) * 128 + ((g_) & 3) * 16) * DM + col0; \
            _Pragma("unroll") for (int bj = 0; bj < 2; ++bj) _Pragma("unroll") for (int n = 0; n < 2; ++n) hb[st_][bj][n] = *(const f32x4*)(hin + base_ + bj * 128 + n * 16); }
        RES_LOAD(0, 0); RES_LOAD(1, 1); RES_LOAD(2, 2);
#pragma unroll
        for (int g = 0; g < 8; ++g) {
            if (g + 3 < 8) { RES_LOAD(g + 3, (g + 3) & 3); }
            const int ai = g >> 2, m = g & 3;
            const size_t base = (size_t)(row0 + ai * 128 + m * 16) * DM + col0;
#pragma unroll
            for (int bj = 0; bj < 2; ++bj)
#pragma unroll
                for (int n = 0; n < 2; ++n) *(f32x4*)(Hout + base + bj * 128 + n * 16) = hb[g & 3][bj][n] + gv[bj][n] * acc[ai][bj][m][n];
        }
#undef RES_LOAD
    }
};
struct EpiPartial {
    float* __restrict__ P;
    __device__ __forceinline__ void operator()(const f32x4 (&acc)[2][2][4][2], const Unit& u, int wr, int wc, int fr_, int fq_) const {
        const int tq_ = opaque_tid(); const int fr = tq_ & 15, fq = (tq_ >> 4) & 3; (void)fr_; (void)fq_;
        const int row0 = u.pm * 256 + wr * 64 + fr, col0 = u.pn * 256 + wc * 32 + 4 * fq;
#pragma unroll
        for (int ai = 0; ai < 2; ++ai)
#pragma unroll
            for (int m = 0; m < 4; ++m) {
                float* hp = P + (size_t)(row0 + ai * 128 + m * 16) * DM + col0;
#pragma unroll
                for (int bj = 0; bj < 2; ++bj)
#pragma unroll
                    for (int n = 0; n < 2; ++n) *(f32x4*)(hp + bj * 128 + n * 16) = acc[ai][bj][m][n];
            }
    }
};
__device__ __forceinline__ void store16bf(bf16_t* dst, const float (&v)[16]) {
    u32x4 w0, w1;
    w0.x = cvt_pk_bf16(v[0], v[1]); w0.y = cvt_pk_bf16(v[2], v[3]); w0.z = cvt_pk_bf16(v[4], v[5]); w0.w = cvt_pk_bf16(v[6], v[7]);
    w1.x = cvt_pk_bf16(v[8], v[9]); w1.y = cvt_pk_bf16(v[10], v[11]); w1.z = cvt_pk_bf16(v[12], v[13]); w1.w = cvt_pk_bf16(v[14], v[15]);
    *(u32x4*)dst = w0; *(u32x4*)(dst + 8) = w1;
}
__device__ __forceinline__ void rope16(float (&v)[16], const float* tab) {
#pragma unroll
    for (int q = 0; q < 4; ++q) {
        const f32x4 cs = *(const f32x4*)(tab + q * 4);
        { const float x1 = v[2 * q], x2 = v[8 + 2 * q]; v[2 * q] = x1 * cs[0] - x2 * cs[1]; v[8 + 2 * q] = x1 * cs[1] + x2 * cs[0]; }
        { const float x1 = v[2 * q + 1], x2 = v[9 + 2 * q]; v[2 * q + 1] = x1 * cs[2] - x2 * cs[3]; v[9 + 2 * q] = x1 * cs[3] + x2 * cs[2]; }
    }
}
__device__ __forceinline__ void store_vt(LAS unsigned char* tw, const float (&v)[16], int fr, int fq, bf16_t* vt) {
    const int pos = ((fr & 4) << 1) | ((fr & 8) >> 1) | (fr & 3);
#pragma unroll
    for (int e = 0; e < 16; ++e) *(LAS bf16_t*)(tw + (16 * fq + e) * 48 + pos * 2) = f2bf(v[e]);
    const int lane = fq * 16 + fr;
#pragma unroll
    for (int i = 0; i < 2; ++i) { const int ch = lane + 64 * i, col = ch >> 1, half = ch & 1;
        const u32x4 w = *(const LAS u32x4*)(tw + col * 48 + half * 16);
        *(u32x4*)(vt + (size_t)col * KVL + half * 8) = w; }
}
struct EpiIn {
    float* __restrict__ U; bf16_t* __restrict__ CQ; bf16_t* __restrict__ CKV; float* __restrict__ SSQ; bf16_t* __restrict__ QD; bf16_t* __restrict__ KD; bf16_t* __restrict__ VTD; bf16_t* __restrict__ KM; const float* __restrict__ ROPED; const float* __restrict__ ROPEM; LAS unsigned char* tl;
    __device__ __forceinline__ void operator()(const f32x4 (&acc)[2][2][4][2], const Unit& u, int wr, int wc, int fr_, int fq_) const {
        const int tq_ = opaque_tid(); const int fr = tq_ & 15, fq = (tq_ >> 4) & 3; (void)fr_; (void)fq_;
        const int pn = u.pn, L0 = 64 * wc + 16 * fq;
#pragma unroll
        for (int ai = 0; ai < 2; ++ai)
#pragma unroll
            for (int m = 0; m < 4; ++m) {
                const int row = u.pm * 256 + ai * 128 + wr * 64 + m * 16 + fr;
                const bool lat = u.pm < 256;
                const int b = lat ? (row >> 12) : ((row - NLAT) >> 8);
                const int key = lat ? (CTXL + (row & 4095)) : ((row - NLAT) & 255);
                const int pos = row & 4095;
                float v[16];
#pragma unroll
                for (int bj = 0; bj < 2; ++bj)
#pragma unroll
                    for (int n = 0; n < 2; ++n)
#pragma unroll
                        for (int j = 0; j < 4; ++j) v[8 * bj + 4 * n + j] = acc[ai][bj][m][n][j];
                if (pn == 0) {
                    float* d = U + (size_t)row * 256 + L0;
#pragma unroll
                    for (int q = 0; q < 4; ++q) *(f32x4*)(d + 4 * q) = (f32x4){v[4 * q], v[4 * q + 1], v[4 * q + 2], v[4 * q + 3]};
                } else if (pn <= 3) {
                    if (pn == 2 && wc >= 2) {
                        if (wc == 2 && fq < 2) {
                            if (lat) rope16(v, ROPEM + ((size_t)pos * 16 + 8 * fq) * 2);
#pragma unroll
                            for (int h = 0; h < 4; ++h) store16bf(KM + ((size_t)(b * 4 + h) * KVL + key) * 96 + 64 + 16 * fq, v);
                        }
                    } else {
                        float s = 0.f;
#pragma unroll
                        for (int e = 0; e < 16; ++e) s += v[e] * v[e];
                        { const int ln = fq * 16 + fr; s += shx(s, 16, ln); s += shx(s, 32, ln); }
                        if (pn < 3) { store16bf(CQ + (size_t)row * 384 + (pn - 1) * 256 + L0, v); if (fq == 0) SSQ[(size_t)row * 16 + (pn - 1) * 4 + wc] = s; }
                        else { store16bf(CKV + (size_t)row * 256 + L0, v); if (fq == 0) SSQ[(size_t)row * 16 + 8 + wc] = s; }
                    }
                } else if (pn <= 7) {
                    const int hd = 4 * ((pn - 4) & 1) + wc;
                    if (lat) rope16(v, ROPED + ((size_t)pos * 32 + 8 * fq) * 2);
                    if (pn <= 5) {
                        const float qs = 0.125f * LOG2E;
#pragma unroll
                        for (int e = 0; e < 16; ++e) v[e] *= qs;
                        store16bf(QD + (size_t)row * 512 + hd * 64 + 16 * fq, v);
                    } else store16bf(KD + ((size_t)(b * 8 + hd) * KVL + key) * 64 + 16 * fq, v);
                } else {
                    const int h = 2 * (pn - 8) + (wc >> 1);
                    store_vt(tl + (wr * 4 + wc) * 3072, v, fr, fq, VTD + ((size_t)(b * 4 + h) * 128 + 64 * (wc & 1)) * KVL + (key - fr));
                }
            }
    }
};
struct EpiQup {
    const float* __restrict__ SSQ; bf16_t* __restrict__ QM; const float* __restrict__ ROPEM;
    __device__ __forceinline__ void operator()(const f32x4 (&acc)[2][2][4][2], const Unit& u, int wr, int wc, int fr_, int fq_) const {
        const int tq_ = opaque_tid(); const int fr = tq_ & 15, fq = (tq_ >> 4) & 3; (void)fr_; (void)fq_;
        const int head = 2 * u.pn + (wc >> 1), part = wc & 1;
        if (part == 1 && fq >= 2) return;
#pragma unroll
        for (int ai = 0; ai < 2; ++ai)
#pragma unroll
            for (int m = 0; m < 4; ++m) {
                const int row = u.pm * 256 + ai * 128 + wr * 64 + m * 16 + fr;
                const f32x4 s4 = *(const f32x4*)(SSQ + (size_t)row * 16); const f32x2 s2 = *(const f32x2*)(SSQ + (size_t)row * 16 + 4);
                const float ss = (s4[0] + s4[1]) + (s4[2] + s4[3]) + (s2[0] + s2[1]);
                const float sc = rsqrtf(ss * (1.f / 384.f) + EPS) * (0.10206207261596577f * LOG2E);
                float v[16];
#pragma unroll
                for (int bj = 0; bj < 2; ++bj)
#pragma unroll
                    for (int n = 0; n < 2; ++n)
#pragma unroll
                        for (int j = 0; j < 4; ++j) v[8 * bj + 4 * n + j] = acc[ai][bj][m][n][j] * sc;
                if (part == 1 && u.pm < 256) rope16(v, ROPEM + ((size_t)(row & 4095) * 16 + 8 * fq) * 2);
                store16bf(QM + (size_t)row * 384 + head * 96 + 64 * part + 16 * fq, v);
            }
    }
};
struct EpiKVup {
    const float* __restrict__ SSQ; bf16_t* __restrict__ KM; bf16_t* __restrict__ VTM; LAS unsigned char* tl;
    __device__ __forceinline__ void operator()(const f32x4 (&acc)[2][2][4][2], const Unit& u, int wr, int wc, int fr_, int fq_) const {
        const int tq_ = opaque_tid(); const int fr = tq_ & 15, fq = (tq_ >> 4) & 3; (void)fr_; (void)fq_;
#pragma unroll
        for (int ai = 0; ai < 2; ++ai)
#pragma unroll
            for (int m = 0; m < 4; ++m) {
                const int row = u.pm * 256 + ai * 128 + wr * 64 + m * 16 + fr;
                const bool lat = u.pm < 256;
                const int b = lat ? (row >> 12) : ((row - NLAT) >> 8);
                const int key = lat ? (CTXL + (row & 4095)) : ((row - NLAT) & 255);
                const f32x4 s4 = *(const f32x4*)(SSQ + (size_t)row * 16 + 8);
                const float sc = rsqrtf(((s4[0] + s4[1]) + (s4[2] + s4[3])) * (1.f / 256.f) + EPS);
                float v[16];
#pragma unroll
                for (int bj = 0; bj < 2; ++bj)
#pragma unroll
                    for (int n = 0; n < 2; ++n)
#pragma unroll
                        for (int j = 0; j < 4; ++j) v[8 * bj + 4 * n + j] = acc[ai][bj][m][n][j] * sc;
                if (u.pn == 0) store16bf(KM + ((size_t)(b * 4 + wc) * KVL + key) * 96 + 16 * fq, v);
                else {
                    store_vt(tl + (wr * 4 + wc) * 3072, v, fr, fq, VTM + ((size_t)(b * 4 + wc) * 64) * KVL + (key - fr));
                }
            }
    }
};

__constant__ float c_invfreq[24] = {1.000000000e+00f, 5.623413324e-01f, 3.162277639e-01f, 1.778279394e-01f, 1.000000015e-01f, 5.623413250e-02f, 3.162277490e-02f, 1.778279431e-02f, 9.999999776e-03f, 5.623413250e-03f, 3.162277630e-03f, 1.778279431e-03f, 1.000000047e-03f, 5.623413017e-04f, 3.162277571e-04f, 1.778279402e-04f, 1.000000000e+00f, 3.162277639e-01f, 1.000000015e-01f, 3.162277490e-02f, 9.999999776e-03f, 3.162277630e-03f, 1.000000047e-03f, 3.162277571e-04f};
__device__ void phase_init(const Params& p, LAS unsigned char* lds) {
    const int tid = opaque_tid();
    const size_t gtid = (size_t)blockIdx.x * 512 + tid, gsz = (size_t)gridDim.x * 512;
    for (size_t i = gtid; i < (size_t)4096 * 48; i += gsz) {
        int pos, a, use_row; float* dst;
        if (i < (size_t)4096 * 32) { pos = (int)(i >> 5); const int ii = (int)(i & 31); a = ii & 15; use_row = ii < 16; dst = p.ROPED + 2 * i; }
        else { const size_t j = i - (size_t)4096 * 32; pos = (int)(j >> 4); const int ii = (int)(j & 15); a = 16 + (ii & 7); use_row = ii < 8; dst = p.ROPEM + 2 * j; }
        const float ang = (float)(use_row ? (pos >> 6) : (pos & 63)) * c_invfreq[a];
        const float kq = rintf(ang * 0.636619772f);
        float r = fmaf(-kq, 1.570770263671875f, ang); r = fmaf(-kq, 2.6063062250614166e-05f, r); r = fmaf(-kq, 6.077094383272197e-11f, r);
        const float r2 = r * r;
        const float sn = r * (1.f + r2 * (-1.6666667e-1f + r2 * (8.3333333e-3f + r2 * (-1.9841270e-4f + r2 * 2.7557319e-6f))));
        const float cs = 1.f + r2 * (-0.5f + r2 * (4.1666667e-2f + r2 * (-1.3888889e-3f + r2 * (2.4801587e-5f + r2 * (-2.7557319e-7f)))));
        const int qd = ((int)kq) & 3;
        dst[0] = qd == 0 ? cs : qd == 1 ? -sn : qd == 2 ? -cs : sn;
        dst[1] = qd == 0 ? sn : qd == 1 ? cs : qd == 2 ? -sn : -cs;
    }
    LAS float* sct = (LAS float*)lds;
    LAS float* red = (LAS float*)(lds + 81920);
    for (int i = tid; i < 17 * 1024; i += 512) { const int bi = i >> 10, k = i & 1023; const float cv = bi < 16 ? p.c[bi * 1024 + k] : p.c_ctx[k]; sct[k * 20 + bi] = cv / (1.f + __expf(-cv)); }
    __syncthreads();
    const int col = tid & 127, kg = tid >> 7;
    for (int u = blockIdx.x; u < DEPTH * 72; u += gridDim.x) {
        const int l = u / 72, n0 = (u % 72) * 128;
        const float* w = p.w_mod + (size_t)l * 1024 * 9216 + n0 + col;
        float a[17];
#pragma unroll
        for (int q = 0; q < 17; ++q) a[q] = 0.f;
#pragma unroll 4
        for (int k = kg * 256; k < kg * 256 + 256; ++k) {
            const float wv = w[(size_t)k * 9216];
            const f32x4 s0 = *(const LAS f32x4*)(sct + k * 20), s1 = *(const LAS f32x4*)(sct + k * 20 + 4), s2 = *(const LAS f32x4*)(sct + k * 20 + 8), s3 = *(const LAS f32x4*)(sct + k * 20 + 12);
            const float s16 = sct[k * 20 + 16];
#pragma unroll
            for (int q = 0; q < 4; ++q) { a[q] += s0[q] * wv; a[4 + q] += s1[q] * wv; a[8 + q] += s2[q] * wv; a[12 + q] += s3[q] * wv; }
            a[16] += s16 * wv;
        }
#pragma unroll
        for (int q = 0; q < 17; ++q) red[(kg * 17 + q) * 128 + col] = a[q];
        __syncthreads();
        for (int i = tid; i < 17 * 128; i += 512) { const int bi = i >> 7, cc = i & 127;
            const float s = (red[(0 * 17 + bi) * 128 + cc] + red[(1 * 17 + bi) * 128 + cc]) + (red[(2 * 17 + bi) * 128 + cc] + red[(3 * 17 + bi) * 128 + cc]);
            p.MODS[((size_t)l * 17 + bi) * 9216 + n0 + cc] = s + p.b_mod[(size_t)l * 9216 + n0 + cc]; }
        __syncthreads();
    }
}

__device__ void phase_norm(const float* H, const float* Hctx, int nrows, const float* gw, const float* mods_l, int shift_idx, int scale_idx, bf16_t* outb, float* outf,
                           const float* P4, const float* pgate, float psc, float* Hw) {
    const int tid = opaque_tid(); const int wid = tid >> 6, lane = tid & 63;
    for (int row = blockIdx.x * 8 + wid; row < nrows; row += gridDim.x * 8) {
        const float* hr = (row < NLAT ? H : Hctx) + (size_t)row * DM + lane * 4;
        f32x4 v[4]; float ss = 0.f;
#pragma unroll
        for (int q = 0; q < 4; ++q) v[q] = *(const f32x4*)(hr + q * 256);
        if (P4 && row >= NLAT) {
            const float* pr = P4 + (size_t)(row - NLAT) * DM + lane * 4;
#pragma unroll
            for (int q = 0; q < 4; ++q) { const f32x4 s4 = (*(const f32x4*)(pr + q * 256) + *(const f32x4*)(pr + (size_t)NCTX * DM + q * 256)) + (*(const f32x4*)(pr + (size_t)2 * NCTX * DM + q * 256) + *(const f32x4*)(pr + (size_t)3 * NCTX * DM + q * 256));
                v[q] += (*(const f32x4*)(pgate + lane * 4 + q * 256) * psc) * s4; *(f32x4*)(Hw + (size_t)row * DM + lane * 4 + q * 256) = v[q]; }
        }
#pragma unroll
        for (int q = 0; q < 4; ++q) ss += (v[q][0] * v[q][0] + v[q][1] * v[q][1]) + (v[q][2] * v[q][2] + v[q][3] * v[q][3]);
        ss += __builtin_bit_cast(float, __builtin_amdgcn_update_dpp(0, __builtin_bit_cast(int, ss), 0xB1, 0xF, 0xF, true));
        ss += __builtin_bit_cast(float, __builtin_amdgcn_update_dpp(0, __builtin_bit_cast(int, ss), 0x4E, 0xF, 0xF, true));
        ss += __builtin_bit_cast(float, __builtin_amdgcn_update_dpp(0, __builtin_bit_cast(int, ss), 0x141, 0xF, 0xF, true));
        ss += __builtin_bit_cast(float, __builtin_amdgcn_update_dpp(0, __builtin_bit_cast(int, ss), 0x140, 0xF, 0xF, true));
        ss += shx(ss, 16, lane); ss += shx(ss, 32, lane);
        const float rstd = rsqrtf(ss * (1.f / DM) + EPS);
        if (outb) {
            const int bi = row < NLAT ? (row >> 12) : 16;
            const float* sh = mods_l + (size_t)bi * 9216 + shift_idx * 1024 + lane * 4; const float* sc = mods_l + (size_t)bi * 9216 + scale_idx * 1024 + lane * 4;
#pragma unroll
            for (int q = 0; q < 4; ++q) {
                const f32x4 g = *(const f32x4*)(gw + lane * 4 + q * 256), s = *(const f32x4*)(sc + q * 256), t = *(const f32x4*)(sh + q * 256);
                const f32x4 y = (v[q] * rstd * g) * (s + 1.f) + t;
                u32x2 w; w.x = cvt_pk_bf16(y[0], y[1]); w.y = cvt_pk_bf16(y[2], y[3]);
                *(u32x2*)(outb + (size_t)row * DM + lane * 4 + q * 256) = w;
            }
        } else {
#pragma unroll
            for (int q = 0; q < 4; ++q) { const f32x4 g = *(const f32x4*)(gw + lane * 4 + q * 256); *(f32x4*)(outf + (size_t)row * DM + lane * 4 + q * 256) = v[q] * rstd * g; }
        }
    }
}

__device__ void phase_convert(const Params& p, int l, LAS unsigned char* lds) {
    LAS float* tile = (LAS float*)lds;
    const int tid = opaque_tid();
    for (int u = blockIdx.x; u < 5176; u += gridDim.x) {
        const float* src; int Nsrc, K; bf16_t* dst; int kind = KNAT, which = 0; const float* ksc = nullptr; int t = u;
        if (t < 4224) { const int j = t / 704; t %= 704; const int f = j / 3, mm = j % 3;
            if (mm < 2) { src = (f ? (mm ? p.ffn2_w3 : p.ffn2_w1) : (mm ? p.ffn1_w3 : p.ffn1_w1)) + (size_t)l * DM * DFF; Nsrc = DFF; K = DM; dst = f ? p.Bt13b : p.Bt13a; kind = KSWI; which = mm; }
            else { src = (f ? p.ffn2_w2 : p.ffn1_w2) + (size_t)l * DFF * DM; Nsrc = DM; K = DFF; dst = f ? p.Bt2b : p.Bt2a; } }
        else if ((t -= 4224) < 624) { src = p.w_in + (size_t)l * DM * INW; Nsrc = INW; K = DM; dst = p.Btin; kind = KIN; }
        else if ((t -= 624) < 256) { src = p.w_out + (size_t)l * DM * DM; Nsrc = DM; K = DM; dst = p.Btout; }
        else if ((t -= 256) < 36) { src = p.mla_w_uq + (size_t)l * 384 * 384; Nsrc = 384; K = 384; dst = p.Btuq; kind = KUQ; ksc = p.mla_q_norm + l * 384; }
        else if ((t -= 36) < 32) { src = p.mla_w_ukv + (size_t)l * 256 * 512; Nsrc = 512; K = 256; dst = p.Btukv; kind = KUKV; ksc = p.mla_kv_norm + l * 256; }
        else { t -= 32; src = p.pool_w + (size_t)(l * 4 + t) * 4096; Nsrc = 64; K = 64; dst = p.Btpool + t * 4096; t = 0; }
        const int nkt = K / 64; const int c0 = (t / nkt) * 64, k0 = (t % nkt) * 64;
        { const int cl = tid & 63, ks = tid >> 6; const int c = c0 + cl;
#pragma unroll
          for (int kk = 0; kk < 8; ++kk) { const int k = ks + 8 * kk; tile[k * 65 + cl] = c < Nsrc ? src[(size_t)(k0 + k) * Nsrc + c] : 0.f; } }
        __syncthreads();
        { const int cl = tid >> 3, kseg = tid & 7; const int c = c0 + cl;
          if (c < Nsrc) { const int row = dstrow(kind, which, c); float v[8];
#pragma unroll
              for (int i = 0; i < 8; ++i) v[i] = tile[(kseg * 8 + i) * 65 + cl] * (ksc ? ksc[k0 + kseg * 8 + i] : 1.f);
              u32x4 w; w.x = cvt_pk_bf16(v[0], v[1]); w.y = cvt_pk_bf16(v[2], v[3]); w.z = cvt_pk_bf16(v[4], v[5]); w.w = cvt_pk_bf16(v[6], v[7]);
              *(u32x4*)(dst + (size_t)row * K + k0 + kseg * 8) = w; } }
        __syncthreads();
    }
}

template <int K> __device__ __forceinline__ void win_sum(const float* base, size_t stride, int cnt, f32x4& s0, f32x4& s1) {
    f32x4 v0[K], v1[K];
#pragma unroll
    for (int i = 0; i < K; ++i) { const float* q = base + (size_t)min(i, cnt - 1) * stride; v0[i] = *(const f32x4*)q; v1[i] = *(const f32x4*)(q + 4); }
#pragma unroll
    for (int i = 0; i < K; ++i) { const float w = i < cnt ? 1.f : 0.f; s0 += v0[i] * w; s1 += v1[i] * w; }
}
__device__ __forceinline__ void win_sum_g(int g, const float* base, size_t stride, int cnt, f32x4& s0, f32x4& s1) {
    if (g == 0) win_sum<2>(base, stride, cnt, s0, s1); else if (g == 1) win_sum<4>(base, stride, cnt, s0, s1); else if (g == 2) win_sum<8>(base, stride, cnt, s0, s1); else win_sum<16>(base, stride, cnt, s0, s1);
}
__device__ void phase_pool(const Params& p, int l, bool with_ctx, LAS unsigned char* lds) {
    LAS float* V = (LAS float*)lds;
    LAS bf16_t* Dm = (LAS bf16_t*)(lds + 17408);
    const int tid = opaque_tid(), wid = tid >> 6, lane = tid & 63, c16 = lane & 15, gq = lane >> 4;
    const int c = tid >> 3, ch0 = (tid & 7) * 8;
    const int nunits = 4096 + (with_ctx ? 256 : 0);
    const float* ps = p.pool_scale + l * 256;
    for (int uu = blockIdx.x; uu < nunits; uu += gridDim.x) {
        const int u = (uu & ~255) | ((uu & 7) << 5) | ((uu & 255) >> 3);
        const bool lat = u < 4096; int b, g, r, tok0;
        if (lat) { b = u >> 8; g = (u >> 6) & 3; r = u & 63; tok0 = b * 4096 + r * 64; }
        else { const int uu = u - 4096; b = uu >> 4; g = (uu >> 2) & 3; r = uu & 3; tok0 = NLAT + b * 256 + r * 64; }
        const int k = 2 << g, lo = k >> 1, hi = k - 1 - lo;
        const float* Ug = p.U + g * 64 + ch0;
        f32x4 m0 = (f32x4){0.f, 0.f, 0.f, 0.f}, m1 = m0; float inv;
        if (lat) {
            const int r0 = max(r - lo, 0), r1 = min(r + hi, 63);
            f32x4 a0 = m0, a1 = m0;
            win_sum_g(g, Ug + (size_t)(b * 4096 + r0 * 64 + c) * 256, (size_t)64 * 256, r1 - r0 + 1, a0, a1);
            const float ir = 1.f / (float)(r1 - r0 + 1);
            *(LAS f32x4*)(V + c * 68 + ch0) = a0 * ir; *(LAS f32x4*)(V + c * 68 + ch0 + 4) = a1 * ir;
            __syncthreads();
            const int cc0 = max(c - lo, 0), cc1 = min(c + hi, 63);
            for (int cc = cc0; cc <= cc1; ++cc) { m0 += *(const LAS f32x4*)(V + cc * 68 + ch0); m1 += *(const LAS f32x4*)(V + cc * 68 + ch0 + 4); }
            inv = 1.f / (float)(cc1 - cc0 + 1);
        } else {
            const int i = r * 64 + c, i0 = max(i - lo, 0), i1 = min(i + hi, 255);
            win_sum_g(g, Ug + (size_t)(NLAT + b * 256 + i0) * 256, (size_t)256, i1 - i0 + 1, m0, m1);
            inv = 1.f / (float)(i1 - i0 + 1);
        }
        { const float* q = Ug + (size_t)(tok0 + c) * 256; const f32x4 u0 = *(const f32x4*)q, u1 = *(const f32x4*)(q + 4);
          const f32x4 d0 = m0 * inv - u0, d1 = m1 * inv - u1;
          u32x4 w; w.x = cvt_pk_bf16(d0[0], d0[1]); w.y = cvt_pk_bf16(d0[2], d0[3]); w.z = cvt_pk_bf16(d1[0], d1[1]); w.w = cvt_pk_bf16(d1[2], d1[3]);
          *(LAS u32x4*)(Dm + c * 72 + ch0) = w; }
        __syncthreads();
        const int tb = wid >> 1;
#pragma unroll
        for (int o = 0; o < 2; ++o) {
            const int ob = (wid & 1) * 2 + o; f32x4 acc = (f32x4){0.f, 0.f, 0.f, 0.f};
#pragma unroll
            for (int ks = 0; ks < 2; ++ks) {
                const bf16x8 a = *(const bf16x8*)(p.Btpool + g * 4096 + (ob * 16 + c16) * 64 + ks * 32 + gq * 8);
                const bf16x8 bb = *(const LAS bf16x8*)(Dm + (tb * 16 + c16) * 72 + ks * 32 + gq * 8);
                acc = __builtin_amdgcn_mfma_f32_16x16x32_bf16(a, bb, acc, 0, 0, 0);
            }
            const int tok = tok0 + tb * 16 + c16, oc = g * 64 + ob * 16 + 4 * gq;
            const f32x4 sc = *(const f32x4*)(ps + oc);
            u32x2 w; w.x = cvt_pk_bf16(acc[0] * sc[0], acc[1] * sc[1]); w.y = cvt_pk_bf16(acc[2] * sc[2], acc[3] * sc[3]);
            *(u32x2*)(p.XN + (size_t)tok * DM + oc) = w;
        }
        __syncthreads();
    }
}

typedef float f32x16 __attribute__((ext_vector_type(16)));
#define ROWMAX32(out, A, B) do { \
    asm("v_max3_f32 %0, %1, %2, %3\n\tv_max3_f32 %0, %0, %4, %5\n\tv_max3_f32 %0, %0, %6, %7\n\tv_max3_f32 %0, %0, %8, %9\n\tv_max3_f32 %0, %0, %10, %11\n\tv_max3_f32 %0, %0, %12, %13\n\tv_max3_f32 %0, %0, %14, %15\n\tv_max3_f32 %0, %0, %16, %16" \
        : "=&v"(out) : "v"((A)[0]), "v"((A)[1]), "v"((A)[2]), "v"((A)[3]), "v"((A)[4]), "v"((A)[5]), "v"((A)[6]), "v"((A)[7]), "v"((A)[8]), "v"((A)[9]), "v"((A)[10]), "v"((A)[11]), "v"((A)[12]), "v"((A)[13]), "v"((A)[14]), "v"((A)[15])); \
    asm("v_max3_f32 %0, %0, %1, %2\n\tv_max3_f32 %0, %0, %3, %4\n\tv_max3_f32 %0, %0, %5, %6\n\tv_max3_f32 %0, %0, %7, %8\n\tv_max3_f32 %0, %0, %9, %10\n\tv_max3_f32 %0, %0, %11, %12\n\tv_max3_f32 %0, %0, %13, %14\n\tv_max3_f32 %0, %0, %15, %16" \
        : "+v"(out) : "v"((B)[0]), "v"((B)[1]), "v"((B)[2]), "v"((B)[3]), "v"((B)[4]), "v"((B)[5]), "v"((B)[6]), "v"((B)[7]), "v"((B)[8]), "v"((B)[9]), "v"((B)[10]), "v"((B)[11]), "v"((B)[12]), "v"((B)[13]), "v"((B)[14]), "v"((B)[15])); } while (0)

template <int DQK, int DV, bool DIFF>
__device__ __forceinline__ void attn_unit(LAS unsigned char* lds, const bf16_t* Qp, int ldq, const bf16_t* Kp, size_t kmap_stride, const bf16_t* Vtp, int kv_len,
                                          bf16_t* outp  , float lam, float post, const float* subln) {
    constexpr int NMAP = DIFF ? 2 : 1;
    constexpr int KROW = DQK * 2 + 16, VROW = 144, KBYTES = 64 * KROW, VBYTES = DV * VROW, KBUF = NMAP * KBYTES, OFFV = 2 * KBUF;
    constexpr int KC8 = DQK / 8, KCH = NMAP * 64 * KC8, VCH = DV * 8, NLK = (KCH + 511) / 512, NLV = (VCH + 511) / 512, NKS = DQK / 16, NDB = DV / 32;
    const int tid = opaque_tid(), wid = tid >> 6, lane = tid & 63, q32 = lane & 31, h = lane >> 5;
    const int qg = DIFF ? (wid >> 1) : wid, mp = DIFF ? (wid & 1) : 0;
    bf16x8 qf[NKS];
    { const bf16_t* qr = Qp + (size_t)(qg * 32 + q32) * ldq + mp * 64 + h * 8;
#pragma unroll
      for (int ks = 0; ks < NKS; ++ks) qf[ks] = *(const bf16x8*)(qr + ks * 16); }
    f32x16 O[NDB];
#pragma unroll
    for (int db = 0; db < NDB; ++db)
#pragma unroll
        for (int j = 0; j < 16; ++j) O[db][j] = 0.f;
    float lsum = 0.f;
    f32x16 mneg;
#pragma unroll
    for (int j = 0; j < 16; ++j) mneg[j] = 0.f;
    u32x4 stk[NLK], stv[NLV];
    auto kchunk = [&](int i) { const int ch = tid + i * 512; return ch < KCH ? ch : ch - 256; };
    const __amdgpu_buffer_rsrc_t srdK = __builtin_amdgcn_make_buffer_rsrc((void*)Kp, (short)0, 0x7fffffff, 0x00020000);
    int kvo[NLK];
#pragma unroll
    for (int i = 0; i < NLK; ++i) { const int ch = kchunk(i), mpc = ch / (64 * KC8), cc = ch % (64 * KC8); kvo[i] = (int)(mpc * kmap_stride * 2) + cc * 16; }
    auto gloadK = [&](int t) {
#pragma unroll
        for (int i = 0; i < NLK; ++i) stk[i] = __builtin_amdgcn_raw_buffer_load_b128(srdK, kvo[i], t * (64 * DQK * 2), 0); };
    auto lstoreK = [&](int t) {
#pragma unroll
        for (int i = 0; i < NLK; ++i) { const int ch = kchunk(i), mpc = ch / (64 * KC8), cc = ch % (64 * KC8); *(LAS u32x4*)(lds + (t & 1) * KBUF + mpc * KBYTES + (cc / KC8) * KROW + (cc % KC8) * 16) = stk[i]; } };
    static_assert(VCH % 512 == 0 && KCH >= 512 && KCH - 256 >= 0, "chunk maps");
    const __amdgpu_buffer_rsrc_t srdV = __builtin_amdgcn_make_buffer_rsrc((void*)Vtp, (short)0, 0x7fffffff, 0x00020000);
    int vvo[NLV];
#pragma unroll
    for (int i = 0; i < NLV; ++i) { const int cc = tid + i * 512; vvo[i] = (cc >> 3) * (KVL * 2) + (cc & 7) * 16; }
    auto gloadV = [&](int t) {
#pragma unroll
        for (int i = 0; i < NLV; ++i) stv[i] = __builtin_amdgcn_raw_buffer_load_b128(srdV, vvo[i], t * 128, 0); };
    auto lstoreV = [&](int t) {
#pragma unroll
        for (int i = 0; i < NLV; ++i) { const int cc = tid + i * 512; *(LAS u32x4*)(lds + OFFV + (t & 1) * VBYTES + (cc >> 3) * VROW + (cc & 7) * 16) = stv[i]; } };
    const int nt = kv_len / 64;
    gloadK(0); gloadV(0); lstoreK(0); lstoreV(1);
    gloadK(1); lstoreK(1);
    __syncthreads();
    f32x16 Sc[2], Sn[2];
    {
        const LAS unsigned char* kb_ = lds + mp * KBYTES + q32 * KROW + h * 16;
#pragma unroll
        for (int kb = 0; kb < 2; ++kb) {
#pragma unroll
            for (int j = 0; j < 16; ++j) Sc[kb][j] = 0.f;
#pragma unroll
            for (int ks = 0; ks < NKS; ++ks) { const bf16x8 a = *(const LAS bf16x8*)(kb_ + kb * 32 * KROW + ks * 32); Sc[kb] = __builtin_amdgcn_mfma_f32_32x32x16_bf16(a, qf[ks], Sc[kb], 0, 0, 0); }
        }
    }
    __syncthreads();
    __builtin_amdgcn_sched_barrier(0);
    asm volatile("s_nop 15\n\ts_nop 15\n\ts_nop 15\n\ts_nop 15\n\ts_nop 15\n\ts_nop 15" ::: "memory");
    __builtin_amdgcn_sched_barrier(0);
    float lm_cur;
    ROWMAX32(lm_cur, Sc[0], Sc[1]);
    bf16x8 Pa[2][2], Pb[2][2];
#pragma unroll
    for (int kb = 0; kb < 2; ++kb)
#pragma unroll
        for (int s = 0; s < 2; ++s)
#pragma unroll
            for (int e = 0; e < 8; ++e) Pa[kb][s][e] = 0;
    auto step = [&](f32x16 (&Sa)[2], f32x16 (&Sb)[2], bf16x8 (&Pp)[2][2], bf16x8 (&Pn)[2][2], int t) {
        const float lm = lm_cur;
        if (t == 0 || __builtin_amdgcn_ballot_w64(lm > 8.f) != 0) {
            const float mx = fmaxf(lm, shx(lm, 32, lane));
            const float delta = (t == 0 || mx > 8.f) ? mx : 0.f;
            const float alpha = t == 0 ? 1.f : fast_exp2(-delta);
            lsum *= alpha;
#pragma unroll
            for (int j = 0; j < 16; ++j) { mneg[j] -= delta; Sa[0][j] -= delta; Sa[1][j] -= delta; }
#pragma unroll
            for (int db = 0; db < NDB; ++db) O[db] *= alpha;
#pragma unroll
            for (int kb = 0; kb < 2; ++kb)
#pragma unroll
                for (int s = 0; s < 2; ++s) { u32x4 w = __builtin_bit_cast(u32x4, Pp[kb][s]);
#pragma unroll
                    for (int e = 0; e < 4; ++e) w[e] = cvt_pk_bf16(__uint_as_float(w[e] << 16) * alpha, __uint_as_float(w[e] & 0xffff0000u) * alpha);
                    Pp[kb][s] = __builtin_bit_cast(bf16x8, w); }
        }
        gloadK(min(t + 2, nt - 1)); gloadV(t);
        const LAS unsigned char* kb_ = lds + ((t + 1) & 1) * KBUF + mp * KBYTES + q32 * KROW + h * 16;
        const LAS unsigned char* vb_ = lds + OFFV + ((t + 1) & 1) * VBYTES + q32 * VROW + h * 16;
        constexpr int NQK = 2 * NKS, NM = NQK + 4 * NDB, NG = NM / 4, PPG = (16 + NG - 2) / (NG - 1);
        static_assert(NM % 4 == 0, "MFMA groups of four");
        bf16x8 fr[2][4];
        float ps0 = 0.f;
        unsigned pk[2][8];
#define ATT_LOADGRP(g) _Pragma("unroll") for (int q_ = 0; q_ < 4; ++q_) { const int i_ = 4 * (g) + q_; \
            fr[(g) & 1][q_] = (i_ < NQK) ? *(const LAS bf16x8*)(kb_ + (i_ / NKS) * 32 * KROW + (i_ % NKS) * 32) \
                                         : *(const LAS bf16x8*)(vb_ + ((i_ - NQK) / 4) * 32 * VROW + (((i_ - NQK) / 2) & 1) * 64 + ((i_ - NQK) & 1) * 32); }
        ATT_LOADGRP(0);
#pragma unroll
        for (int g = 0; g < NG; ++g) {
            if (g + 1 < NG) { ATT_LOADGRP(g + 1); }
#pragma unroll
            for (int q_ = 0; q_ < 4; ++q_) { const int i_ = 4 * g + q_;
                if (i_ < NQK) { const int kb = i_ / NKS, ks = i_ % NKS;
                    if (ks == 0) Sb[kb] = __builtin_amdgcn_mfma_f32_32x32x16_bf16(fr[g & 1][q_], qf[ks], mneg, 0, 0, 0);
                    else Sb[kb] = __builtin_amdgcn_mfma_f32_32x32x16_bf16(fr[g & 1][q_], qf[ks], Sb[kb], 0, 0, 0); }
                else { const int j_ = i_ - NQK, db = j_ / 4, kb = (j_ / 2) & 1, sx = j_ & 1; O[db] = __builtin_amdgcn_mfma_f32_32x32x16_bf16(fr[g & 1][q_], Pp[kb][sx], O[db], 0, 0, 0); } }
#pragma unroll
            for (int pp = g * PPG; pp < (g + 1) * PPG && pp < 16; ++pp) { const int kb = pp / 8, j = pp % 8;
                Sa[kb][2 * j] = fast_exp2(Sa[kb][2 * j]); Sa[kb][2 * j + 1] = fast_exp2(Sa[kb][2 * j + 1]); }
            if (g > 0) {
#pragma unroll
                for (int pp = (g - 1) * PPG; pp < g * PPG && pp < 16; ++pp) { const int kb = pp / 8, j = pp % 8;
                    asm("v_add_f32 %0, %1, %2" : "=v"(ps0) : "v"(ps0), "v"(Sa[kb][2 * j])); asm("v_add_f32 %0, %1, %2" : "=v"(ps0) : "v"(ps0), "v"(Sa[kb][2 * j + 1]));
                    pk[kb][j] = cvt_pk_bf16(Sa[kb][2 * j], Sa[kb][2 * j + 1]); }
            }
            if (g == NG - 2) { lstoreK(t + 2); lstoreV(t); }
            if (g == NG - 1) {
                float lmn;
                ROWMAX32(lmn, Sb[0], Sb[1]);
                lm_cur = lmn;
            }
            __builtin_amdgcn_sched_barrier(0);
        }
#pragma unroll
        for (int pp = (NG - 1) * PPG; pp < 16; ++pp) { const int kb = pp / 8, j = pp % 8;
            asm("v_add_f32 %0, %1, %2" : "=v"(ps0) : "v"(ps0), "v"(Sa[kb][2 * j])); asm("v_add_f32 %0, %1, %2" : "=v"(ps0) : "v"(ps0), "v"(Sa[kb][2 * j + 1]));
            pk[kb][j] = cvt_pk_bf16(Sa[kb][2 * j], Sa[kb][2 * j + 1]); }
#undef ATT_LOADGRP
#pragma unroll
        for (int kb = 0; kb < 2; ++kb) { Pn[kb][0] = __builtin_bit_cast(bf16x8, (u32x4){pk[kb][0], pk[kb][1], pk[kb][2], pk[kb][3]}); Pn[kb][1] = __builtin_bit_cast(bf16x8, (u32x4){pk[kb][4], pk[kb][5], pk[kb][6], pk[kb][7]}); }
        lsum += ps0;
        __syncthreads();
    };
    for (int t = 0; t < nt; t += 2) { step(Sc, Sn, Pa, Pb, t); step(Sn, Sc, Pb, Pa, t + 1); }
    bf16x8 (&pfp)[2][2] = Pa;
    { const LAS unsigned char* vb_ = lds + OFFV + ((nt - 1) & 1) * VBYTES + q32 * VROW + h * 16;
#pragma unroll
      for (int db = 0; db < NDB; ++db)
#pragma unroll
          for (int kb = 0; kb < 2; ++kb)
#pragma unroll
              for (int s = 0; s < 2; ++s) { const bf16x8 a = *(const LAS bf16x8*)(vb_ + db * 32 * VROW + kb * 64 + s * 32); O[db] = __builtin_amdgcn_mfma_f32_32x32x16_bf16(a, pfp[kb][s], O[db], 0, 0, 0); } }
    __syncthreads();
    const int te_ = opaque_tid(), lane_e = te_ & 63, q32e = lane_e & 31, he = lane_e >> 5;
    const float ltot = lsum + shx(lsum, 32, lane_e);
    const float inv = 1.f / ltot;
    bf16_t* orow = outp + (size_t)(qg * 32 + q32e) * DM + 4 * he;
    if constexpr (!DIFF) {
#pragma unroll
        for (int db = 0; db < NDB; ++db)
#pragma unroll
            for (int jj = 0; jj < 4; ++jj) { u32x2 w; w.x = cvt_pk_bf16(O[db][4 * jj] * inv, O[db][4 * jj + 1] * inv); w.y = cvt_pk_bf16(O[db][4 * jj + 2] * inv, O[db][4 * jj + 3] * inv);
                *(u32x2*)(orow + db * 32 + jj * 8) = w; }
    } else {
        LAS float* X = (LAS float*)lds + (qg * 32 + q32e) * 132 + 4 * he;
        if (mp == 1) { float lam_ = lam; asm volatile("" : "+v"(lam_)); const float sc = lam_ * inv;
#pragma unroll
            for (int db = 0; db < NDB; ++db)
#pragma unroll
                for (int jj = 0; jj < 4; ++jj) *(LAS f32x4*)(X + db * 32 + jj * 8) = (f32x4){O[db][4 * jj] * sc, O[db][4 * jj + 1] * sc, O[db][4 * jj + 2] * sc, O[db][4 * jj + 3] * sc}; }
        __syncthreads();
        if (mp == 0) {
            float ss = 0.f;
#pragma unroll
            for (int db = 0; db < NDB; ++db)
#pragma unroll
                for (int jj = 0; jj < 4; ++jj) { const f32x4 x = *(const LAS f32x4*)(X + db * 32 + jj * 8);
#pragma unroll
                    for (int e = 0; e < 4; ++e) { const float o = O[db][4 * jj + e] * inv - x[e]; O[db][4 * jj + e] = o; ss += o * o; } }
            ss += shx(ss, 32, lane_e);
            float li_ = post; asm volatile("" : "+v"(li_));
            const float r = rsqrtf(ss * (1.f / DV) + EPS) * (1.f - li_);
#pragma unroll
            for (int db = 0; db < NDB; ++db)
#pragma unroll
                for (int jj = 0; jj < 4; ++jj) { const f32x4 gsub = *(const f32x4*)(subln + db * 32 + jj * 8 + 4 * he);
                    u32x2 w; w.x = cvt_pk_bf16(O[db][4 * jj] * r * gsub[0], O[db][4 * jj + 1] * r * gsub[1]); w.y = cvt_pk_bf16(O[db][4 * jj + 2] * r * gsub[2], O[db][4 * jj + 3] * r * gsub[3]);
                    *(u32x2*)(orow + db * 32 + jj * 8) = w; }
        }
        __syncthreads();
    }
}

__device__ void phase_attn(const Params& p, int l, bool with_ctx, LAS unsigned char* lds) {
    const float lam_init = 0.8f - 0.6f * expf(-0.3f * (float)l);
    const float* dl = p.diff_lambda + l * 256;
    float s1 = 0.f, s2 = 0.f;
    for (int i = 0; i < 64; ++i) { s1 += dl[i] * dl[64 + i]; s2 += dl[128 + i] * dl[192 + i]; }
    const float lam = __builtin_bit_cast(float, __builtin_amdgcn_readfirstlane(__builtin_bit_cast(int, expf(s1) - expf(s2) + lam_init)));
    const float post_scale = __builtin_bit_cast(float, __builtin_amdgcn_readfirstlane(__builtin_bit_cast(int, 1.f - lam_init)));
    const int total = 3072 + (with_ctx ? 192 : 0);
    for (int u = blockIdx.x; u < total; u += gridDim.x) {
        bool diff; int b, h, row0, kvlen;
        if (u < 2048) { diff = true; const int i = u >> 8, blk = u & 255, bh = i * 8 + (blk & 7), qb = blk >> 3; b = bh >> 2; h = bh & 3; row0 = b * 4096 + qb * 128; kvlen = KVL; }
        else if (u < 3072) { diff = false; const int uu = u - 2048, i = uu >> 8, blk = uu & 255, slot = blk >> 3, bh = i * 16 + 2 * (blk & 7) + (slot >> 4), qb = slot & 15; b = bh >> 2; h = bh & 3; row0 = b * 4096 + qb * 256; kvlen = KVL; }
        else if (u < 3200) { diff = true; const int uu = u - 3072, bh = uu >> 1; b = bh >> 2; h = bh & 3; row0 = NLAT + b * 256 + (uu & 1) * 128; kvlen = CTXL; }
        else { diff = false; const int bh = u - 3200; b = bh >> 2; h = bh & 3; row0 = NLAT + b * 256; kvlen = CTXL; }
        if (diff) attn_unit<64, 128, true>(lds, p.QD + (size_t)row0 * 512 + (2 * h) * 64, 512, p.KD + (size_t)(b * 8 + 2 * h) * KVL * 64, (size_t)KVL * 64, p.VTD + (size_t)(b * 4 + h) * 128 * KVL, kvlen,
                                           p.XN + (size_t)row0 * DM + 512 + h * 128, lam, lam_init, p.diff_subln + l * 128);
        else attn_unit<96, 64, false>(lds, p.QM + (size_t)row0 * 384 + h * 96, 384, p.KM + (size_t)(b * 4 + h) * KVL * 96, 0, p.VTM + (size_t)(b * 4 + h) * 64 * KVL, kvlen,
                                      p.XN + (size_t)row0 * DM + 256 + h * 64, 0.f, 1.f, nullptr);
    }
}

constexpr int NPHASE = 2 + DEPTH * 11;
__device__ __forceinline__ void run_phase(const Params& p, int ph, LAS unsigned char* lds) {
    const int G = (int)gridDim.x, cb = (int)blockIdx.x;
    if (ph == 0) { phase_init(p, lds); return; }
    if (ph == NPHASE - 1) { phase_norm(p.H, p.H, NLAT, p.final_norm, nullptr, 0, 0, nullptr, p.out, nullptr, nullptr, 0.f, nullptr); return; }
    const int l = (ph - 1) / 11, k = (ph - 1) % 11; const bool last = l == DEPTH - 1;
    const float* mods_l = p.MODS + (size_t)l * 17 * 9216;
    const int Mlate = last ? NLAT : NT;
    pg8::StaticOrder S;
    if (k == 0 || k == 3 || k == 8) {
        const float* gw = (k == 0 ? p.ffn1_norm : k == 3 ? p.mix_norm : p.ffn2_norm) + l * DM;
        const int si = k == 8 ? 6 : k;
        const bool first = (l == 0 && k == 0);
        const bool pend = !first && !(k == 8 && last);
        const float* pgate = (k == 0 ? mods_l - 17 * 9216 + 8 * 1024 : k == 3 ? mods_l + 2 * 1024 : mods_l + 5 * 1024) + (size_t)16 * 9216;
        const bool ctx_in = (l == 0 && k <= 3);
        phase_norm(first ? p.x : p.H, ctx_in ? p.ctx - (size_t)NLAT * DM : p.H, k == 8 ? Mlate : NT, gw, mods_l, si, si + 1, p.XN, nullptr, pend ? p.P4 : nullptr, pgate, k == 8 ? 1.f : 0.5f, p.H);
        if (k == 0) phase_convert(p, l, lds);
    } else if (k == 1 || k == 9) {
        pg8::Gemm g{p.XN, k == 1 ? p.Bt13a : p.Bt13b, k == 1 ? NT : Mlate, 2 * DFF, DM, DM};
        S.init(g.M, g.N, G, cb); EpiSwiGLU E{p.G};
        pg8::gemm_phase(lds, g, S, E);
    } else if (k == 2 || k == 7 || k == 10) {
        const int Kf = k == 7 ? DM : DFF;
        const bf16_t* Ap = k == 7 ? p.XN : p.G; const bf16_t* Bp = k == 2 ? p.Bt2a : k == 7 ? p.Btout : p.Bt2b;
        const bool first = (l == 0 && k == 2);
        { pg8::Gemm g{Ap, Bp, NLAT, DM, Kf, Kf};
          S.init(g.M, g.N, G, cb); EpiResid E{first ? p.x : p.H, p.H, p.H, mods_l + (k == 2 ? 2 : k == 7 ? 5 : 8) * 1024, k == 7 ? 1.f : 0.5f};
          pg8::gemm_phase(lds, g, S, E); }
        if (k == 2 || !last) {
            const int kt = Kf / 128, q0 = kt / 4, r0 = kt % 4;
            for (int idx = cb; idx < 256; idx += G) {
                const int unit = idx >> 2, sl = idx & 3;
                const int kb0 = sl * q0 + (sl < r0 ? sl : r0), kl = q0 + (sl < r0 ? 1 : 0);
                pg8::Gemm g{Ap + (size_t)NLAT * Kf + kb0 * 128, Bp + kb0 * 128, NCTX, DM, kl * 128, Kf};
                S.init(g.M, g.N, G, cb); S.fixed = unit;
                EpiPartial E{p.P4 + (size_t)sl * NCTX * DM};
                __syncthreads();
                pg8::gemm_phase(lds, g, S, E);
            }
        }
    } else if (k == 4) {
        pg8::Gemm g{p.XN, p.Btin, NT, 2560, DM, DM};
        S.init(g.M, g.N, G, cb); EpiIn E{p.U, p.CQ, p.CKV, p.SSQ, p.QD, p.KD, p.VTD, p.KM, p.ROPED, p.ROPEM, lds + 131072};
        pg8::gemm_phase(lds, g, S, E);
    } else if (k == 5) {
        { pg8::Gemm g{p.CQ, p.Btuq, NT, 512, 384, 384}; S.init(g.M, g.N, G, cb); EpiQup E{p.SSQ, p.QM, p.ROPEM}; pg8::gemm_phase(lds, g, S, E); }
        { pg8::Gemm g{p.CKV, p.Btukv, NT, 512, 256, 256}; S.init(g.M, g.N, G, (cb + 32) % G); EpiKVup E{p.SSQ, p.KM, p.VTM, lds + 131072}; pg8::gemm_phase(lds, g, S, E); }
        __syncthreads();
        phase_pool(p, l, !last, lds);
    } else if (k == 6) {
        phase_attn(p, l, !last, lds);
    }
}

__device__ __forceinline__ void grid_barrier(unsigned* ctr, unsigned target) {
    asm volatile("s_waitcnt vmcnt(0) lgkmcnt(0)" ::: "memory");
    __syncthreads();
    if (threadIdx.x == 0) {
        __builtin_amdgcn_fence(__ATOMIC_RELEASE, "agent");
        asm volatile("s_waitcnt vmcnt(0)" ::: "memory");
        __hip_atomic_fetch_add(ctr, 1u, __ATOMIC_RELAXED, __HIP_MEMORY_SCOPE_AGENT);
        while (__hip_atomic_load(ctr, __ATOMIC_RELAXED, __HIP_MEMORY_SCOPE_AGENT) < target) __builtin_amdgcn_s_sleep(1);
        __builtin_amdgcn_fence(__ATOMIC_ACQUIRE, "agent");
        asm volatile("s_waitcnt vmcnt(0)" ::: "memory");
    }
    __syncthreads();
}

__global__ __launch_bounds__(512, 2) void hymba_mega(Params p) {
    extern __shared__ __attribute__((aligned(16))) unsigned char smem[];
    LAS unsigned char* lds = (LAS unsigned char*)smem;
    cg::grid_group grid = cg::this_grid();
    unsigned nbar = 0;
    for (int ph = p.ph_lo; ph < p.ph_hi; ++ph) {
        run_phase(p, ph, lds);
        if (ph + 1 < p.ph_hi) {
            if (ph == p.ph_lo) grid.sync();
            else grid_barrier(p.BAR, ++nbar * gridDim.x);
        }
    }
}

extern "C" void kernel_launch(void* const* d_in, const int* in_sizes, int n_in, void* d_out, int out_size, void* d_ws, size_t ws_size, hipStream_t stream) {
    static int grid_blocks = 0;
    if (!grid_blocks) {
        int dev = 0, cus = 0, per_cu = 0;
        hipGetDevice(&dev);
        hipDeviceGetAttribute(&cus, hipDeviceAttributeMultiprocessorCount, dev);
        if (hipFuncSetAttribute((const void*)hymba_mega, hipFuncAttributeMaxDynamicSharedMemorySize, LDS_BYTES) != hipSuccess) fprintf(stderr, "hipFuncSetAttribute failed\n");
        if (hipOccupancyMaxActiveBlocksPerMultiprocessor(&per_cu, (const void*)hymba_mega, 512, LDS_BYTES) != hipSuccess || per_cu < 1) { per_cu = 1; (void)hipGetLastError(); }
        grid_blocks = cus * per_cu;
        if (grid_blocks <= 0) grid_blocks = 256;
    }
    Params p{};
    const float** in = (const float**)&p;
    for (int i = 0; i < 26 && i < n_in; ++i) in[i] = (const float*)d_in[i];
    p.out = (float*)d_out;
    unsigned char* w = (unsigned char*)d_ws; size_t off = 0;
    auto take = [&](size_t bytes) { unsigned char* r = w + off; off += (bytes + 255) & ~(size_t)255; return r; };
    p.H = (float*)take((size_t)NT * DM * 4);
    p.XN = (bf16_t*)take((size_t)NT * DM * 2);
    unsigned char* big = w + off; size_t boff = 0;
    auto takeb = [&](size_t bytes) { unsigned char* r = big + boff; boff += (bytes + 255) & ~(size_t)255; return r; };
    p.U = (float*)takeb((size_t)NT * 256 * 4);
    p.CQ = (bf16_t*)takeb((size_t)NT * 384 * 2);
    p.CKV = (bf16_t*)takeb((size_t)NT * 256 * 2);
    p.SSQ = (float*)takeb((size_t)NT * 16 * 4);
    p.QD = (bf16_t*)takeb((size_t)NT * 512 * 2);
    p.KD = (bf16_t*)takeb((size_t)NB * 8 * KVL * 64 * 2);
    p.VTD = (bf16_t*)takeb((size_t)NB * 4 * 128 * KVL * 2);
    p.QM = (bf16_t*)takeb((size_t)NT * 384 * 2);
    p.KM = (bf16_t*)takeb((size_t)NB * 4 * KVL * 96 * 2);
    p.VTM = (bf16_t*)takeb((size_t)NB * 4 * 64 * KVL * 2);
    p.G = (bf16_t*)big;
    p.P4 = (float*)(big + (((size_t)NT * DFF * 2 + 255) & ~(size_t)255));
    const size_t gbytes = (size_t)NT * DFF * 2;
    off += (boff > gbytes ? boff : gbytes); off = (off + 255) & ~(size_t)255;
    p.Bt13a = (bf16_t*)take((size_t)2 * DFF * DM * 2); p.Bt2a = (bf16_t*)take((size_t)DM * DFF * 2);
    p.Bt13b = (bf16_t*)take((size_t)2 * DFF * DM * 2); p.Bt2b = (bf16_t*)take((size_t)DM * DFF * 2);
    p.Btin = (bf16_t*)take((size_t)2560 * DM * 2); p.Btout = (bf16_t*)take((size_t)DM * DM * 2);
    p.Btuq = (bf16_t*)take((size_t)512 * 384 * 2); p.Btukv = (bf16_t*)take((size_t)512 * 256 * 2); p.Btpool = (bf16_t*)take((size_t)4 * 64 * 64 * 2);
    p.MODS = (float*)take((size_t)DEPTH * 17 * 9216 * 4);
    p.BAR = (unsigned*)take(256);
    p.ROPED = (float*)take((size_t)4096 * 32 * 2 * 4); p.ROPEM = (float*)take((size_t)4096 * 16 * 2 * 4);
    if (off > ws_size) { fprintf(stderr, "kernel_launch: workspace too small: need %zu have %zu\n", off, ws_size); return; }
    (void)hipMemsetAsync(p.BAR, 0, 256, stream);
#if MULTI_LAUNCH
    for (int ph = 0; ph < NPHASE; ++ph) { p.ph_lo = ph; p.ph_hi = ph + 1; hipLaunchKernelGGL(hymba_mega, dim3(grid_blocks), dim3(512), LDS_BYTES, stream, p); }
#else
    p.ph_lo = 0; p.ph_hi = NPHASE;
    void* args[] = {&p};
    hipError_t e = hipLaunchCooperativeKernel((const void*)hymba_mega, dim3(grid_blocks), dim3(512), args, LDS_BYTES, stream);
    if (e != hipSuccess) fprintf(stderr, "cooperative launch failed: %s (grid %d)\n", hipGetErrorString(e), grid_blocks);
#endif
}
```
